# Optimizing an MI355X kernel written in HIP

```python
import math
import jax, jax.numpy as jnp
from jax import lax
import numpy as np

D_MODEL = 1024
BATCH = 8
SEQ = 4096
DEPTH = 2

HEAD_DIM = 64
SB_HEADS = 8
SB_WIDTH = SB_HEADS * HEAD_DIM
LRU_WIDTH = 512
LRU_BLOCKS = 8
LRU_BLOCK = LRU_WIDTH // LRU_BLOCKS
CONV_WIDTH = 4
LRU_C = 8.0
DIFF_HEADS = 8
DIFF_VDIM = 2 * HEAD_DIM
DIFF_QK = 2 * DIFF_HEADS * HEAD_DIM
DIFF_V = DIFF_HEADS * DIFF_VDIM
EVEN_IN = 3 * SB_WIDTH + 2 * LRU_WIDTH
ODD_IN = 2 * DIFF_QK + DIFF_V
N_BUCKETS = 32
MAX_EXACT = N_BUCKETS // 2
MAX_DISTANCE = 128
D_FF_DENSE = 2816
N_EXPERTS = 8
TOP_K = 2
D_FF_EXPERT = 3584
Q_BLOCK = 128
EPS = 1e-6

kernel_name = "hybrid_sb_rglru_diffattn_moe_adaln"


def rmsnorm(x, g):
    xf = x.astype(jnp.float32)
    n = xf * lax.rsqrt(jnp.mean(xf * xf, axis=-1, keepdims=True) + EPS)
    return (n * g.astype(jnp.float32)).astype(x.dtype)


def modulate(h, shift, scale):
    return h * (1.0 + scale[:, None, :]) + shift[:, None, :]


def _query_blocks(q):
    b, h, s, d = q.shape
    return jnp.moveaxis(q.reshape(b, h, s // Q_BLOCK, Q_BLOCK, d), 2, 0)


def _merge_blocks(o):
    nb, b, h, qb, d = o.shape
    return jnp.moveaxis(o, 0, 2).reshape(b, h, nb * qb, d)


def stick_breaking_attention(q, k, v):
    s_len = q.shape[2]
    scale = HEAD_DIM ** -0.5
    key_pos = jnp.arange(s_len, dtype=jnp.int32)

    def block(args):
        qb, blk = args
        z = jnp.einsum('bhqd,bhkd->bhqk', qb, k).astype(jnp.float32) * scale
        q_pos = blk * Q_BLOCK + jnp.arange(Q_BLOCK, dtype=jnp.int32)
        mask = key_pos[None, :] < q_pos[:, None]
        log_keep = jnp.where(mask, jax.nn.log_sigmoid(-z), 0.0)
        later = lax.cumsum(log_keep, axis=3, reverse=True) - log_keep
        w = jnp.where(mask, jnp.exp(jax.nn.log_sigmoid(z) + later), 0.0)
        return jnp.einsum('bhqk,bhkd->bhqd', w.astype(v.dtype), v)

    nb = s_len // Q_BLOCK
    out = lax.map(block, (_query_blocks(q), jnp.arange(nb, dtype=jnp.int32)))
    return _merge_blocks(out)


def rg_lru_branch(xb, gb, conv_w, conv_b, ga_w, ga_b, gx_w, gx_b, lam):
    b, s_len, c = xb.shape
    xc = lax.conv_general_dilated(
        xb, conv_w[:, None, :], window_strides=(1,), padding=[(CONV_WIDTH - 1, 0)],
        dimension_numbers=('NWC', 'WIO', 'NWC'), feature_group_count=c) + conv_b
    xg = xc.reshape(b, s_len, LRU_BLOCKS, LRU_BLOCK)
    r = jax.nn.sigmoid(jnp.einsum('bsgi,gij->bsgj', xg, ga_w).reshape(b, s_len, c) + ga_b)
    i = jax.nn.sigmoid(jnp.einsum('bsgi,gij->bsgj', xg, gx_w).reshape(b, s_len, c) + gx_b)
    log_a = LRU_C * r.astype(jnp.float32) * jax.nn.log_sigmoid(lam.astype(jnp.float32))
    a = jnp.exp(log_a)
    u = jnp.sqrt(-jnp.expm1(2.0 * log_a)) * (i * xc).astype(jnp.float32)

    def combine(left, right):
        a1, b1 = left
        a2, b2 = right
        return a1 * a2, a2 * b1 + b2

    _, h = lax.associative_scan(combine, (a, u), axis=1)
    return h.astype(xb.dtype) * jax.nn.gelu(gb)


def even_mixer(h, w_in, w_out, conv_w, conv_b, ga_w, ga_b, gx_w, gx_b, lam):
    b, s_len, _ = h.shape
    proj = h @ w_in
    q, k, v, xb, gb = jnp.split(
        proj, [SB_WIDTH, 2 * SB_WIDTH, 3 * SB_WIDTH, 3 * SB_WIDTH + LRU_WIDTH], axis=-1)
    heads = lambda t: t.reshape(b, s_len, SB_HEADS, HEAD_DIM).transpose(0, 2, 1, 3)
    ya = stick_breaking_attention(heads(q), heads(k), heads(v))
    ya = ya.transpose(0, 2, 1, 3).reshape(b, s_len, SB_WIDTH)
    yb = rg_lru_branch(xb, gb, conv_w, conv_b, ga_w, ga_b, gx_w, gx_b, lam)
    return jnp.concatenate([ya, yb], axis=-1) @ w_out


def t5_bucket(rel):
    n = jnp.maximum(rel, 0)
    nf = jnp.maximum(n, 1).astype(jnp.float32)
    large = MAX_EXACT + (jnp.log(nf / MAX_EXACT) / math.log(MAX_DISTANCE / MAX_EXACT)
                         * (N_BUCKETS - MAX_EXACT)).astype(jnp.int32)
    large = jnp.minimum(large, N_BUCKETS - 1)
    return jnp.where(n < MAX_EXACT, n, large)


def differential_attention(q, k, v, rel_bias, lam):
    b, _, s_len, _ = q.shape
    scale = HEAD_DIM ** -0.5
    key_pos = jnp.arange(s_len, dtype=jnp.int32)

    def block(args):
        qb, blk = args
        z = jnp.einsum('bhqd,bhkd->bhqk', qb, k).astype(jnp.float32) * scale
        z = z.reshape(b, DIFF_HEADS, 2, Q_BLOCK, s_len)
        q_pos = blk * Q_BLOCK + jnp.arange(Q_BLOCK, dtype=jnp.int32)
        rel = q_pos[:, None] - key_pos[None, :]
        bias = jnp.transpose(rel_bias[t5_bucket(rel)].astype(jnp.float32), (2, 0, 1))
        z = jnp.where(rel >= 0, z + bias[None, :, None], -jnp.inf)
        p = jax.nn.softmax(z, axis=-1)
        attn = p[:, :, 0] - lam * p[:, :, 1]
        return jnp.einsum('bhqk,bhkd->bhqd', attn.astype(v.dtype), v)

    nb = s_len // Q_BLOCK
    out = lax.map(block, (_query_blocks(q), jnp.arange(nb, dtype=jnp.int32)))
    return _merge_blocks(out)


def odd_mixer(h, w_in, w_out, rel_bias, lq1, lk1, lq2, lk2, subln, lambda_init):
    b, s_len, _ = h.shape
    proj = h @ w_in
    q, k, v = jnp.split(proj, [DIFF_QK, 2 * DIFF_QK], axis=-1)
    q = q.reshape(b, s_len, 2 * DIFF_HEADS, HEAD_DIM).transpose(0, 2, 1, 3)
    k = k.reshape(b, s_len, 2 * DIFF_HEADS, HEAD_DIM).transpose(0, 2, 1, 3)
    v = v.reshape(b, s_len, DIFF_HEADS, DIFF_VDIM).transpose(0, 2, 1, 3)
    lam = (jnp.exp(jnp.sum(lq1.astype(jnp.float32) * lk1.astype(jnp.float32)))
           - jnp.exp(jnp.sum(lq2.astype(jnp.float32) * lk2.astype(jnp.float32)))
           + lambda_init)
    o = differential_attention(q, k, v, rel_bias, lam)
    o = rmsnorm(o, subln) * (1.0 - lambda_init)
    return o.transpose(0, 2, 1, 3).reshape(b, s_len, DIFF_V) @ w_out


def swiglu(h, w_gate, w_up, w_down):
    return (jax.nn.silu(h @ w_gate) * (h @ w_up)) @ w_down


def moe_ffn(h, router_w, router_b, wg, wu, wd):
    logits = (jnp.einsum('bsd,de->bse', h, router_w) + router_b).astype(jnp.float32)
    top_vals, top_idx = lax.top_k(logits, TOP_K)
    top_w = jax.nn.softmax(top_vals, axis=-1)
    gates = jnp.einsum('bsk,bske->bse', top_w,
                       jax.nn.one_hot(top_idx, N_EXPERTS, dtype=jnp.float32))
    y = jnp.zeros_like(h)
    for e in range(N_EXPERTS):
        y = y + gates[..., e:e + 1].astype(h.dtype) * swiglu(h, wg[e], wu[e], wd[e])
    return y


def setup_inputs(seed: int = 0) -> dict:
    key = jax.random.key(seed)
    ks = jax.random.split(key, 32)
    f32 = jnp.float32
    ne = (DEPTH + 1) // 2
    no = DEPTH // 2
    nrm = lambda k, shape, s: jax.random.normal(k, shape, f32) * s
    u = jax.random.uniform(ks[16], (ne, LRU_WIDTH), f32, 0.9, 0.999)
    root = u ** (1.0 / LRU_C)
    return {
        "x": nrm(ks[0], (BATCH, SEQ, D_MODEL), 1.0),
        "c": nrm(ks[1], (BATCH, D_MODEL), 1.0),
        "rel_bias": nrm(ks[2], (N_BUCKETS, DIFF_HEADS), 0.5),
        "ada_w": nrm(ks[3], (DEPTH, D_MODEL, 6 * D_MODEL), D_MODEL ** -0.5),
        "ada_b": nrm(ks[4], (DEPTH, 6 * D_MODEL), 0.02),
        "ln_mix": 1.0 + nrm(ks[5], (DEPTH, D_MODEL), 0.1),
        "ln_ffn": 1.0 + nrm(ks[6], (DEPTH, D_MODEL), 0.1),
        "ln_final": 1.0 + nrm(ks[7], (D_MODEL,), 0.1),
        "even_w_in": nrm(ks[8], (ne, D_MODEL, EVEN_IN), D_MODEL ** -0.5),
        "even_w_out": nrm(ks[9], (ne, SB_WIDTH + LRU_WIDTH, D_MODEL), (SB_WIDTH + LRU_WIDTH) ** -0.5),
        "lru_conv_w": nrm(ks[10], (ne, CONV_WIDTH, LRU_WIDTH), CONV_WIDTH ** -0.5),
        "lru_conv_b": nrm(ks[11], (ne, LRU_WIDTH), 0.02),
        "lru_gate_a_w": nrm(ks[12], (ne, LRU_BLOCKS, LRU_BLOCK, LRU_BLOCK), LRU_BLOCK ** -0.5),
        "lru_gate_a_b": nrm(ks[13], (ne, LRU_WIDTH), 0.02),
        "lru_gate_x_w": nrm(ks[14], (ne, LRU_BLOCKS, LRU_BLOCK, LRU_BLOCK), LRU_BLOCK ** -0.5),
        "lru_gate_x_b": nrm(ks[15], (ne, LRU_WIDTH), 0.02),
        "lru_lambda": jnp.log(root) - jnp.log1p(-root),
        "ffn_w_gate": nrm(ks[17], (ne, D_MODEL, D_FF_DENSE), D_MODEL ** -0.5),
        "ffn_w_up": nrm(ks[18], (ne, D_MODEL, D_FF_DENSE), D_MODEL ** -0.5),
        "ffn_w_down": nrm(ks[19], (ne, D_FF_DENSE, D_MODEL), D_FF_DENSE ** -0.5),
        "odd_w_in": nrm(ks[20], (no, D_MODEL, ODD_IN), D_MODEL ** -0.5),
        "odd_w_out": nrm(ks[21], (no, DIFF_V, D_MODEL), DIFF_V ** -0.5),
        "diff_lambda_q1": nrm(ks[22], (no, HEAD_DIM), 0.1),
        "diff_lambda_k1": nrm(ks[23], (no, HEAD_DIM), 0.1),
        "diff_lambda_q2": nrm(ks[24], (no, HEAD_DIM), 0.1),
        "diff_lambda_k2": nrm(ks[25], (no, HEAD_DIM), 0.1),
        "diff_subln": 1.0 + nrm(ks[26], (no, DIFF_VDIM), 0.1),
        "router_w": nrm(ks[27], (no, D_MODEL, N_EXPERTS), D_MODEL ** -0.5),
        "router_b": nrm(ks[28], (no, N_EXPERTS), 0.01),
        "moe_w_gate": nrm(ks[29], (no, N_EXPERTS, D_MODEL, D_FF_EXPERT), D_MODEL ** -0.5),
        "moe_w_up": nrm(ks[30], (no, N_EXPERTS, D_MODEL, D_FF_EXPERT), D_MODEL ** -0.5),
        "moe_w_down": nrm(ks[31], (no, N_EXPERTS, D_FF_EXPERT, D_MODEL), D_FF_EXPERT ** -0.5),
    }


def reference(x, c, rel_bias, ada_w, ada_b, ln_mix, ln_ffn, ln_final,
              even_w_in, even_w_out, lru_conv_w, lru_conv_b, lru_gate_a_w, lru_gate_a_b,
              lru_gate_x_w, lru_gate_x_b, lru_lambda, ffn_w_gate, ffn_w_up, ffn_w_down,
              odd_w_in, odd_w_out, diff_lambda_q1, diff_lambda_k1, diff_lambda_q2,
              diff_lambda_k2, diff_subln, router_w, router_b, moe_w_gate, moe_w_up, moe_w_down):
    cond = jax.nn.silu(c)
    for layer in range(DEPTH):
        i = layer // 2
        mod = cond @ ada_w[layer] + ada_b[layer]
        sh1, sc1, g1, sh2, sc2, g2 = jnp.split(mod, 6, axis=-1)
        h = modulate(rmsnorm(x, ln_mix[layer]), sh1, sc1)
        if layer % 2 == 0:
            mix = even_mixer(h, even_w_in[i], even_w_out[i], lru_conv_w[i], lru_conv_b[i],
                             lru_gate_a_w[i], lru_gate_a_b[i], lru_gate_x_w[i], lru_gate_x_b[i],
                             lru_lambda[i])
        else:
            lambda_init = 0.8 - 0.6 * math.exp(-0.3 * layer)
            mix = odd_mixer(h, odd_w_in[i], odd_w_out[i], rel_bias, diff_lambda_q1[i],
                            diff_lambda_k1[i], diff_lambda_q2[i], diff_lambda_k2[i],
                            diff_subln[i], lambda_init)
        x = x + g1[:, None, :] * mix
        h = modulate(rmsnorm(x, ln_ffn[layer]), sh2, sc2)
        if layer % 2 == 0:
            ffn = swiglu(h, ffn_w_gate[i], ffn_w_up[i], ffn_w_down[i])
        else:
            ffn = moe_ffn(h, router_w[i], router_b[i], moe_w_gate[i], moe_w_up[i], moe_w_down[i])
        x = x + g2[:, None, :] * ffn
    return rmsnorm(x, ln_final)
```

```cpp
#include <hip/hip_runtime.h>
#include <cstdio>
#include <cstdint>
#include <cmath>
namespace pg8 {
#define PG8_LAS __attribute__((address_space(3)))
typedef unsigned short bf16_t;
typedef short bf16x8 __attribute__((ext_vector_type(8)));
typedef float f32x4 __attribute__((ext_vector_type(4)));
typedef unsigned u32x4 __attribute__((ext_vector_type(4)));
constexpr int BM = 256, BK = 64, HALF = 128, HTB = HALF * BK * 2  , STAGE_BYTES = 8 * HTB, NXCD = 8, WGM = 8;

__host__ __device__ __forceinline__ int lds_byte(int r, int c) { const int st = (r >> 4) * 2 + (c >> 5), rr = r & 15, cc = c & 31, ob = rr * 64 + cc * 2; return st * 1024 + (ob ^ (((ob >> 9) & 1) << 5)); }
__host__ __device__ __forceinline__ void stage_rc(int b, int& R, int& C) { const int st = b / 1024, sb = b % 1024, swz = sb ^ (((sb >> 9) & 1) << 5); R = (st >> 1) * 16 + swz / 64; C = (st & 1) * 32 + (swz % 64) / 2; }
__host__ __device__ __forceinline__ int perm32(int rho) { const int n = rho >> 4, i = rho & 15; return 8 * (i >> 2) + 4 * n + (i & 3); }

struct Unit { int pm, pn; };
struct Gemm { const bf16_t* A; const bf16_t* Bt; int M, N, K, pad; };

struct StaticOrder {
    int nM, nN, nwg, G, c;
    __host__ __device__ void init(int M, int N, int G_, int c_) { nM = M / BM; nN = N / BM; nwg = nM * nN; G = G_; c = c_; }
    __host__ __device__ bool next(int i, Unit& u) const {
        const long L = (long)i * G + c; if (L >= nwg) return false;
        int wgid = (int)L; { const int q = nwg / NXCD, r = nwg % NXCD, xcd = wgid % NXCD, off = wgid / NXCD; wgid = (xcd < r ? xcd * (q + 1) : r * (q + 1) + (xcd - r) * q) + off; }
        const int nig = WGM * nN, gid = wgid / nig, fm = gid * WGM, gsz = (nM - fm) < WGM ? (nM - fm) : WGM;
        u.pm = fm + ((wgid % nig) % gsz); u.pn = (wgid % nig) / gsz; return true;
    }
    __device__ __forceinline__ void a_ready(const Unit&) const {}
    __device__ __forceinline__ void done(const Unit&) const {}
};

__device__ __forceinline__ unsigned cvt_pk_bf16(float lo, float hi) { unsigned r; asm volatile("v_cvt_pk_bf16_f32 %0, %1, %2" : "=v"(r) : "v"(lo), "v"(hi)); return r; }
typedef float f32x2 __attribute__((ext_vector_type(2)));
__device__ __forceinline__ f32x2 gelu_pk(f32x2 v) {
    const f32x2 av = __builtin_elementwise_abs(v), d = av * 0.2316418882f + 1.0f;
    f32x2 t; t.x = __builtin_amdgcn_rcpf(d.x); t.y = __builtin_amdgcn_rcpf(d.y);
    f32x2 q = t * 0.5307027145f + (-0.7265760135f); q = q * t + 0.7107068705f; q = q * t + (-0.142248368f); q = q * t + 0.127414796f; q = q * t;
    const f32x2 s = (v * v) * (-0.72134752044f);
    f32x2 e; e.x = __builtin_amdgcn_exp2f(s.x); e.y = __builtin_amdgcn_exp2f(s.y);
    const f32x2 m = v * (q * e), r = v - m;
    f32x2 o; o.x = v.x < 0.f ? m.x : r.x; o.y = v.y < 0.f ? m.y : r.y; return o;
}

template <int ACT  > struct EpiBf16 {
    static constexpr bool PERM = true, AFTER_DRAIN = false; static_assert(ACT == 0 || ACT == 1, "EpiBf16: ACT is 0 (none) or 1 (gelu_pk)");
    bf16_t* O; int ldc; const float* bias; int split_cols; size_t split_stride; float scale0;
    __device__ __forceinline__ void operator()(const f32x4 (&acc)[2][2][4][2], const Unit& u, int wr, int wc, int fr, int fq) const {
        const int row0 = u.pm * BM + wr * 64 + fr; int colt = u.pn * BM; bf16_t* base = O;
        float sc = 1.f; if (split_cols) { const int t = colt / split_cols; base += (size_t)t * split_stride; colt -= t * split_cols; if (t == 0) sc = scale0; }
        const int col0 = colt + wc * 32 + 8 * fq, bcol0 = u.pn * BM + wc * 32 + 8 * fq;
        f32x4 bv[2][2];
#pragma unroll
        for (int bj = 0; bj < 2; ++bj)
#pragma unroll
            for (int n = 0; n < 2; ++n) bv[bj][n] = bias ? *(const f32x4*)(bias + bcol0 + bj * HALF + 4 * n) : (f32x4){0.f, 0.f, 0.f, 0.f};
#pragma unroll
        for (int ai = 0; ai < 2; ++ai)
#pragma unroll
            for (int m = 0; m < 4; ++m) { bf16_t* rowp = base + (size_t)(row0 + ai * HALF + m * 16) * ldc + col0;
#pragma unroll
                for (int bj = 0; bj < 2; ++bj) { f32x4 v0 = acc[ai][bj][m][0] + bv[bj][0], v1 = acc[ai][bj][m][1] + bv[bj][1];
                    if (ACT == 1) { f32x2 a = gelu_pk((f32x2){v0[0], v0[1]}), b = gelu_pk((f32x2){v0[2], v0[3]}), c = gelu_pk((f32x2){v1[0], v1[1]}), d = gelu_pk((f32x2){v1[2], v1[3]});
                        v0 = (f32x4){a.x, a.y, b.x, b.y}; v1 = (f32x4){c.x, c.y, d.x, d.y}; }
                    v0 = v0 * sc; v1 = v1 * sc; u32x4 w; w.x = cvt_pk_bf16(v0[0], v0[1]); w.y = cvt_pk_bf16(v0[2], v0[3]); w.z = cvt_pk_bf16(v1[0], v1[1]); w.w = cvt_pk_bf16(v1[2], v1[3]);
                    *(u32x4*)(rowp + bj * HALF) = w; } }
    }
};
__device__ __forceinline__ float silu_f(float x) { return x * __builtin_amdgcn_rcpf(1.0f + __expf(-x)); }
struct EpiResid {
    static constexpr bool PERM = true, AFTER_DRAIN = false;
    const float* xin; float* xout; const float* gate; const float* rowgate; int gate_ld; int rows_per_batch; int ldc; int rg_ld;
    __device__ __forceinline__ void operator()(const f32x4 (&acc)[2][2][4][2], const Unit& u, int wr, int wc, int fr, int fq) const {
        const int row0 = u.pm * BM + wr * 64 + fr, col0 = u.pn * BM + wc * 32 + 8 * fq;
        const int b = (u.pm * BM) / rows_per_batch;
        f32x4 gv[2][2];
#pragma unroll
        for (int bj = 0; bj < 2; ++bj)
#pragma unroll
            for (int n = 0; n < 2; ++n) gv[bj][n] = *(const f32x4*)(gate + (size_t)b * gate_ld + col0 + bj * HALF + 4 * n);
#pragma unroll
        for (int ai = 0; ai < 2; ++ai)
#pragma unroll
            for (int m = 0; m < 4; ++m) { const int row = row0 + ai * HALF + m * 16; const size_t off = (size_t)row * ldc + col0;
                const float rg = rowgate ? rowgate[(size_t)row * rg_ld] : 1.0f;
#pragma unroll
                for (int bj = 0; bj < 2; ++bj) {
                    const f32x4 x0 = *(const f32x4*)(xin + off + bj * HALF), x1 = *(const f32x4*)(xin + off + bj * HALF + 4);
                    *(f32x4*)(xout + off + bj * HALF) = x0 + gv[bj][0] * rg * acc[ai][bj][m][0];
                    *(f32x4*)(xout + off + bj * HALF + 4) = x1 + gv[bj][1] * rg * acc[ai][bj][m][1]; } }
    }
};
struct EpiSwiglu {
    static constexpr bool PERM = true, AFTER_DRAIN = false;
    bf16_t* O; int ldc; int pad;
    __device__ __forceinline__ void operator()(const f32x4 (&acc)[2][2][4][2], const Unit& u, int wr, int wc, int fr, int fq) const {
        const int row0 = u.pm * BM + wr * 64 + fr, col0 = u.pn * HALF + wc * 32 + 8 * fq;
#pragma unroll
        for (int ai = 0; ai < 2; ++ai)
#pragma unroll
            for (int m = 0; m < 4; ++m) { bf16_t* rowp = O + (size_t)(row0 + ai * HALF + m * 16) * ldc + col0;
                const f32x4 g0 = acc[ai][0][m][0], g1 = acc[ai][0][m][1], u0 = acc[ai][1][m][0], u1 = acc[ai][1][m][1];
                u32x4 w;
                w.x = cvt_pk_bf16(silu_f(g0[0]) * u0[0], silu_f(g0[1]) * u0[1]); w.y = cvt_pk_bf16(silu_f(g0[2]) * u0[2], silu_f(g0[3]) * u0[3]);
                w.z = cvt_pk_bf16(silu_f(g1[0]) * u1[0], silu_f(g1[1]) * u1[1]); w.w = cvt_pk_bf16(silu_f(g1[2]) * u1[2], silu_f(g1[3]) * u1[3]);
                *(u32x4*)rowp = w; }
    }
};
struct EpiStore {
    static constexpr bool PERM = true, AFTER_DRAIN = false;
    bf16_t* O; long ldc;
    __device__ __forceinline__ void operator()(const f32x4 (&acc)[2][2][4][2], const Unit& u, int wr, int wc, int fr, int fq) const {
        const int row0 = u.pm * BM + wr * 64 + fr, col0 = u.pn * BM + wc * 32 + 8 * fq;
#pragma unroll
        for (int ai = 0; ai < 2; ++ai)
#pragma unroll
            for (int m = 0; m < 4; ++m) { bf16_t* rowp = O + (size_t)(row0 + ai * HALF + m * 16) * ldc + col0;
#pragma unroll
                for (int bj = 0; bj < 2; ++bj) { const f32x4 v0 = acc[ai][bj][m][0], v1 = acc[ai][bj][m][1]; u32x4 w;
                    w.x = cvt_pk_bf16(v0[0], v0[1]); w.y = cvt_pk_bf16(v0[2], v0[3]); w.z = cvt_pk_bf16(v1[0], v1[1]); w.w = cvt_pk_bf16(v1[2], v1[3]);
                    *(u32x4*)(rowp + bj * HALF) = w; } }
    }
};
template <class Epi, class Sched, bool ALIGN_EPI = false, bool SP2 = false>
__device__ __forceinline__ void gemm_phase(PG8_LAS unsigned char* lds, const Gemm g, const Sched& S, const Epi& E) {
    const int tid = threadIdx.x, wid = __builtin_amdgcn_readfirstlane(tid >> 6), lane = tid & 63, wr = wid >> 2, wc = wid & 3, fr = lane & 15, fq = lane >> 4;
    const int K = g.K, nt = K / BK;
    unsigned voffA[2], voffB[2];
#pragma unroll
    for (int i = 0; i < 2; ++i) { int R, C; stage_rc(tid * 16 + i * 8192, R, C); const int Rb = Epi::PERM ? ((R & ~31) + perm32(R & 31)) : R;
        voffA[i] = (unsigned)(R * K + C) * 2u; voffB[i] = (unsigned)(Rb * K + C) * 2u; }
    const size_t kstep = (size_t)(BK * 2);
    const size_t hstep = (size_t)HALF * K * 2;
    const size_t tstep = 2 * hstep;
    const unsigned ldsw = (unsigned)wid * 1024u;
    const int aoff = lds_byte(wr * 64 + fr, fq * 8), boff = lds_byte(wc * 32 + fr, fq * 8);
#define PG8_SA(b, h) (((b) * 2 + (h)) * HTB)
#define PG8_SB(b, h) ((4 + (b) * 2 + (h)) * HTB)
#define PG8_STAGE(bufoff, gbase, voff) do { _Pragma("unroll") for (int _i = 0; _i < 2; ++_i) \
        __builtin_amdgcn_global_load_lds((const unsigned*)((const char*)(gbase) + (voff)[_i]), (PG8_LAS unsigned*)(lds + (bufoff) + ldsw + _i * 8192), 16, 0, 0); } while (0)
#define PG8_LDA(dst, b, h) do { _Pragma("unroll") for (int m = 0; m < 4; ++m) _Pragma("unroll") for (int k = 0; k < 2; ++k) dst[m][k] = *(const PG8_LAS bf16x8*)(lds + PG8_SA(b, h) + aoff + m * 2048 + k * 1024); } while (0)
#define PG8_LDB(dst, b, h) do { _Pragma("unroll") for (int n = 0; n < 2; ++n) _Pragma("unroll") for (int k = 0; k < 2; ++k) dst[n][k] = *(const PG8_LAS bf16x8*)(lds + PG8_SB(b, h) + boff + n * 2048 + k * 1024); } while (0)
#define PG8_MMA(ai, bj, At, Bt) do { __builtin_amdgcn_s_setprio(1); _Pragma("unroll") for (int m = 0; m < 4; ++m) _Pragma("unroll") for (int n = 0; n < 2; ++n) _Pragma("unroll") for (int k = 0; k < 2; ++k) \
        acc[ai][bj][m][n] = __builtin_amdgcn_mfma_f32_16x16x32_bf16(Bt[n][k], At[m][k], acc[ai][bj][m][n], 0, 0, 0); __builtin_amdgcn_s_setprio(0); } while (0)
#define PG8_WAIT_V(n) asm volatile("s_waitcnt vmcnt(" #n ")" ::: "memory")
#define PG8_WAIT_L(n) asm volatile("s_waitcnt lgkmcnt(" #n ")" ::: "memory")
#define PG8_BAR __builtin_amdgcn_s_barrier()
#define PG8_SCHED __builtin_amdgcn_sched_barrier(0)
    Unit cur, nxt; int ui = 0;
    if (!S.next(0, cur)) return;
    f32x4 acc[2][2][4][2];
#pragma unroll
    for (int a = 0; a < 2; ++a)
#pragma unroll
        for (int b = 0; b < 2; ++b)
#pragma unroll
            for (int m = 0; m < 4; ++m)
#pragma unroll
                for (int n = 0; n < 2; ++n) acc[a][b][m][n] = (f32x4){0.f, 0.f, 0.f, 0.f};
    bf16x8 At[4][2], B0[2][2], B1[2][2];
    const char* cA = (const char*)g.A + (size_t)cur.pm * tstep; const char* cB = (const char*)g.Bt + (size_t)cur.pn * tstep;
    S.a_ready(cur);
    if constexpr (SP2) {
        PG8_STAGE(PG8_SB(0, 0), cB, voffB); PG8_STAGE(PG8_SB(0, 1), cB + hstep, voffB); PG8_STAGE(PG8_SA(0, 0), cA, voffA); PG8_STAGE(PG8_SA(0, 1), cA + hstep, voffA);
        if (wr == 1) PG8_BAR;
        PG8_WAIT_V(2); PG8_BAR;
        PG8_STAGE(PG8_SB(1, 0), cB + kstep, voffB); PG8_STAGE(PG8_SA(1, 0), cA + kstep, voffA); PG8_STAGE(PG8_SB(1, 1), cB + hstep + kstep, voffB);
        PG8_WAIT_V(6); PG8_BAR;
    } else {
        PG8_STAGE(PG8_SB(0, 0), cB, voffB); PG8_STAGE(PG8_SA(0, 0), cA, voffA); PG8_STAGE(PG8_SB(0, 1), cB + hstep, voffB); PG8_STAGE(PG8_SA(0, 1), cA + hstep, voffA);
        if (wr == 1) PG8_BAR;
        PG8_WAIT_V(4); PG8_BAR;
        PG8_STAGE(PG8_SB(1, 0), cB + kstep, voffB); PG8_STAGE(PG8_SA(1, 0), cA + kstep, voffA); PG8_STAGE(PG8_SB(1, 1), cB + hstep + kstep, voffB);
        PG8_WAIT_V(6); PG8_BAR;
    }
    for (;;) {
        const bool has_next = S.next(ui + 1, nxt);
        const char* nA = has_next ? (const char*)g.A + (size_t)nxt.pm * tstep : cA; const char* nB = has_next ? (const char*)g.Bt + (size_t)nxt.pn * tstep : cB;
        for (int t = 0; t < nt; t += 2) {
            const bool last = (t == nt - 2);
            const char* a1 = cA + (size_t)(t + 1) * kstep;
            const char* a2 = last ? nA : cA + (size_t)(t + 2) * kstep; const char* b2 = last ? nB : cB + (size_t)(t + 2) * kstep;
            const char* a3 = a2 + kstep; const char* b3 = b2 + kstep;
            if (last && has_next) S.a_ready(nxt);
            if constexpr (SP2) {
            PG8_LDB(B0, 0, 0); PG8_LDB(B1, 0, 1); PG8_SCHED; PG8_LDA(At, 0, 0); PG8_STAGE(PG8_SA(1, 1), a1 + hstep, voffA);
            PG8_WAIT_V(8); PG8_WAIT_L(0); PG8_BAR; PG8_MMA(0, 0, At, B0); PG8_MMA(0, 1, At, B1); PG8_BAR; PG8_SCHED;
            PG8_LDA(At, 0, 1); PG8_STAGE(PG8_SB(0, 0), b2, voffB); PG8_STAGE(PG8_SB(0, 1), b2 + hstep, voffB); PG8_STAGE(PG8_SA(0, 0), a2, voffA);
            PG8_WAIT_V(8); PG8_WAIT_L(0); PG8_BAR; PG8_MMA(1, 0, At, B0); PG8_MMA(1, 1, At, B1); PG8_BAR; PG8_SCHED;
            PG8_LDB(B0, 1, 0); PG8_LDB(B1, 1, 1); PG8_SCHED; PG8_LDA(At, 1, 0); PG8_STAGE(PG8_SA(0, 1), a2 + hstep, voffA);
            PG8_WAIT_V(8); PG8_WAIT_L(0); PG8_BAR; PG8_MMA(0, 0, At, B0); PG8_MMA(0, 1, At, B1); PG8_BAR; PG8_SCHED;
            PG8_LDA(At, 1, 1); PG8_STAGE(PG8_SB(1, 0), b3, voffB); PG8_STAGE(PG8_SB(1, 1), b3 + hstep, voffB); PG8_STAGE(PG8_SA(1, 0), a3, voffA);
            PG8_WAIT_V(8); PG8_WAIT_L(0); PG8_BAR; PG8_MMA(1, 0, At, B0); PG8_MMA(1, 1, At, B1); PG8_BAR; PG8_SCHED;
            } else {
            PG8_LDB(B0, 0, 0); PG8_SCHED; PG8_LDA(At, 0, 0); PG8_STAGE(PG8_SA(1, 1), a1 + hstep, voffA);
            PG8_WAIT_L(8); PG8_BAR; PG8_WAIT_L(0); PG8_MMA(0, 0, At, B0); PG8_BAR; PG8_SCHED;
            PG8_LDB(B1, 0, 1); PG8_STAGE(PG8_SB(0, 0), b2, voffB);
            PG8_BAR; PG8_WAIT_L(0); PG8_MMA(0, 1, At, B1); PG8_BAR;
            PG8_LDA(At, 0, 1); PG8_STAGE(PG8_SA(0, 0), a2, voffA);
            PG8_BAR; PG8_WAIT_L(0); PG8_MMA(1, 0, At, B0); PG8_BAR; PG8_SCHED;
            PG8_STAGE(PG8_SB(0, 1), b2 + hstep, voffB);
            PG8_WAIT_V(6); PG8_BAR; PG8_MMA(1, 1, At, B1); PG8_BAR;
            PG8_LDB(B0, 1, 0); PG8_SCHED; PG8_LDA(At, 1, 0); PG8_STAGE(PG8_SA(0, 1), a2 + hstep, voffA);
            PG8_WAIT_L(8); PG8_BAR; PG8_WAIT_L(0); PG8_MMA(0, 0, At, B0); PG8_BAR; PG8_SCHED;
            PG8_LDB(B1, 1, 1); PG8_STAGE(PG8_SB(1, 0), b3, voffB);
            PG8_BAR; PG8_WAIT_L(0); PG8_MMA(0, 1, At, B1); PG8_BAR;
            PG8_LDA(At, 1, 1); PG8_STAGE(PG8_SA(1, 0), a3, voffA);
            PG8_BAR; PG8_WAIT_L(0); PG8_MMA(1, 0, At, B0); PG8_BAR; PG8_SCHED;
            PG8_STAGE(PG8_SB(1, 1), b3 + hstep, voffB);
            PG8_WAIT_V(6); PG8_BAR; PG8_MMA(1, 1, At, B1); PG8_BAR;
            }
        }
        if constexpr (ALIGN_EPI) { if (wr == 0) PG8_BAR; }
        if constexpr (!Epi::AFTER_DRAIN) { E(acc, cur, wr, wc, fr, fq); S.done(cur); }
        if (!has_next) break;
#pragma unroll
        for (int a = 0; a < 2; ++a)
#pragma unroll
            for (int b = 0; b < 2; ++b)
#pragma unroll
                for (int m = 0; m < 4; ++m)
#pragma unroll
                    for (int n = 0; n < 2; ++n) acc[a][b][m][n] = (f32x4){0.f, 0.f, 0.f, 0.f};
        cur = nxt; cA = nA; cB = nB; ++ui;
        if constexpr (ALIGN_EPI) { if (wr == 1) PG8_BAR; }
    }
    PG8_WAIT_V(0);
    if constexpr (!ALIGN_EPI) { if (wr == 0) PG8_BAR; }
    PG8_BAR;
    if constexpr (Epi::AFTER_DRAIN) { E.fused(acc, cur, wr, wc, fr, fq, lds, wid, lane); S.done(cur); }
#undef PG8_SA
#undef PG8_SB
#undef PG8_STAGE
#undef PG8_LDA
#undef PG8_LDB
#undef PG8_MMA
#undef PG8_WAIT_V
#undef PG8_WAIT_L
#undef PG8_BAR
#undef PG8_SCHED
}
}
#define GAS __attribute__((address_space(1)))
#define LAS __attribute__((address_space(3)))
typedef unsigned short bf16;
typedef unsigned v4u __attribute__((ext_vector_type(4)));
typedef float f32x4 __attribute__((ext_vector_type(4)));
typedef short bf16x8 __attribute__((ext_vector_type(8)));
typedef GAS unsigned gu32;
typedef GAS unsigned long long gu64;
#define RLX_AGENT __ATOMIC_RELAXED, __HIP_MEMORY_SCOPE_AGENT
#define LDS_WAIT() asm volatile("s_waitcnt lgkmcnt(0)" ::: "memory")
#define VM_WAIT() asm volatile("s_waitcnt vmcnt(0)" ::: "memory")
__device__ __forceinline__ unsigned long long rt() { return __builtin_amdgcn_s_memrealtime(); }
__device__ __forceinline__ unsigned f2bf(float f) { unsigned u = __builtin_bit_cast(unsigned, f); return (u + 0x7fffu + ((u >> 16) & 1u)) >> 16; }
__device__ __forceinline__ unsigned pk2(float lo, float hi) { return f2bf(lo) | (f2bf(hi) << 16); }

#define XB_TMO      128
#define XB_XCNT(j)  (256  + 64 * (j))
#define XB_XSUB(j)  (1280 + 64 * (j))
#define XB_XGEN(j)  (2304 + 64 * (j))
#define XB_TOP      3328
#define XB_TOPGEN   3392
#define XCD_BAR_WORDS 3456
#define XB_SPIN_CAP (1u << 18)

__device__ __forceinline__ unsigned xb_ld(unsigned* p)              { return __hip_atomic_load(p, __ATOMIC_RELAXED, __HIP_MEMORY_SCOPE_AGENT); }
__device__ __forceinline__ unsigned xb_add(unsigned* p, unsigned v) { return __hip_atomic_fetch_add(p, v, __ATOMIC_RELAXED, __HIP_MEMORY_SCOPE_AGENT); }
__device__ __forceinline__ unsigned xb_xcc_id() { return (unsigned)__builtin_amdgcn_s_getreg((3 << 11) | 20) & 0xFu; }
#define XB_SPIN(cond, bar) do { unsigned _sp = 0; while (cond) { __builtin_amdgcn_s_sleep(1); \
    if ((++_sp & 255u) == 0u) { if (xb_ld(&(bar)[XB_TMO])) break; if (_sp > XB_SPIN_CAP) { atomicAdd(&(bar)[XB_TMO], 1u); break; } } } } while (0)

struct XcdBarrier {
    unsigned* bar; unsigned x;
    volatile LAS unsigned* st;
};

__device__ __forceinline__ XcdBarrier xcd_barrier_post(unsigned* bar, volatile LAS unsigned* st) {
    XcdBarrier b; b.bar = bar; b.x = xb_xcc_id(); b.st = st;
    if (threadIdx.x == 0) (void)xb_add(&bar[XB_XCNT(b.x)], 1u);
    return b;
}
__device__ __forceinline__ void xcd_barrier_complete(unsigned* bar, unsigned x, unsigned& nloc, unsigned& nx) {
    const unsigned G = gridDim.x * gridDim.y * gridDim.z;
    unsigned sum, cnt, mine, sp = 0u;
    for (;;) {
        sum = 0u; cnt = 0u; mine = 0u;
#pragma unroll
        for (unsigned j = 0; j < 16; ++j) { const unsigned c = xb_ld(&bar[XB_XCNT(j)]); sum += c; cnt += (c > 0u) ? 1u : 0u; mine = (j == x) ? c : mine; }
        if (sum == G) break;
        __builtin_amdgcn_s_sleep(1);
        if ((++sp & 255u) == 0u) { if (xb_ld(&bar[XB_TMO])) break; if (sp > XB_SPIN_CAP) { atomicAdd(&bar[XB_TMO], 1u); break; } }
    }
    nloc = mine > 0u ? mine : 1u; nx = cnt > 0u ? cnt : 1u;
}

__device__ __forceinline__ void xcd_barrier(const XcdBarrier& b) {
    asm volatile("s_waitcnt vmcnt(0)" ::: "memory");
    __syncthreads();
    if (threadIdx.x == 0) {
        unsigned* bar = b.bar;
        __builtin_amdgcn_s_waitcnt(0);
        unsigned nloc = b.st[0], nx = b.st[1];
        if (nloc == 0u) { xcd_barrier_complete(bar, b.x, nloc, nx); b.st[0] = nloc; b.st[1] = nx; }
        const unsigned old = xb_add(&bar[XB_XSUB(b.x)], 1u);
        const unsigned gen = old / nloc;
        if (old + 1u == (gen + 1u) * nloc) {
            __builtin_amdgcn_fence(__ATOMIC_RELEASE, "agent");
            asm volatile("s_waitcnt vmcnt(0)" ::: "memory");
            const unsigned og = xb_add(&bar[XB_TOP], 1u);
            const unsigned tg = og / nx;
            if (og + 1u == (tg + 1u) * nx) xb_add(&bar[XB_TOPGEN], 1u);
            else XB_SPIN(xb_ld(&bar[XB_TOPGEN]) == tg, bar);
            __builtin_amdgcn_fence(__ATOMIC_ACQUIRE, "agent");
            xb_add(&bar[XB_XGEN(b.x)], 1u);
            asm volatile("s_waitcnt vmcnt(0)" ::: "memory");
        } else {
            XB_SPIN(xb_ld(&bar[XB_XGEN(b.x)]) == gen, bar);
            __builtin_amdgcn_fence(__ATOMIC_ACQUIRE, "agent");
            asm volatile("s_waitcnt vmcnt(0)" ::: "memory");
        }
    }
    __syncthreads();
}
constexpr int NB = 8, SEQ = 4096, DM = 1024, MTOK = NB * SEQ;
constexpr int EVEN_IN = 2560, ODD_IN = 3072, FFD = 2816, FFE = 3584, NEXP = 8;
constexpr float EPS = 1e-6f;
constexpr size_t MiB = 1u << 20;
constexpr size_t WS_CTL = 0, CTL_ZERO_BYTES = 1 * MiB;
constexpr size_t WS_MOD = 1 * MiB;
constexpr size_t WS_GATES = 2 * MiB;
constexpr size_t WS_WIN0 = 4 * MiB, WS_WOUT0 = 9 * MiB, WS_WGU0 = 11 * MiB, WS_WD0 = 22 * MiB, WS_WIN1 = 28 * MiB, WS_WOUT1 = 34 * MiB;
constexpr size_t WS_WMOE = 40 * MiB, WMOE_STRIDE = 21 * MiB, WMOE_D_OFF = 14 * MiB;
constexpr size_t WS_H = 208 * MiB;
constexpr size_t WS_PROJ = 272 * MiB;
constexpr size_t WS_MIX = 464 * MiB;
constexpr size_t WS_ACT = 272 * MiB;
constexpr size_t WS_END = 528 * MiB;

__device__ __forceinline__ float bf2f(bf16 v) { return __builtin_bit_cast(float, (unsigned)v << 16); }
__device__ __forceinline__ float wave_sum(float v) {
#pragma unroll
    for (int o = 1; o < 64; o <<= 1) v += __shfl_xor(v, o);
    return v;
}
__device__ __forceinline__ float logsig_f(float z) { return fminf(z, 0.f) - log1pf(expf(-fabsf(z))); }
__device__ __forceinline__ float sigmoid_f(float z) { return 1.0f / (1.0f + expf(-z)); }
__device__ __forceinline__ float gelu_tanh_f(float x) { const float t = tanhf(0.7978845608028654f * (x + 0.044715f * x * x * x)); return 0.5f * x * (1.0f + t); }

__device__ __forceinline__ void transpose_item(const float* W, int N, int k0, int n0, bf16* dst  , int ldk, LAS float* scr, int lane) {
#pragma unroll 8
    for (int i = 0; i < 32; ++i) { const int kk = 2 * i + (lane >> 5); scr[kk * 33 + (lane & 31)] = W[(size_t)(k0 + kk) * N + n0 + (lane & 31)]; }
    LDS_WAIT(); asm volatile("" ::: "memory");
    const int c = lane & 7;
#pragma unroll
    for (int j = 0; j < 4; ++j) { const int n = (lane >> 3) + 8 * j; const LAS float* s = scr + (8 * c) * 33 + n;
        v4u o; o.x = pk2(s[0 * 33], s[1 * 33]); o.y = pk2(s[2 * 33], s[3 * 33]); o.z = pk2(s[4 * 33], s[5 * 33]); o.w = pk2(s[6 * 33], s[7 * 33]);
        *(GAS v4u*)(dst + (size_t)n * ldk + k0 + 8 * c) = o; }
    LDS_WAIT(); asm volatile("" ::: "memory");
}
__device__ __forceinline__ bool tr_plain(int& r, const float* W, int K, int N, bf16* Wt, LAS float* scr, int lane) {
    const int nblk = N / 32, items = (K / 64) * nblk;
    if (r >= items) { r -= items; return false; }
    const int kb = r / nblk, nb = r % nblk;
    transpose_item(W, N, 64 * kb, 32 * nb, Wt + (size_t)(32 * nb) * K, K, scr, lane); return true;
}
__device__ __forceinline__ bool tr_gu(int& r, const float* Wg, const float* Wu, int K, int F, bf16* Wt, LAS float* scr, int lane) {
    const int nblk = F / 32, items = (K / 64) * nblk;
    if (r >= 2 * items) { r -= 2 * items; return false; }
    const int up = r >= items ? 1 : 0; const int q = r - up * items; const int kb = q / nblk, nb = q % nblk, n0 = 32 * nb;
    transpose_item(up ? Wu : Wg, F, 64 * kb, n0, Wt + (size_t)(256 * (n0 / 128) + 128 * up + (n0 % 128)) * K, K, scr, lane); return true;
}
struct ProArgs { const float* c; const float* ada_w; const float* ada_b; const float* w_in0; const float* w_out0; const float* wg0; const float* wu0; const float* wd0; const float* w_in1; const float* w_out1;
                 const float* mg; const float* mu; const float* md; unsigned char* ws; };
__global__ void __launch_bounds__(512, 2) k_prologue(ProArgs a) {
    extern __shared__ __attribute__((aligned(16))) unsigned char lds[];
    LAS unsigned char* L = (LAS unsigned char*)lds;
    const int tid = threadIdx.x, lane = tid & 63, wave = tid >> 6;
    const int gw = blockIdx.x * 8 + wave, NGW = gridDim.x * 8;
    LAS float* cond = (LAS float*)L;
    for (int i = tid; i < NB * DM; i += 512) { const float c = a.c[i]; cond[i] = c / (1.0f + expf(-c)); }
    __syncthreads();
    float* mod = (float*)(a.ws + WS_MOD);
    for (int it = gw; it < 768; it += NGW) {
        const int layer = it / 384, j0 = (it % 384) * 16, cj = lane & 15, kp = lane >> 4;
        float acc[NB];
#pragma unroll
        for (int b = 0; b < NB; ++b) acc[b] = 0.f;
        const float* wp = a.ada_w + (size_t)layer * DM * 6144 + j0 + cj;
#pragma unroll 4
        for (int k = kp; k < DM; k += 4) { const float w = wp[(size_t)k * 6144];
#pragma unroll
            for (int b = 0; b < NB; ++b) acc[b] += cond[b * DM + k] * w; }
#pragma unroll
        for (int b = 0; b < NB; ++b) { acc[b] += __shfl_xor(acc[b], 16); acc[b] += __shfl_xor(acc[b], 32); }
        if (kp == 0) {
            const float bias = a.ada_b[layer * 6144 + j0 + cj];
#pragma unroll
            for (int b = 0; b < NB; ++b) mod[(size_t)(layer * NB + b) * 6144 + j0 + cj] = acc[b] + bias; }
    }
    __syncthreads();
    LAS float* scr = (LAS float*)(L + wave * 16384);
    constexpr int ITEMS_MOE_E = 3 * (DM / 64) * (FFE / 32);
    constexpr int ITEMS_FIX = (DM / 64) * (EVEN_IN / 32) + (DM / 64) * (DM / 32) + 2 * (DM / 64) * (FFD / 32) + (FFD / 64) * (DM / 32) + (DM / 64) * (ODD_IN / 32) + (DM / 64) * (DM / 32);
    constexpr int NITEMS = ITEMS_FIX + NEXP * ITEMS_MOE_E;
    for (int it = gw; it < NITEMS; it += NGW) {
        int r = it;
        if (tr_plain(r, a.w_in0, DM, EVEN_IN, (bf16*)(a.ws + WS_WIN0), scr, lane)) continue;
        if (tr_plain(r, a.w_out0, DM, DM, (bf16*)(a.ws + WS_WOUT0), scr, lane)) continue;
        if (tr_gu(r, a.wg0, a.wu0, DM, FFD, (bf16*)(a.ws + WS_WGU0), scr, lane)) continue;
        if (tr_plain(r, a.wd0, FFD, DM, (bf16*)(a.ws + WS_WD0), scr, lane)) continue;
        if (tr_plain(r, a.w_in1, DM, ODD_IN, (bf16*)(a.ws + WS_WIN1), scr, lane)) continue;
        if (tr_plain(r, a.w_out1, DM, DM, (bf16*)(a.ws + WS_WOUT1), scr, lane)) continue;
        const int e = r / ITEMS_MOE_E; r -= e * ITEMS_MOE_E;
        unsigned char* we = a.ws + WS_WMOE + (size_t)e * WMOE_STRIDE;
        if (tr_gu(r, a.mg + (size_t)e * DM * FFE, a.mu + (size_t)e * DM * FFE, DM, FFE, (bf16*)we, scr, lane)) continue;
        tr_plain(r, a.md + (size_t)e * FFE * DM, FFE, DM, (bf16*)(we + WMOE_D_OFF), scr, lane);
    }
}

__global__ void __launch_bounds__(512, 2) k_norm_mod(const float* X, bf16* H, const float* ln, const float* modl, int sh_off, int sc_off) {
    const int tid = threadIdx.x, lane = tid & 63, wave = tid >> 6;
    const int gw = blockIdx.x * 8 + wave, NGW = gridDim.x * 8;
    for (int m = gw; m < MTOK; m += NGW) {
        const int b = m / SEQ;
        const GAS f32x4* xr = (const GAS f32x4*)(X + (size_t)m * DM) + lane;
        f32x4 v[4]; float ss = 0.f;
#pragma unroll
        for (int j = 0; j < 4; ++j) { v[j] = xr[64 * j]; ss += (v[j].x * v[j].x + v[j].y * v[j].y) + (v[j].z * v[j].z + v[j].w * v[j].w); }
        const float rstd = 1.0f / sqrtf(wave_sum(ss) * (1.f / DM) + EPS);
        GAS unsigned long long* o8 = (GAS unsigned long long*)(H + (size_t)m * DM) + lane;
#pragma unroll
        for (int j = 0; j < 4; ++j) { const int col = 4 * lane + 256 * j;
            const f32x4 g = *(const f32x4*)(ln + col), sc = *(const f32x4*)(modl + (size_t)b * 6144 + sc_off + col), sh = *(const f32x4*)(modl + (size_t)b * 6144 + sh_off + col);
            const f32x4 h = v[j] * rstd * g * (sc + 1.0f) + sh;
            o8[64 * j] = (unsigned long long)pk2(h.x, h.y) | ((unsigned long long)pk2(h.z, h.w) << 32); }
    }
}
__global__ void __launch_bounds__(512, 2) k_norm_router(const float* X, bf16* H, const float* ln, const float* modl, int sh_off, int sc_off, const float* rw, const float* rb, float* gates) {
    extern __shared__ __attribute__((aligned(16))) unsigned char lds[];
    LAS float* rws = (LAS float*)lds;
    const int tid = threadIdx.x, lane = tid & 63, wave = tid >> 6;
    for (int i = tid; i < DM * NEXP; i += 512) rws[i] = rw[i];
    __syncthreads();
    const int gw = blockIdx.x * 8 + wave, NGW = gridDim.x * 8;
    for (int m = gw; m < MTOK; m += NGW) {
        const int b = m / SEQ;
        const GAS f32x4* xr = (const GAS f32x4*)(X + (size_t)m * DM) + lane;
        f32x4 v[4]; float ss = 0.f;
#pragma unroll
        for (int j = 0; j < 4; ++j) { v[j] = xr[64 * j]; ss += (v[j].x * v[j].x + v[j].y * v[j].y) + (v[j].z * v[j].z + v[j].w * v[j].w); }
        const float rstd = 1.0f / sqrtf(wave_sum(ss) * (1.f / DM) + EPS);
        GAS unsigned long long* o8 = (GAS unsigned long long*)(H + (size_t)m * DM) + lane;
        float lg[NEXP];
#pragma unroll
        for (int e = 0; e < NEXP; ++e) lg[e] = 0.f;
#pragma unroll
        for (int j = 0; j < 4; ++j) { const int col = 4 * lane + 256 * j;
            const f32x4 g = *(const f32x4*)(ln + col), sc = *(const f32x4*)(modl + (size_t)b * 6144 + sc_off + col), sh = *(const f32x4*)(modl + (size_t)b * 6144 + sh_off + col);
            const f32x4 h = v[j] * rstd * g * (sc + 1.0f) + sh;
            o8[64 * j] = (unsigned long long)pk2(h.x, h.y) | ((unsigned long long)pk2(h.z, h.w) << 32);
#pragma unroll
            for (int q = 0; q < 4; ++q) { const f32x4 w0 = *(const LAS f32x4*)(rws + (col + q) * 8), w1 = *(const LAS f32x4*)(rws + (col + q) * 8 + 4); const float hv = h[q];
                lg[0] += hv * w0.x; lg[1] += hv * w0.y; lg[2] += hv * w0.z; lg[3] += hv * w0.w; lg[4] += hv * w1.x; lg[5] += hv * w1.y; lg[6] += hv * w1.z; lg[7] += hv * w1.w; } }
#pragma unroll
        for (int e = 0; e < NEXP; ++e) lg[e] = wave_sum(lg[e]) + rb[e];
        int i0 = 0; float v0 = lg[0];
#pragma unroll
        for (int e = 1; e < NEXP; ++e) if (lg[e] > v0) { v0 = lg[e]; i0 = e; }
        int i1 = -1; float v1 = -INFINITY;
#pragma unroll
        for (int e = 0; e < NEXP; ++e) if (e != i0 && lg[e] > v1) { v1 = lg[e]; i1 = e; }
        const float w0 = 1.0f / (1.0f + expf(v1 - v0)), w1 = 1.0f - w0;
        if (lane < NEXP) gates[(size_t)m * NEXP + lane] = (lane == i0) ? w0 : ((lane == i1) ? w1 : 0.f);
    }
}
__global__ void __launch_bounds__(512, 2) k_final(const float* X, float* O, const float* ln) {
    const int tid = threadIdx.x, lane = tid & 63, wave = tid >> 6;
    const int gw = blockIdx.x * 8 + wave, NGW = gridDim.x * 8;
    for (int m = gw; m < MTOK; m += NGW) {
        const GAS f32x4* xr = (const GAS f32x4*)(X + (size_t)m * DM) + lane;
        f32x4 v[4]; float ss = 0.f;
#pragma unroll
        for (int j = 0; j < 4; ++j) { v[j] = xr[64 * j]; ss += (v[j].x * v[j].x + v[j].y * v[j].y) + (v[j].z * v[j].z + v[j].w * v[j].w); }
        const float rstd = 1.0f / sqrtf(wave_sum(ss) * (1.f / DM) + EPS);
        GAS f32x4* orow = (GAS f32x4*)(O + (size_t)m * DM) + lane;
#pragma unroll
        for (int j = 0; j < 4; ++j) { const f32x4 g = *(const f32x4*)(ln + 4 * lane + 256 * j); orow[64 * j] = v[j] * rstd * g; }
    }
}

__global__ void __launch_bounds__(256) k_sb_naive(const bf16* proj, bf16* mix) {
    const int w = blockIdx.x * 4 + (threadIdx.x >> 6), lane = threadIdx.x & 63;
    const int t = w % SEQ, bh = w / SEQ, h = bh % 8, b = bh / 8;
    const size_t row = (size_t)b * SEQ + t;
    const float q = bf2f(proj[row * EVEN_IN + h * 64 + lane]);
    float acc = 0.f, later = 0.f;
    for (int s = t - 1; s >= 0; --s) {
        const size_t kr = ((size_t)b * SEQ + s) * EVEN_IN;
        const float kk = bf2f(proj[kr + 512 + h * 64 + lane]), vv = bf2f(proj[kr + 1024 + h * 64 + lane]);
        const float z = wave_sum(q * kk) * 0.125f;
        const float lp = logsig_f(z), ln_ = lp - z;
        acc += expf(lp + later) * vv; later += ln_;
        if (later < -110.f) break;
    }
    mix[row * DM + h * 64 + lane] = (bf16)f2bf(acc);
}
__global__ void __launch_bounds__(64) k_lru_naive(const bf16* proj, bf16* mix, const float* conv_w, const float* conv_b, const float* ga_w, const float* ga_b, const float* gx_w, const float* gx_b, const float* lam) {
    __shared__ float wa[64 * 64], wx[64 * 64], xcs[64];
    const int b = blockIdx.x / 8, g = blockIdx.x % 8, j = threadIdx.x, c = g * 64 + j;
    for (int i = j; i < 4096; i += 64) { wa[i] = ga_w[g * 4096 + i]; wx[i] = gx_w[g * 4096 + i]; }
    const float cw0 = conv_w[c], cw1 = conv_w[512 + c], cw2 = conv_w[1024 + c], cw3 = conv_w[1536 + c], cb = conv_b[c], ba = ga_b[c], bx = gx_b[c], lsl = logsig_f(lam[c]);
    float x1 = 0.f, x2 = 0.f, x3 = 0.f, hs = 0.f;
    __syncthreads();
    for (int t = 0; t < SEQ; ++t) {
        const size_t row = (size_t)b * SEQ + t;
        const float xb = bf2f(proj[row * EVEN_IN + 1536 + c]), gb = bf2f(proj[row * EVEN_IN + 2048 + c]);
        const float xc = cw0 * x3 + cw1 * x2 + cw2 * x1 + cw3 * xb + cb; x3 = x2; x2 = x1; x1 = xb;
        xcs[j] = xc; __syncthreads();
        float ra = ba, rx = bx;
#pragma unroll 8
        for (int i = 0; i < 64; ++i) { const float xi = xcs[i]; ra += xi * wa[i * 64 + j]; rx += xi * wx[i * 64 + j]; }
        __syncthreads();
        const float r = sigmoid_f(ra), ig = sigmoid_f(rx), log_a = 8.0f * r * lsl, aa = expf(log_a), u = sqrtf(-expm1f(2.0f * log_a)) * (ig * xc);
        hs = aa * hs + u;
        mix[row * DM + 512 + c] = (bf16)f2bf(hs * gelu_tanh_f(gb));
    }
}
__global__ void __launch_bounds__(256) k_diff_naive(const bf16* proj, bf16* o, const float* rel_bias, const float* lq1, const float* lk1, const float* lq2, const float* lk2, const float* subln, float lambda_init) {
    __shared__ float lut[129]; __shared__ float lam_s;
    const int tile = blockIdx.x % 64, bh = blockIdx.x / 64, h = bh % 8, b = bh / 8;
    const int qi = threadIdx.x >> 2, part = threadIdx.x & 3, t = tile * 64 + qi;
    if (threadIdx.x < 129) { const int n = threadIdx.x; int bk;
        if (n < 16) bk = n; else bk = 16 + (n >= 19) + (n >= 21) + (n >= 24) + (n >= 27) + (n >= 31) + (n >= 35) + (n >= 40) + (n >= 46) + (n >= 52) + (n >= 59) + (n >= 67) + (n >= 77) + (n >= 87) + (n >= 99) + (n >= 113);
        lut[n] = rel_bias[bk * 8 + h]; }
    if (threadIdx.x == 0) { float s1 = 0.f, s2 = 0.f; for (int i = 0; i < 64; ++i) { s1 += lq1[i] * lk1[i]; s2 += lq2[i] * lk2[i]; } lam_s = expf(s1) - expf(s2) + lambda_init; }
    __syncthreads();
    const float lam = lam_s;
    const size_t row = (size_t)b * SEQ + t;
    float q1[16], q2[16], a1[32], a2[32];
#pragma unroll
    for (int i = 0; i < 16; ++i) { q1[i] = bf2f(proj[row * ODD_IN + (2 * h) * 64 + part * 16 + i]); q2[i] = bf2f(proj[row * ODD_IN + (2 * h + 1) * 64 + part * 16 + i]); }
#pragma unroll
    for (int i = 0; i < 32; ++i) { a1[i] = 0.f; a2[i] = 0.f; }
    float m1 = -INFINITY, m2 = -INFINITY, l1 = 0.f, l2 = 0.f;
    const int tmax = tile * 64 + 63;
    for (int s = 0; s <= tmax; ++s) {
        const bf16* kr = proj + ((size_t)b * SEQ + s) * ODD_IN;
        const bf16x8 ka = *(const bf16x8*)(kr + 1024 + (2 * h) * 64 + part * 16), kb = *(const bf16x8*)(kr + 1024 + (2 * h) * 64 + part * 16 + 8);
        const bf16x8 kc = *(const bf16x8*)(kr + 1024 + (2 * h + 1) * 64 + part * 16), kd = *(const bf16x8*)(kr + 1024 + (2 * h + 1) * 64 + part * 16 + 8);
        float d1 = 0.f, d2 = 0.f;
#pragma unroll
        for (int i = 0; i < 8; ++i) { d1 += q1[i] * bf2f((bf16)ka[i]) + q1[8 + i] * bf2f((bf16)kb[i]); d2 += q2[i] * bf2f((bf16)kc[i]) + q2[8 + i] * bf2f((bf16)kd[i]); }
        d1 += __shfl_xor(d1, 1); d1 += __shfl_xor(d1, 2); d2 += __shfl_xor(d2, 1); d2 += __shfl_xor(d2, 2);
        if (s <= t) {
            const int rel = t - s; const float bias = lut[rel > 128 ? 128 : rel];
            const float z1 = d1 * 0.125f + bias, z2 = d2 * 0.125f + bias;
            const float n1 = fmaxf(m1, z1), n2 = fmaxf(m2, z2);
            const float s1 = expf(m1 - n1), s2 = expf(m2 - n2), p1 = expf(z1 - n1), p2 = expf(z2 - n2);
            l1 = l1 * s1 + p1; l2 = l2 * s2 + p2; m1 = n1; m2 = n2;
            const bf16* vr = kr + 2048 + h * 128 + part * 32;
#pragma unroll
            for (int c8 = 0; c8 < 4; ++c8) { const bf16x8 vv = *(const bf16x8*)(vr + 8 * c8);
#pragma unroll
                for (int i = 0; i < 8; ++i) { const float vf = bf2f((bf16)vv[i]); a1[8 * c8 + i] = a1[8 * c8 + i] * s1 + p1 * vf; a2[8 * c8 + i] = a2[8 * c8 + i] * s2 + p2 * vf; } }
        }
    }
    const float r1 = 1.0f / l1, r2 = lam / l2; float ss = 0.f;
#pragma unroll
    for (int i = 0; i < 32; ++i) { a1[i] = a1[i] * r1 - a2[i] * r2; ss += a1[i] * a1[i]; }
    ss += __shfl_xor(ss, 1); ss += __shfl_xor(ss, 2);
    const float rstd = 1.0f / sqrtf(ss * (1.0f / 128.0f) + EPS) * (1.0f - lambda_init);
    bf16* op = o + row * DM + h * 128 + part * 32;
#pragma unroll
    for (int i = 0; i < 32; i += 2) *(unsigned*)(op + i) = pk2(a1[i] * rstd * subln[part * 32 + i], a1[i + 1] * rstd * subln[part * 32 + i + 1]);
}

template <class Epi> __global__ void __launch_bounds__(512, 2) k_gemm(pg8::Gemm g, Epi E) {
    extern __shared__ __attribute__((aligned(16))) unsigned char lds[];
    pg8::StaticOrder S; S.init(g.M, g.N, (int)gridDim.x, (int)blockIdx.x);
    pg8::gemm_phase<Epi, pg8::StaticOrder, true, true>((LAS unsigned char*)lds, g, S, E);
}
constexpr int GEMM_LDS = 131072;
template <class Epi> static void launch_gemm(const bf16* A, const bf16* Bt, int M, int N, int K, const Epi& E, int grid, hipStream_t st) {
    static bool attr = false;
    if (!attr) { (void)hipFuncSetAttribute((const void*)k_gemm<Epi>, hipFuncAttributeMaxDynamicSharedMemorySize, GEMM_LDS); attr = true; }
    pg8::Gemm g{A, Bt, M, N, K};
    hipLaunchKernelGGL(k_gemm<Epi>, dim3(grid), dim3(512), GEMM_LDS, st, g, E);
}

extern "C" void kernel_launch(void* const* d_in, const int* in_sizes, int n_in, void* d_out, int out_size, void* d_ws, size_t ws_size, hipStream_t stream) {
    static int grid = 0;
    if (grid == 0) {
        int dev = 0, cus = 0;
        if (hipGetDevice(&dev) != hipSuccess || hipDeviceGetAttribute(&cus, hipDeviceAttributeMultiprocessorCount, dev) != hipSuccess) { grid = -1; return; }
        if (n_in != 32 || ws_size < WS_END) { fprintf(stderr, "kernel_launch: unexpected n_in %d / ws %zu\n", n_in, ws_size); grid = -1; return; }
        (void)hipFuncSetAttribute((const void*)k_prologue, hipFuncAttributeMaxDynamicSharedMemorySize, GEMM_LDS);
        grid = cus;
    }
    if (grid < 0) return;
    const float* const* in = (const float* const*)d_in;
    unsigned char* ws = (unsigned char*)d_ws;
    float* xo = (float*)d_out;
    float* mod = (float*)(ws + WS_MOD);
    bf16* H = (bf16*)(ws + WS_H); bf16* PROJ = (bf16*)(ws + WS_PROJ); bf16* MIX = (bf16*)(ws + WS_MIX); bf16* ACT = (bf16*)(ws + WS_ACT);
    float* gates = (float*)(ws + WS_GATES);
    (void)hipMemsetAsync(ws + WS_CTL, 0, CTL_ZERO_BYTES, stream);
    ProArgs pa{}; pa.c = in[1]; pa.ada_w = in[3]; pa.ada_b = in[4]; pa.w_in0 = in[8]; pa.w_out0 = in[9]; pa.wg0 = in[17]; pa.wu0 = in[18]; pa.wd0 = in[19]; pa.w_in1 = in[20]; pa.w_out1 = in[21];
    pa.mg = in[29]; pa.mu = in[30]; pa.md = in[31]; pa.ws = ws;
    hipLaunchKernelGGL(k_prologue, dim3(grid), dim3(512), GEMM_LDS, stream, pa);
    const float* mod0 = mod; const float* mod1 = mod + (size_t)NB * 6144;
    hipLaunchKernelGGL(k_norm_mod, dim3(grid), dim3(512), 0, stream, in[0], H, in[5], mod0, 0, 1024);
    { pg8::EpiStore E{}; E.O = PROJ; E.ldc = EVEN_IN;
      launch_gemm(H, (const bf16*)(ws + WS_WIN0), MTOK, EVEN_IN, DM, E, grid, stream); }
    hipLaunchKernelGGL(k_sb_naive, dim3(NB * 8 * SEQ / 4), dim3(256), 0, stream, (const bf16*)PROJ, MIX);
    hipLaunchKernelGGL(k_lru_naive, dim3(NB * 8), dim3(64), 0, stream, (const bf16*)PROJ, MIX, in[10], in[11], in[12], in[13], in[14], in[15], in[16]);
    { pg8::EpiResid E{}; E.xin = in[0]; E.xout = xo; E.gate = mod0 + 2048; E.rowgate = nullptr; E.gate_ld = 6144; E.rows_per_batch = SEQ; E.ldc = DM; E.rg_ld = 0;
      launch_gemm(MIX, (const bf16*)(ws + WS_WOUT0), MTOK, DM, DM, E, grid, stream); }
    hipLaunchKernelGGL(k_norm_mod, dim3(grid), dim3(512), 0, stream, (const float*)xo, H, in[6], mod0, 3072, 4096);
    { pg8::EpiSwiglu E{}; E.O = ACT; E.ldc = FFD; E.pad = 0;
      launch_gemm(H, (const bf16*)(ws + WS_WGU0), MTOK, 2 * FFD, DM, E, grid, stream); }
    { pg8::EpiResid E{}; E.xin = xo; E.xout = xo; E.gate = mod0 + 5120; E.rowgate = nullptr; E.gate_ld = 6144; E.rows_per_batch = SEQ; E.ldc = DM; E.rg_ld = 0;
      launch_gemm(ACT, (const bf16*)(ws + WS_WD0), MTOK, DM, FFD, E, grid, stream); }
    hipLaunchKernelGGL(k_norm_mod, dim3(grid), dim3(512), 0, stream, (const float*)xo, H, in[5] + DM, mod1, 0, 1024);
    { pg8::EpiStore E{}; E.O = PROJ; E.ldc = ODD_IN;
      launch_gemm(H, (const bf16*)(ws + WS_WIN1), MTOK, ODD_IN, DM, E, grid, stream); }
    const float lambda_init = (float)(0.8 - 0.6 * exp(-0.3 * 1.0));
    hipLaunchKernelGGL(k_diff_naive, dim3(NB * 8 * 64), dim3(256), 0, stream, (const bf16*)PROJ, MIX, in[2], in[22], in[23], in[24], in[25], in[26], lambda_init);
    { pg8::EpiResid E{}; E.xin = xo; E.xout = xo; E.gate = mod1 + 2048; E.rowgate = nullptr; E.gate_ld = 6144; E.rows_per_batch = SEQ; E.ldc = DM; E.rg_ld = 0;
      launch_gemm(MIX, (const bf16*)(ws + WS_WOUT1), MTOK, DM, DM, E, grid, stream); }
    static bool rattr = false; if (!rattr) { (void)hipFuncSetAttribute((const void*)k_norm_router, hipFuncAttributeMaxDynamicSharedMemorySize, 32768); rattr = true; }
    hipLaunchKernelGGL(k_norm_router, dim3(grid), dim3(512), 32768, stream, (const float*)xo, H, in[6] + DM, mod1, 3072, 4096, in[27], in[28], gates);
    for (int e = 0; e < NEXP; ++e) {
        const unsigned char* we = ws + WS_WMOE + (size_t)e * WMOE_STRIDE;
        { pg8::EpiSwiglu E{}; E.O = ACT; E.ldc = FFE; E.pad = 0;
          launch_gemm(H, (const bf16*)we, MTOK, 2 * FFE, DM, E, grid, stream); }
        { pg8::EpiResid E{}; E.xin = xo; E.xout = xo; E.gate = mod1 + 5120; E.rowgate = gates + e; E.gate_ld = 6144; E.rows_per_batch = SEQ; E.ldc = DM; E.rg_ld = NEXP;
          launch_gemm(ACT, (const bf16*)(we + WMOE_D_OFF), MTOK, DM, FFE, E, grid, stream); }
    }
    hipLaunchKernelGGL(k_final, dim3(grid), dim3(512), 0, stream, (const float*)xo, xo, in[7]);
}
```

```cpp
#include <hip/hip_runtime.h>
#include <cstdio>
#include <cstdint>
#include <cmath>
namespace pg8 {
#define PG8_LAS __attribute__((address_space(3)))
typedef unsigned short bf16_t;
typedef short bf16x8 __attribute__((ext_vector_type(8)));
typedef float f32x4 __attribute__((ext_vector_type(4)));
typedef unsigned u32x4 __attribute__((ext_vector_type(4)));
constexpr int BM = 256, BK = 64, HALF = 128, HTB = HALF * BK * 2  , STAGE_BYTES = 8 * HTB, NXCD = 8, WGM = 8;

__host__ __device__ __forceinline__ int lds_byte(int r, int c) { const int st = (r >> 4) * 2 + (c >> 5), rr = r & 15, cc = c & 31, ob = rr * 64 + cc * 2; return st * 1024 + (ob ^ (((ob >> 9) & 1) << 5)); }
__host__ __device__ __forceinline__ void stage_rc(int b, int& R, int& C) { const int st = b / 1024, sb = b % 1024, swz = sb ^ (((sb >> 9) & 1) << 5); R = (st >> 1) * 16 + swz / 64; C = (st & 1) * 32 + (swz % 64) / 2; }
__host__ __device__ __forceinline__ int perm32(int rho) { const int n = rho >> 4, i = rho & 15; return 8 * (i >> 2) + 4 * n + (i & 3); }

struct Unit { int pm, pn; };
struct Gemm { const bf16_t* A; const bf16_t* Bt; int M, N, K, pad; };

struct StaticOrder {
    int nM, nN, nwg, G, c;
    __host__ __device__ void init(int M, int N, int G_, int c_) { nM = M / BM; nN = N / BM; nwg = nM * nN; G = G_; c = c_; }
    __host__ __device__ bool next(int i, Unit& u) const {
        const long L = (long)i * G + c; if (L >= nwg) return false;
        int wgid = (int)L; { const int q = nwg / NXCD, r = nwg % NXCD, xcd = wgid % NXCD, off = wgid / NXCD; wgid = (xcd < r ? xcd * (q + 1) : r * (q + 1) + (xcd - r) * q) + off; }
        const int nig = WGM * nN, gid = wgid / nig, fm = gid * WGM, gsz = (nM - fm) < WGM ? (nM - fm) : WGM;
        u.pm = fm + ((wgid % nig) % gsz); u.pn = (wgid % nig) / gsz; return true;
    }
    __device__ __forceinline__ void a_ready(const Unit&) const {}
    __device__ __forceinline__ void done(const Unit&) const {}
};

__device__ __forceinline__ unsigned cvt_pk_bf16(float lo, float hi) { typedef float f2_ __attribute__((ext_vector_type(2))); typedef __bf16 b2_ __attribute__((ext_vector_type(2))); const f2_ v = {lo, hi}; const b2_ b = __builtin_convertvector(v, b2_); return __builtin_bit_cast(unsigned, b); }
typedef float f32x2 __attribute__((ext_vector_type(2)));
__device__ __forceinline__ f32x2 gelu_pk(f32x2 v) {
    const f32x2 av = __builtin_elementwise_abs(v), d = av * 0.2316418882f + 1.0f;
    f32x2 t; t.x = __builtin_amdgcn_rcpf(d.x); t.y = __builtin_amdgcn_rcpf(d.y);
    f32x2 q = t * 0.5307027145f + (-0.7265760135f); q = q * t + 0.7107068705f; q = q * t + (-0.142248368f); q = q * t + 0.127414796f; q = q * t;
    const f32x2 s = (v * v) * (-0.72134752044f);
    f32x2 e; e.x = __builtin_amdgcn_exp2f(s.x); e.y = __builtin_amdgcn_exp2f(s.y);
    const f32x2 m = v * (q * e), r = v - m;
    f32x2 o; o.x = v.x < 0.f ? m.x : r.x; o.y = v.y < 0.f ? m.y : r.y; return o;
}

template <int ACT  > struct EpiBf16 {
    static constexpr bool PERM = true, AFTER_DRAIN = false; static_assert(ACT == 0 || ACT == 1, "EpiBf16: ACT is 0 (none) or 1 (gelu_pk)");
    bf16_t* O; int ldc; const float* bias; int split_cols; size_t split_stride; float scale0;
    __device__ __forceinline__ void operator()(const f32x4 (&acc)[2][2][4][2], const Unit& u, int wr, int wc, int fr, int fq) const {
        const int row0 = u.pm * BM + wr * 64 + fr; int colt = u.pn * BM; bf16_t* base = O;
        float sc = 1.f; if (split_cols) { const int t = colt / split_cols; base += (size_t)t * split_stride; colt -= t * split_cols; if (t == 0) sc = scale0; }
        const int col0 = colt + wc * 32 + 8 * fq, bcol0 = u.pn * BM + wc * 32 + 8 * fq;
        f32x4 bv[2][2];
#pragma unroll
        for (int bj = 0; bj < 2; ++bj)
#pragma unroll
            for (int n = 0; n < 2; ++n) bv[bj][n] = bias ? *(const f32x4*)(bias + bcol0 + bj * HALF + 4 * n) : (f32x4){0.f, 0.f, 0.f, 0.f};
#pragma unroll
        for (int ai = 0; ai < 2; ++ai)
#pragma unroll
            for (int m = 0; m < 4; ++m) { bf16_t* rowp = base + (size_t)(row0 + ai * HALF + m * 16) * ldc + col0;
#pragma unroll
                for (int bj = 0; bj < 2; ++bj) { f32x4 v0 = acc[ai][bj][m][0] + bv[bj][0], v1 = acc[ai][bj][m][1] + bv[bj][1];
                    if (ACT == 1) { f32x2 a = gelu_pk((f32x2){v0[0], v0[1]}), b = gelu_pk((f32x2){v0[2], v0[3]}), c = gelu_pk((f32x2){v1[0], v1[1]}), d = gelu_pk((f32x2){v1[2], v1[3]});
                        v0 = (f32x4){a.x, a.y, b.x, b.y}; v1 = (f32x4){c.x, c.y, d.x, d.y}; }
                    v0 = v0 * sc; v1 = v1 * sc; u32x4 w; w.x = cvt_pk_bf16(v0[0], v0[1]); w.y = cvt_pk_bf16(v0[2], v0[3]); w.z = cvt_pk_bf16(v1[0], v1[1]); w.w = cvt_pk_bf16(v1[2], v1[3]);
                    *(u32x4*)(rowp + bj * HALF) = w; } }
    }
};
struct UnitX { int pm, pn; const char* A; const char* B; int e, nvalid, r0, pad; };
__device__ __forceinline__ float silu_f(float x) { return x * __builtin_amdgcn_rcpf(1.0f + __expf(-x)); }
template <bool XIN_BF16> struct EpiResid {
    static constexpr bool PERM = true, AFTER_DRAIN = false;
    const void* xin; bf16_t* xout; const float* gate; int gate_ld; int rows_per_batch; int ldc; int pad;
    __device__ __forceinline__ void operator()(const f32x4 (&acc)[2][2][4][2], const UnitX& u, int wr, int wc, int fr, int fq) const {
        const int row0 = u.pm * BM + wr * 64 + fr, col0 = u.pn * BM + wc * 32 + 8 * fq;
        const int b = (u.pm * BM) / rows_per_batch;
        f32x4 gv[2][2];
#pragma unroll
        for (int bj = 0; bj < 2; ++bj)
#pragma unroll
            for (int n = 0; n < 2; ++n) gv[bj][n] = *(const f32x4*)(gate + (size_t)b * gate_ld + col0 + bj * HALF + 4 * n);
#pragma unroll
        for (int ai = 0; ai < 2; ++ai)
#pragma unroll
            for (int m = 0; m < 4; ++m) { const int row = row0 + ai * HALF + m * 16; const size_t off = (size_t)row * ldc + col0;
#pragma unroll
                for (int bj = 0; bj < 2; ++bj) {
                    f32x4 x0, x1;
                    if constexpr (XIN_BF16) { const u32x4 xw = *(const u32x4*)((const bf16_t*)xin + off + bj * HALF);
                        x0 = (f32x4){__uint_as_float(xw.x << 16), __uint_as_float(xw.x & 0xffff0000u), __uint_as_float(xw.y << 16), __uint_as_float(xw.y & 0xffff0000u)};
                        x1 = (f32x4){__uint_as_float(xw.z << 16), __uint_as_float(xw.z & 0xffff0000u), __uint_as_float(xw.w << 16), __uint_as_float(xw.w & 0xffff0000u)}; }
                    else { x0 = *(const f32x4*)((const float*)xin + off + bj * HALF); x1 = *(const f32x4*)((const float*)xin + off + bj * HALF + 4); }
                    const f32x4 y0 = x0 + gv[bj][0] * acc[ai][bj][m][0], y1 = x1 + gv[bj][1] * acc[ai][bj][m][1];
                    u32x4 w; w.x = cvt_pk_bf16(y0[0], y0[1]); w.y = cvt_pk_bf16(y0[2], y0[3]); w.z = cvt_pk_bf16(y1[0], y1[1]); w.w = cvt_pk_bf16(y1[2], y1[3]);
                    *(u32x4*)(xout + off + bj * HALF) = w; } }
    }
};
struct EpiSwiglu {
    static constexpr bool PERM = true, AFTER_DRAIN = false;
    bf16_t* O; int ldc; int pad;
    __device__ __forceinline__ void operator()(const f32x4 (&acc)[2][2][4][2], const UnitX& u, int wr, int wc, int fr, int fq) const {
        const int row0 = u.pm * BM + wr * 64 + fr, col0 = u.pn * HALF + wc * 32 + 8 * fq;
#pragma unroll
        for (int ai = 0; ai < 2; ++ai)
#pragma unroll
            for (int m = 0; m < 4; ++m) { bf16_t* rowp = O + (size_t)(row0 + ai * HALF + m * 16) * ldc + col0;
                const f32x4 g0 = acc[ai][0][m][0], g1 = acc[ai][0][m][1], u0 = acc[ai][1][m][0], u1 = acc[ai][1][m][1];
                u32x4 w;
                w.x = cvt_pk_bf16(silu_f(g0[0]) * u0[0], silu_f(g0[1]) * u0[1]); w.y = cvt_pk_bf16(silu_f(g0[2]) * u0[2], silu_f(g0[3]) * u0[3]);
                w.z = cvt_pk_bf16(silu_f(g1[0]) * u1[0], silu_f(g1[1]) * u1[1]); w.w = cvt_pk_bf16(silu_f(g1[2]) * u1[2], silu_f(g1[3]) * u1[3]);
                *(u32x4*)rowp = w; }
    }
};
struct EpiStore {
    static constexpr bool PERM = true, AFTER_DRAIN = false;
    bf16_t* O; long ldc; int scale_cols; float scale;
    __device__ __forceinline__ void operator()(const f32x4 (&acc)[2][2][4][2], const UnitX& u, int wr, int wc, int fr, int fq) const {
        const int row0 = u.pm * BM + wr * 64 + fr, col0 = u.pn * BM + wc * 32 + 8 * fq;
        const float sc = (u.pn * BM < scale_cols) ? scale : 1.0f;
#pragma unroll
        for (int ai = 0; ai < 2; ++ai)
#pragma unroll
            for (int m = 0; m < 4; ++m) { bf16_t* rowp = O + (size_t)(row0 + ai * HALF + m * 16) * ldc + col0;
#pragma unroll
                for (int bj = 0; bj < 2; ++bj) { const f32x4 v0 = acc[ai][bj][m][0] * sc, v1 = acc[ai][bj][m][1] * sc; u32x4 w;
                    w.x = cvt_pk_bf16(v0[0], v0[1]); w.y = cvt_pk_bf16(v0[2], v0[3]); w.z = cvt_pk_bf16(v1[0], v1[1]); w.w = cvt_pk_bf16(v1[2], v1[3]);
                    *(u32x4*)(rowp + bj * HALF) = w; } }
    }
};
struct EpiMoeDown {
    static constexpr bool PERM = true, AFTER_DRAIN = false;
    bf16_t* Y; const int* list; long cap;
    __device__ __forceinline__ void operator()(const f32x4 (&acc)[2][2][4][2], const UnitX& u, int wr, int wc, int fr, int fq) const {
        const int col0 = u.pn * BM + wc * 32 + 8 * fq;
        const int* lp = list + (size_t)u.e * cap + u.r0;
#pragma unroll
        for (int ai = 0; ai < 2; ++ai)
#pragma unroll
            for (int m = 0; m < 4; ++m) { const int r = ai * HALF + wr * 64 + m * 16 + fr;
                if (r < u.nvalid) { const int entry = lp[r]; bf16_t* rowp = Y + (size_t)entry * 1024 + col0;
#pragma unroll
                    for (int bj = 0; bj < 2; ++bj) { const f32x4 v0 = acc[ai][bj][m][0], v1 = acc[ai][bj][m][1]; u32x4 w;
                        w.x = cvt_pk_bf16(v0[0], v0[1]); w.y = cvt_pk_bf16(v0[2], v0[3]); w.z = cvt_pk_bf16(v1[0], v1[1]); w.w = cvt_pk_bf16(v1[2], v1[3]);
                        *(u32x4*)(rowp + bj * HALF) = w; } } }
    }
};
struct SchedPlain {
    const char* A; const char* Bt; int K; StaticOrder so;
    __device__ __forceinline__ void init(const void* A_, const void* Bt_, int M, int N, int K_, int G, int c) { A = (const char*)A_; Bt = (const char*)Bt_; K = K_; so.init(M, N, G, c); }
    __device__ __forceinline__ bool next(int i, UnitX& u) const { Unit t; if (!so.next(i, t)) return false; u.pm = t.pm; u.pn = t.pn; u.A = A + (size_t)t.pm * BM * K * 2; u.B = Bt + (size_t)t.pn * BM * K * 2; u.e = 0; u.nvalid = BM; u.r0 = 0; u.pad = 0; return true; }
};
struct SchedMoe {
    const char* A; const char* W; size_t wstride; const int* list; long cap; const PG8_LAS int* tab; int t0, K, gather, ovf_at, ovf_tile0, mode, nd, rounds; StaticOrder so;
    static constexpr int ND_DROP = 3;
    __device__ __forceinline__ bool deal(int i, Unit& t) const {
        if (mode == 0) return so.next(i, t);
        if (mode == 2) { if (i != 0 || so.c >= nd) return false; t.pm = ovf_at + (so.c >> 2); t.pn = so.c & 3; return true; }
        if (so.c < nd) return i < rounds - ND_DROP ? so.next(i, t) : false;
        if (i < rounds) return so.next(i, t);
        const int j = so.c - nd; if (i != rounds || j >= ND_DROP * nd) return false;
        StaticOrder o2 = so; o2.c = j % nd; return o2.next(rounds - ND_DROP + j / nd, t);
    }
    __device__ __forceinline__ bool next(int i, UnitX& u) const {
        Unit t; if (!deal(i, t)) return false;
        const int tile = t.pm < ovf_at ? t0 + t.pm : ovf_tile0 + (t.pm - ovf_at); int e = 0;
#pragma unroll
        for (int j = 1; j < 8; ++j) e += (tile >= tab[j]) ? 1 : 0;
        const int tse = tab[e], ce = tab[16 + e];
        u.pm = t.pm; u.pn = t.pn; u.e = e; u.r0 = (tile - tse) * BM; u.nvalid = ce - u.r0 < BM ? ce - u.r0 : BM; u.pad = 0;
        u.A = gather ? A : A + (size_t)t.pm * BM * K * 2; u.B = W + (size_t)e * wstride + (size_t)t.pn * BM * K * 2; return true;
    }
    __device__ __forceinline__ void a_tok_async(const UnitX& u, const int (&R)[2], int (&tok)[2][2]) const {
        const int* lp = list + (size_t)u.e * cap + u.r0;
#pragma unroll
        for (int h = 0; h < 2; ++h)
#pragma unroll
            for (int i = 0; i < 2; ++i) { const int r = h * HALF + R[i]; const int* ap = lp + (r < u.nvalid ? r : u.nvalid - 1);
                asm volatile("global_load_dword %0, %1, off" : "=v"(tok[h][i]) : "v"(ap) : "memory"); }
    }
    __device__ __forceinline__ void a_off(const UnitX& u, const int (&R)[2], const int (&C2)[2], unsigned (&go)[2][2]) const {
        const int* lp = list + (size_t)u.e * cap + u.r0; int tok[2][2];
#pragma unroll
        for (int h = 0; h < 2; ++h)
#pragma unroll
            for (int i = 0; i < 2; ++i) { const int r = h * HALF + R[i]; tok[h][i] = lp[r < u.nvalid ? r : u.nvalid - 1] >> 1; }
#pragma unroll
        for (int h = 0; h < 2; ++h)
#pragma unroll
            for (int i = 0; i < 2; ++i) go[h][i] = (unsigned)tok[h][i] * (unsigned)(K * 2) + (unsigned)C2[i];
    }
};
template <class Epi, class Sched, bool GATHER, bool ALIGN_EPI = true>
__device__ __forceinline__ void gphase(PG8_LAS unsigned char* lds, const int K, const Sched& S, const Epi& E, const int wid, const int lane) {
    const int tid = wid * 64 + lane, wr = wid >> 2, wc = wid & 3, fr = lane & 15, fq = lane >> 4;
    const int nt = K / BK;
    unsigned voffB[2]; int RA[2], CA2[2];
#pragma unroll
    for (int i = 0; i < 2; ++i) { int R, C; stage_rc(tid * 16 + i * 8192, R, C); const int Rb = Epi::PERM ? ((R & ~31) + perm32(R & 31)) : R;
        RA[i] = R; CA2[i] = C * 2; voffB[i] = (unsigned)(Rb * K + C) * 2u; }
    const size_t kstep = (size_t)(BK * 2);
    const size_t hstep = (size_t)HALF * K * 2;
    const unsigned ldsw = (unsigned)wid * 1024u;
    const int aoff = lds_byte(wr * 64 + fr, fq * 8), boff = lds_byte(wc * 32 + fr, fq * 8);
#define PG8_SA(b, h) (((b) * 2 + (h)) * HTB)
#define PG8_SB(b, h) ((4 + (b) * 2 + (h)) * HTB)
#define PG8_STAGE(bufoff, gbase, voff) do { _Pragma("unroll") for (int _i = 0; _i < 2; ++_i) \
        __builtin_amdgcn_global_load_lds((const unsigned*)((const char*)(gbase) + (voff)[_i]), (PG8_LAS unsigned*)(lds + (bufoff) + ldsw + _i * 8192), 16, 0, 0); } while (0)
#define PG8_LDA(dst, b, h) do { _Pragma("unroll") for (int m = 0; m < 4; ++m) _Pragma("unroll") for (int k = 0; k < 2; ++k) dst[m][k] = *(const PG8_LAS bf16x8*)(lds + PG8_SA(b, h) + aoff + m * 2048 + k * 1024); } while (0)
#define PG8_LDB(dst, b, h) do { _Pragma("unroll") for (int n = 0; n < 2; ++n) _Pragma("unroll") for (int k = 0; k < 2; ++k) dst[n][k] = *(const PG8_LAS bf16x8*)(lds + PG8_SB(b, h) + boff + n * 2048 + k * 1024); } while (0)
#define PG8_MMA(ai, bj, At, Bt) do { __builtin_amdgcn_s_setprio(1); _Pragma("unroll") for (int m = 0; m < 4; ++m) _Pragma("unroll") for (int n = 0; n < 2; ++n) _Pragma("unroll") for (int k = 0; k < 2; ++k) \
        acc[ai][bj][m][n] = __builtin_amdgcn_mfma_f32_16x16x32_bf16(Bt[n][k], At[m][k], acc[ai][bj][m][n], 0, 0, 0); __builtin_amdgcn_s_setprio(0); } while (0)
#define PG8_WAIT_V(n) asm volatile("s_waitcnt vmcnt(" #n ")" ::: "memory")
#define PG8_WAIT_L(n) asm volatile("s_waitcnt lgkmcnt(" #n ")" ::: "memory")
#define PG8_BAR __builtin_amdgcn_s_barrier()
#define PG8_SCHED __builtin_amdgcn_sched_barrier(0)
    UnitX cur, nxt; int ui = 0;
    if (!S.next(0, cur)) return;
    unsigned goC[2][2], goN[2][2];
    if constexpr (GATHER) { S.a_off(cur, RA, CA2, goC); }
    else {
#pragma unroll
        for (int h = 0; h < 2; ++h)
#pragma unroll
            for (int i = 0; i < 2; ++i) goC[h][i] = (unsigned)(RA[i] * K * 2 + CA2[i]) + (unsigned)h * (unsigned)hstep; }
#pragma unroll
    for (int h = 0; h < 2; ++h)
#pragma unroll
        for (int i = 0; i < 2; ++i) goN[h][i] = goC[h][i];
    f32x4 acc[2][2][4][2];
#pragma unroll
    for (int a = 0; a < 2; ++a)
#pragma unroll
        for (int b = 0; b < 2; ++b)
#pragma unroll
            for (int m = 0; m < 4; ++m)
#pragma unroll
                for (int n = 0; n < 2; ++n) acc[a][b][m][n] = (f32x4){0.f, 0.f, 0.f, 0.f};
    bf16x8 At[4][2], B0[2][2], B1[2][2];
    const char* cA = cur.A; const char* cB = cur.B;
    PG8_STAGE(PG8_SB(0, 0), cB, voffB); PG8_STAGE(PG8_SB(0, 1), cB + hstep, voffB); PG8_STAGE(PG8_SA(0, 0), cA, goC[0]); PG8_STAGE(PG8_SA(0, 1), cA, goC[1]);
    if (wr == 1) PG8_BAR;
    PG8_WAIT_V(2); PG8_BAR;
    PG8_STAGE(PG8_SB(1, 0), cB + kstep, voffB); PG8_STAGE(PG8_SA(1, 0), cA + kstep, goC[0]); PG8_STAGE(PG8_SB(1, 1), cB + hstep + kstep, voffB);
    PG8_WAIT_V(6); PG8_BAR;
    for (;;) {
        const bool has_next = S.next(ui + 1, nxt);
        int tokN[2][2] = {{0, 0}, {0, 0}};
        if constexpr (GATHER) { if (has_next) S.a_tok_async(nxt, RA, tokN); }
        const char* nA = has_next ? nxt.A : cA; const char* nB = has_next ? nxt.B : cB;
        for (int t = 0; t < nt; t += 2) {
            const bool last = (t == nt - 2);
            const char* a1 = cA + (size_t)(t + 1) * kstep;
            const char* a2 = last ? nA : cA + (size_t)(t + 2) * kstep; const char* b2 = last ? nB : cB + (size_t)(t + 2) * kstep;
            const char* a3 = a2 + kstep; const char* b3 = b2 + kstep;
            unsigned g2[2][2];
#pragma unroll
            for (int h = 0; h < 2; ++h)
#pragma unroll
                for (int i = 0; i < 2; ++i) { if constexpr (GATHER) { asm volatile("" : "+v"(tokN[h][i])); goN[h][i] = (unsigned)(tokN[h][i] >> 1) * (unsigned)(K * 2) + (unsigned)CA2[i]; }
                    g2[h][i] = (GATHER && last && has_next) ? goN[h][i] : goC[h][i]; }
            PG8_LDB(B0, 0, 0); PG8_LDB(B1, 0, 1); PG8_SCHED; PG8_LDA(At, 0, 0); PG8_STAGE(PG8_SA(1, 1), a1, goC[1]);
            PG8_WAIT_V(8); PG8_WAIT_L(0); PG8_BAR; PG8_MMA(0, 0, At, B0); PG8_MMA(0, 1, At, B1); PG8_BAR; PG8_SCHED;
            PG8_LDA(At, 0, 1); PG8_STAGE(PG8_SB(0, 0), b2, voffB); PG8_STAGE(PG8_SB(0, 1), b2 + hstep, voffB); PG8_STAGE(PG8_SA(0, 0), a2, g2[0]);
            PG8_WAIT_V(8); PG8_WAIT_L(0); PG8_BAR; PG8_MMA(1, 0, At, B0); PG8_MMA(1, 1, At, B1); PG8_BAR; PG8_SCHED;
            PG8_LDB(B0, 1, 0); PG8_LDB(B1, 1, 1); PG8_SCHED; PG8_LDA(At, 1, 0); PG8_STAGE(PG8_SA(0, 1), a2, g2[1]);
            PG8_WAIT_V(8); PG8_WAIT_L(0); PG8_BAR; PG8_MMA(0, 0, At, B0); PG8_MMA(0, 1, At, B1); PG8_BAR; PG8_SCHED;
            PG8_LDA(At, 1, 1); PG8_STAGE(PG8_SB(1, 0), b3, voffB); PG8_STAGE(PG8_SB(1, 1), b3 + hstep, voffB); PG8_STAGE(PG8_SA(1, 0), a3, g2[0]);
            PG8_WAIT_V(8); PG8_WAIT_L(0); PG8_BAR; PG8_MMA(1, 0, At, B0); PG8_MMA(1, 1, At, B1); PG8_BAR; PG8_SCHED;
        }
        if constexpr (ALIGN_EPI) { if (wr == 0) PG8_BAR; }
        E(acc, cur, wr, wc, fr, fq);
        if (!has_next) break;
#pragma unroll
        for (int a = 0; a < 2; ++a)
#pragma unroll
            for (int b = 0; b < 2; ++b)
#pragma unroll
                for (int m = 0; m < 4; ++m)
#pragma unroll
                    for (int n = 0; n < 2; ++n) acc[a][b][m][n] = (f32x4){0.f, 0.f, 0.f, 0.f};
        cur = nxt; cA = nA; cB = nB; ++ui;
#pragma unroll
        for (int h = 0; h < 2; ++h)
#pragma unroll
            for (int i = 0; i < 2; ++i) goC[h][i] = goN[h][i];
        if constexpr (ALIGN_EPI) { if (wr == 1) PG8_BAR; }
    }
    PG8_WAIT_V(0);
    if constexpr (!ALIGN_EPI) { if (wr == 0) PG8_BAR; }
    PG8_BAR;
#undef PG8_SA
#undef PG8_SB
#undef PG8_STAGE
#undef PG8_LDA
#undef PG8_LDB
#undef PG8_MMA
#undef PG8_WAIT_V
#undef PG8_WAIT_L
#undef PG8_BAR
#undef PG8_SCHED
}
}
#define GAS __attribute__((address_space(1)))
#define LAS __attribute__((address_space(3)))
typedef unsigned short bf16;
typedef unsigned v4u __attribute__((ext_vector_type(4)));
typedef float f32x4 __attribute__((ext_vector_type(4)));
typedef short bf16x8 __attribute__((ext_vector_type(8)));
typedef GAS unsigned gu32;
typedef GAS unsigned long long gu64;
#define RLX_AGENT __ATOMIC_RELAXED, __HIP_MEMORY_SCOPE_AGENT
#define LDS_WAIT() asm volatile("s_waitcnt lgkmcnt(0)" ::: "memory")
#define VM_WAIT() asm volatile("s_waitcnt vmcnt(0)" ::: "memory")
__device__ __forceinline__ unsigned long long rt() { return __builtin_amdgcn_s_memrealtime(); }
__device__ __forceinline__ unsigned f2bf(float f) { unsigned u = __builtin_bit_cast(unsigned, f); return (u + 0x7fffu + ((u >> 16) & 1u)) >> 16; }
__device__ __forceinline__ unsigned pk2(float lo, float hi) { return f2bf(lo) | (f2bf(hi) << 16); }

#define XB_TMO      128
#define XB_XCNT(j)  (256  + 64 * (j))
#define XB_XSUB(j)  (1280 + 64 * (j))
#define XB_XGEN(j)  (2304 + 64 * (j))
#define XB_TOP      3328
#define XB_TOPGEN   3392
#define XCD_BAR_WORDS 3456
#define XB_SPIN_CAP (1u << 18)

__device__ __forceinline__ unsigned xb_ld(unsigned* p)              { return __hip_atomic_load(p, __ATOMIC_RELAXED, __HIP_MEMORY_SCOPE_AGENT); }
__device__ __forceinline__ unsigned xb_add(unsigned* p, unsigned v) { return __hip_atomic_fetch_add(p, v, __ATOMIC_RELAXED, __HIP_MEMORY_SCOPE_AGENT); }
__device__ __forceinline__ unsigned xb_xcc_id() { return (unsigned)__builtin_amdgcn_s_getreg((3 << 11) | 20) & 0xFu; }
#define XB_SPIN(cond, bar) do { unsigned _sp = 0; while (cond) { __builtin_amdgcn_s_sleep(1); \
    if ((++_sp & 255u) == 0u) { if (xb_ld(&(bar)[XB_TMO])) break; if (_sp > XB_SPIN_CAP) { atomicAdd(&(bar)[XB_TMO], 1u); break; } } } } while (0)

__device__ __forceinline__ int mk_lane() { int l; asm volatile("v_mbcnt_lo_u32_b32 %0, -1, 0\n\tv_mbcnt_hi_u32_b32 %0, -1, %0" : "=v"(l)); return l; }
struct XcdBarrier {
    unsigned* bar; unsigned x; int wave;
    volatile LAS unsigned* st;
};

__device__ __forceinline__ XcdBarrier xcd_barrier_post(unsigned* bar, volatile LAS unsigned* st, int wave) {
    XcdBarrier b; b.bar = bar; b.x = xb_xcc_id(); b.st = st; b.wave = wave;
    if (wave == 0 && mk_lane() == 0) (void)xb_add(&bar[XB_XCNT(b.x)], 1u);
    return b;
}
__device__ __forceinline__ void xcd_barrier_complete(unsigned* bar, unsigned x, unsigned& nloc, unsigned& nx) {
    const unsigned G = gridDim.x * gridDim.y * gridDim.z;
    unsigned sum, cnt, mine, sp = 0u;
    for (;;) {
        sum = 0u; cnt = 0u; mine = 0u;
#pragma unroll
        for (unsigned j = 0; j < 16; ++j) { const unsigned c = xb_ld(&bar[XB_XCNT(j)]); sum += c; cnt += (c > 0u) ? 1u : 0u; mine = (j == x) ? c : mine; }
        if (sum == G) break;
        __builtin_amdgcn_s_sleep(1);
        if ((++sp & 255u) == 0u) { if (xb_ld(&bar[XB_TMO])) break; if (sp > XB_SPIN_CAP) { atomicAdd(&bar[XB_TMO], 1u); break; } }
    }
    nloc = mine > 0u ? mine : 1u; nx = cnt > 0u ? cnt : 1u;
}

__device__ __forceinline__ void xcd_barrier(const XcdBarrier& b) {
    asm volatile("s_waitcnt vmcnt(0)" ::: "memory");
    __syncthreads();
    if (b.wave == 0 && mk_lane() == 0) {
        unsigned* bar = b.bar;
        __builtin_amdgcn_s_waitcnt(0);
        unsigned nloc = b.st[0], nx = b.st[1];
        if (nloc == 0u) { xcd_barrier_complete(bar, b.x, nloc, nx); b.st[0] = nloc; b.st[1] = nx; }
        const unsigned old = xb_add(&bar[XB_XSUB(b.x)], 1u);
        const unsigned gen = old / nloc;
        if (old + 1u == (gen + 1u) * nloc) {
            __builtin_amdgcn_fence(__ATOMIC_RELEASE, "agent");
            asm volatile("s_waitcnt vmcnt(0)" ::: "memory");
            const unsigned og = xb_add(&bar[XB_TOP], 1u);
            const unsigned tg = og / nx;
            if (og + 1u == (tg + 1u) * nx) xb_add(&bar[XB_TOPGEN], 1u);
            else XB_SPIN(xb_ld(&bar[XB_TOPGEN]) == tg, bar);
            __builtin_amdgcn_fence(__ATOMIC_ACQUIRE, "agent");
            xb_add(&bar[XB_XGEN(b.x)], 1u);
            asm volatile("s_waitcnt vmcnt(0)" ::: "memory");
        } else {
            XB_SPIN(xb_ld(&bar[XB_XGEN(b.x)]) == gen, bar);
            __builtin_amdgcn_fence(__ATOMIC_ACQUIRE, "agent");
            asm volatile("s_waitcnt vmcnt(0)" ::: "memory");
        }
    }
    __syncthreads();
}
#ifndef MK_DIAG_SEL
#define MK_DIAG_SEL -1
#endif
#ifndef MK_DIAG_SCALE
#define MK_DIAG_SCALE 1e-5f
#endif
constexpr int NB = 8, SEQ = 4096, DM = 1024, MTOK = NB * SEQ;
constexpr int EVEN_IN = 2560, ODD_IN = 3072, FFD = 2816, FFE = 3584, NEXP = 8;
constexpr float EPS = 1e-6f;
constexpr size_t MiB = 1u << 20;
constexpr int NWAVES = 8;
constexpr size_t WS_CTL = 0, CTL_ZERO_BYTES = 1 * MiB;
constexpr size_t WS_MOD = 1 * MiB;
constexpr size_t WS_TOPW = 2 * MiB;
constexpr size_t WS_LIST = 3 * MiB;
constexpr size_t WS_WIN0 = 4 * MiB, WS_WOUT0 = 9 * MiB, WS_WGU0 = 11 * MiB, WS_WD0 = 22 * MiB, WS_WIN1 = 28 * MiB, WS_WOUT1 = 34 * MiB;
constexpr size_t WS_WMOE = 40 * MiB, WMOE_STRIDE = 21 * MiB, WMOE_D_OFF = 14 * MiB;
constexpr size_t WS_H = 208 * MiB;
constexpr size_t WS_PROJ = 272 * MiB;
constexpr size_t WS_MIX = 464 * MiB;
constexpr size_t WS_ACT = 272 * MiB;
constexpr size_t WS_XB = 510 * MiB;
constexpr size_t WS_END = 574 * MiB;
constexpr long LIST_CAP = 32768;
constexpr int MOE_CHUNK_TILES = 128;
constexpr int CW_BAR = 4096;
constexpr int CW_CNT = 8192;
constexpr int RING_BYTES = 131072, MISC_OFF = RING_BYTES, LDS_BYTES = 135168;

__device__ __forceinline__ float bf2f(bf16 v) { return __builtin_bit_cast(float, (unsigned)v << 16); }
__device__ __forceinline__ float wave_sum(float v) {
#pragma unroll
    for (int o = 1; o < 64; o <<= 1) v += __shfl_xor(v, o);
    return v;
}
__device__ __forceinline__ float logsig_f(float z) { return fminf(z, 0.f) - log1pf(expf(-fabsf(z))); }
__device__ __forceinline__ float sigmoid_f(float z) { return 1.0f / (1.0f + expf(-z)); }
__device__ __forceinline__ float gelu_tanh_f(float x) { const float t = tanhf(0.7978845608028654f * (x + 0.044715f * x * x * x)); return 0.5f * x * (1.0f + t); }

struct Frame {
    LAS unsigned char* lds; volatile LAS unsigned* MISC; gu32* ctl;
    int tid, lane, wave, G, gw, NGW;
    float* out; unsigned char* ws;
};
__device__ __forceinline__ const float* inp(const Frame& F, int i) {
    const unsigned long long v = ((const LAS unsigned long long*)(F.lds + MISC_OFF + 512))[i];
    const unsigned lo = __builtin_amdgcn_readfirstlane((unsigned)v), hi = __builtin_amdgcn_readfirstlane((unsigned)(v >> 32));
    return (const float*)(((unsigned long long)hi << 32) | lo);
}

typedef short v4i16p __attribute__((ext_vector_type(4)));
constexpr int TR_ROW = 288;
__device__ __forceinline__ void transpose_item(const float* W, int N, int k0, int n0, bf16* dst, int ldk, LAS unsigned char* scr, int lane) {
    const int l32 = lane & 31, rh = lane >> 5;
    const GAS f32x4* src = (const GAS f32x4*)(W + (size_t)(k0 + rh) * N + n0) + l32;
    const size_t rs2 = (size_t)(N >> 1);
    {
        f32x4 v[16];
#pragma unroll
        for (int i = 0; i < 16; ++i) v[i] = src[(size_t)i * rs2];
#pragma unroll
        for (int i = 0; i < 16; ++i) *(LAS unsigned long long*)(scr + (2 * i + rh) * TR_ROW + 8 * l32) = (unsigned long long)pk2(v[i].x, v[i].y) | ((unsigned long long)pk2(v[i].z, v[i].w) << 32);
    }
    LDS_WAIT(); asm volatile("" ::: "memory");
    const int kc = lane >> 4, li = lane & 15, q = li >> 2, p = li & 3;
    LAS unsigned char* rb = scr + (8 * kc + q) * TR_ROW + 8 * p;
#pragma unroll
    for (int j = 0; j < 8; ++j) {
        const v4i16p lo = __builtin_amdgcn_ds_read_tr16_b64_v4i16((LAS v4i16p*)(rb + 32 * j)), hi = __builtin_amdgcn_ds_read_tr16_b64_v4i16((LAS v4i16p*)(rb + 4 * TR_ROW + 32 * j));
        v4u o; o.x = (unsigned)(unsigned short)lo[0] | ((unsigned)(unsigned short)lo[1] << 16); o.y = (unsigned)(unsigned short)lo[2] | ((unsigned)(unsigned short)lo[3] << 16);
        o.z = (unsigned)(unsigned short)hi[0] | ((unsigned)(unsigned short)hi[1] << 16); o.w = (unsigned)(unsigned short)hi[2] | ((unsigned)(unsigned short)hi[3] << 16);
        *(GAS v4u*)(dst + (size_t)(16 * j + li) * ldk + k0 + 8 * kc) = o; }
    LDS_WAIT(); asm volatile("" ::: "memory");
}
__device__ __forceinline__ bool tr_plain(int& r, const float* W, int K, int N, bf16* Wt, LAS unsigned char* scr, int lane) {
    const int nblk = N / 128, items = (K / 32) * nblk;
    if (r >= items) { r -= items; return false; }
    const int kb = r / nblk, nb = r % nblk;
    transpose_item(W, N, 32 * kb, 128 * nb, Wt + (size_t)(128 * nb) * K, K, scr, lane); return true;
}
__device__ __forceinline__ bool tr_gu(int& r, const float* Wg, const float* Wu, int K, int F, bf16* Wt, LAS unsigned char* scr, int lane) {
    const int nblk = F / 128, items = (K / 32) * nblk;
    if (r >= 2 * items) { r -= 2 * items; return false; }
    const int up = r >= items ? 1 : 0; const int q = r - up * items; const int kb = q / nblk, nb = q % nblk;
    transpose_item(up ? Wu : Wg, F, 32 * kb, 128 * nb, Wt + (size_t)(256 * nb + 128 * up) * K, K, scr, lane); return true;
}
__device__ __forceinline__ void p_prologue(Frame& F) {
    LAS float* cond = (LAS float*)F.lds;
    const float* cin = inp(F, 1);
    for (int i = F.tid; i < NB * DM; i += 512) { const float c = cin[i]; cond[i] = c / (1.0f + expf(-c)); }
    __syncthreads();
    float* mod = (float*)(F.ws + WS_MOD);
    const float* ada_w = inp(F, 3); const float* ada_b = inp(F, 4);
    for (int it = F.gw; it < 768; it += F.NGW) {
        const int layer = it / 384, j0 = (it % 384) * 16, cj = F.lane & 15, kp = F.lane >> 4;
        float acc[NB];
#pragma unroll
        for (int b = 0; b < NB; ++b) acc[b] = 0.f;
        const float* wp = ada_w + (size_t)layer * DM * 6144 + j0 + cj;
#pragma unroll 16
        for (int k = kp; k < DM; k += 4) { const float w = wp[(size_t)k * 6144];
#pragma unroll
            for (int b = 0; b < NB; ++b) acc[b] += cond[b * DM + k] * w; }
#pragma unroll
        for (int b = 0; b < NB; ++b) { acc[b] += __shfl_xor(acc[b], 16); acc[b] += __shfl_xor(acc[b], 32); }
        if (kp == 0) {
            const float bias = ada_b[layer * 6144 + j0 + cj];
#pragma unroll
            for (int b = 0; b < NB; ++b) mod[(size_t)(layer * NB + b) * 6144 + j0 + cj] = acc[b] + bias; }
    }
    __syncthreads();
    LAS unsigned char* scr = F.lds + F.wave * 16384;
    constexpr int ITEMS_MOE_E = 3 * (DM / 32) * (FFE / 128);
    constexpr int ITEMS_FIX = (DM / 32) * (EVEN_IN / 128) + (DM / 32) * (DM / 128) + 2 * (DM / 32) * (FFD / 128) + (FFD / 32) * (DM / 128) + (DM / 32) * (ODD_IN / 128) + (DM / 32) * (DM / 128);
    constexpr int NITEMS = ITEMS_FIX + NEXP * ITEMS_MOE_E;
    unsigned char* ws = F.ws;
    for (int it = F.gw; it < NITEMS; it += F.NGW) {
        int r = it;
        if (tr_plain(r, inp(F, 8), DM, EVEN_IN, (bf16*)(ws + WS_WIN0), scr, F.lane)) continue;
        if (tr_plain(r, inp(F, 9), DM, DM, (bf16*)(ws + WS_WOUT0), scr, F.lane)) continue;
        if (tr_gu(r, inp(F, 17), inp(F, 18), DM, FFD, (bf16*)(ws + WS_WGU0), scr, F.lane)) continue;
        if (tr_plain(r, inp(F, 19), FFD, DM, (bf16*)(ws + WS_WD0), scr, F.lane)) continue;
        if (tr_plain(r, inp(F, 20), DM, ODD_IN, (bf16*)(ws + WS_WIN1), scr, F.lane)) continue;
        if (tr_plain(r, inp(F, 21), DM, DM, (bf16*)(ws + WS_WOUT1), scr, F.lane)) continue;
        const int e = r / ITEMS_MOE_E; r -= e * ITEMS_MOE_E;
        unsigned char* we = ws + WS_WMOE + (size_t)e * WMOE_STRIDE;
        if (tr_gu(r, inp(F, 29) + (size_t)e * DM * FFE, inp(F, 30) + (size_t)e * DM * FFE, DM, FFE, (bf16*)we, scr, F.lane)) continue;
        tr_plain(r, inp(F, 31) + (size_t)e * FFE * DM, FFE, DM, (bf16*)(we + WMOE_D_OFF), scr, F.lane);
    }
}

__device__ __forceinline__ f32x4 bf4_to_f32(unsigned long long w) { return (f32x4){__uint_as_float((unsigned)w << 16), __uint_as_float((unsigned)w & 0xffff0000u), __uint_as_float((unsigned)(w >> 32) << 16), __uint_as_float((unsigned)(w >> 32) & 0xffff0000u)}; }
template <bool X_BF16> __device__ __forceinline__ void p_norm_mod(Frame& F, const void* X, bf16* H, const float* ln, const float* modl, int sh_off, int sc_off) {
    for (int m = F.gw; m < MTOK; m += F.NGW) {
        const int b = m / SEQ;
        const GAS f32x4* xr = (const GAS f32x4*)((const float*)X + (size_t)m * DM) + F.lane;
        const GAS unsigned long long* xb8 = (const GAS unsigned long long*)((const bf16*)X + (size_t)m * DM) + F.lane;
        f32x4 v[4]; float ss = 0.f;
#pragma unroll
        for (int j = 0; j < 4; ++j) { if constexpr (X_BF16) v[j] = bf4_to_f32(xb8[64 * j]); else v[j] = xr[64 * j]; ss += (v[j].x * v[j].x + v[j].y * v[j].y) + (v[j].z * v[j].z + v[j].w * v[j].w); }
        const float rstd = 1.0f / sqrtf(wave_sum(ss) * (1.f / DM) + EPS);
        GAS unsigned long long* o8 = (GAS unsigned long long*)(H + (size_t)m * DM) + F.lane;
#pragma unroll
        for (int j = 0; j < 4; ++j) { const int col = 4 * F.lane + 256 * j;
            const f32x4 g = *(const GAS f32x4*)(ln + col), sc = *(const GAS f32x4*)(modl + (size_t)b * 6144 + sc_off + col), sh = *(const GAS f32x4*)(modl + (size_t)b * 6144 + sh_off + col);
            const f32x4 h = v[j] * rstd * g * (sc + 1.0f) + sh;
            o8[64 * j] = (unsigned long long)pk2(h.x, h.y) | ((unsigned long long)pk2(h.z, h.w) << 32); }
    }
}
__device__ __forceinline__ void p_router(Frame& F, const bf16* X, bf16* H, const float* ln, const float* modl, int sh_off, int sc_off) {
    LAS float* rws = (LAS float*)F.lds;
    LAS int* sel = (LAS int*)(F.lds + 32768);
    const float* rw = inp(F, 27); const float* rb = inp(F, 28);
    float* topw = (float*)(F.ws + WS_TOPW); int* list = (int*)(F.ws + WS_LIST);
    for (int i = F.tid; i < DM * NEXP; i += 512) rws[i] = rw[i];
    __syncthreads();
    for (int chunk = blockIdx.x; chunk < MTOK / 128; chunk += F.G) {
        for (int i = 0; i < 16; ++i) {
            const int lt = F.wave * 16 + i, m = chunk * 128 + lt, b = m / SEQ;
            const GAS unsigned long long* xb8 = (const GAS unsigned long long*)(X + (size_t)m * DM) + F.lane;
            f32x4 v[4]; float ss = 0.f;
#pragma unroll
            for (int j = 0; j < 4; ++j) { v[j] = bf4_to_f32(xb8[64 * j]); ss += (v[j].x * v[j].x + v[j].y * v[j].y) + (v[j].z * v[j].z + v[j].w * v[j].w); }
            const float rstd = 1.0f / sqrtf(wave_sum(ss) * (1.f / DM) + EPS);
            GAS unsigned long long* o8 = (GAS unsigned long long*)(H + (size_t)m * DM) + F.lane;
            float lg[NEXP];
#pragma unroll
            for (int e = 0; e < NEXP; ++e) lg[e] = 0.f;
#pragma unroll
            for (int j = 0; j < 4; ++j) { const int col = 4 * F.lane + 256 * j;
                const f32x4 g = *(const GAS f32x4*)(ln + col), sc = *(const GAS f32x4*)(modl + (size_t)b * 6144 + sc_off + col), sh = *(const GAS f32x4*)(modl + (size_t)b * 6144 + sh_off + col);
                const f32x4 h = v[j] * rstd * g * (sc + 1.0f) + sh;
                o8[64 * j] = (unsigned long long)pk2(h.x, h.y) | ((unsigned long long)pk2(h.z, h.w) << 32);
#pragma unroll
                for (int q = 0; q < 4; ++q) { const f32x4 w0 = *(const LAS f32x4*)(rws + (col + q) * 8), w1 = *(const LAS f32x4*)(rws + (col + q) * 8 + 4); const float hv = h[q];
                    lg[0] += hv * w0.x; lg[1] += hv * w0.y; lg[2] += hv * w0.z; lg[3] += hv * w0.w; lg[4] += hv * w1.x; lg[5] += hv * w1.y; lg[6] += hv * w1.z; lg[7] += hv * w1.w; } }
#pragma unroll
            for (int e = 0; e < NEXP; ++e) lg[e] = wave_sum(lg[e]) + rb[e];
            int i0 = 0; float v0 = lg[0];
#pragma unroll
            for (int e = 1; e < NEXP; ++e) if (lg[e] > v0) { v0 = lg[e]; i0 = e; }
            int i1 = (i0 == 0) ? 1 : 0; float v1 = (i0 == 0) ? lg[1] : lg[0];
#pragma unroll
            for (int e = 1; e < NEXP; ++e) if (e != i0 && lg[e] > v1) { v1 = lg[e]; i1 = e; }
            const float w0 = 1.0f / (1.0f + expf(v1 - v0)), w1 = 1.0f - w0;
            if (F.lane == 0) { sel[2 * lt] = i0; sel[2 * lt + 1] = i1; topw[(size_t)m * 2] = w0; topw[(size_t)m * 2 + 1] = w1; }
        }
        __syncthreads();
        {
            const int e = F.wave; bool mt[4]; int rk[4]; int total = 0;
#pragma unroll
            for (int r = 0; r < 4; ++r) { mt[r] = (sel[r * 64 + F.lane] == e); const unsigned long long mask = __ballot(mt[r]);
                rk[r] = total + __popcll(mask & ((1ull << F.lane) - 1ull)); total += __popcll(mask); }
            int base = 0;
            if (F.lane == 0 && total > 0) base = (int)__hip_atomic_fetch_add((unsigned*)(F.ctl + CW_CNT + 64 * e), (unsigned)total, RLX_AGENT);
            base = __builtin_amdgcn_readfirstlane(base);
#pragma unroll
            for (int r = 0; r < 4; ++r) if (mt[r]) list[(size_t)e * LIST_CAP + base + rk[r]] = (chunk * 128) * 2 + r * 64 + F.lane;
        }
        __syncthreads();
    }
}
__device__ __forceinline__ void p_final(Frame& F, const bf16* XB, const float* gate, const float* ln) {
    const float* topw = (const float*)(F.ws + WS_TOPW);
    for (int m = F.gw; m < MTOK; m += F.NGW) {
        const int b = m / SEQ;
        const GAS unsigned long long* x8 = (const GAS unsigned long long*)(XB + (size_t)m * DM) + F.lane;
        const GAS unsigned long long* y0 = (const GAS unsigned long long*)((const bf16*)F.out + (size_t)(2 * m) * DM) + F.lane;
        const GAS unsigned long long* y1 = (const GAS unsigned long long*)((const bf16*)F.out + (size_t)(2 * m + 1) * DM) + F.lane;
        const float w0 = topw[(size_t)m * 2], w1 = topw[(size_t)m * 2 + 1];
        f32x4 v[4]; float ss = 0.f;
#pragma unroll
        for (int j = 0; j < 4; ++j) { const unsigned long long xa = x8[64 * j], ya = y0[64 * j], yb = y1[64 * j];
            const f32x4 g = *(const GAS f32x4*)(gate + (size_t)b * 6144 + 4 * F.lane + 256 * j);
            f32x4 xv, y0v, y1v;
            xv.x = bf2f((bf16)(xa & 0xffff)); xv.y = bf2f((bf16)((xa >> 16) & 0xffff)); xv.z = bf2f((bf16)((xa >> 32) & 0xffff)); xv.w = bf2f((bf16)(xa >> 48));
            y0v.x = bf2f((bf16)(ya & 0xffff)); y0v.y = bf2f((bf16)((ya >> 16) & 0xffff)); y0v.z = bf2f((bf16)((ya >> 32) & 0xffff)); y0v.w = bf2f((bf16)(ya >> 48));
            y1v.x = bf2f((bf16)(yb & 0xffff)); y1v.y = bf2f((bf16)((yb >> 16) & 0xffff)); y1v.z = bf2f((bf16)((yb >> 32) & 0xffff)); y1v.w = bf2f((bf16)(yb >> 48));
            v[j] = xv + g * (y0v * w0 + y1v * w1);
            ss += (v[j].x * v[j].x + v[j].y * v[j].y) + (v[j].z * v[j].z + v[j].w * v[j].w); }
        float rstd = 1.0f / sqrtf(wave_sum(ss) * (1.f / DM) + EPS);
#if MK_DIAG_SEL >= 0
        rstd *= 1.0f + ((const float*)(F.ws + WS_CTL + 65536))[MK_DIAG_SEL] * MK_DIAG_SCALE;
#endif
        asm volatile("" ::: "memory");
        GAS f32x4* orow = (GAS f32x4*)(F.out + (size_t)m * DM) + F.lane;
#pragma unroll
        for (int j = 0; j < 4; ++j) { const f32x4 g = *(const GAS f32x4*)(ln + 4 * F.lane + 256 * j); orow[64 * j] = v[j] * rstd * g; }
    }
}

__device__ __forceinline__ void p_sb_naive(Frame& F, const bf16* proj, bf16* mix) {
    for (int w = blockIdx.x * 7 + (F.wave - 1); w < NB * 8 * SEQ; w += F.G * 7) {
        const int t = w % SEQ, bh = w / SEQ, h = bh % 8, b = bh / 8;
        const size_t row = (size_t)b * SEQ + t;
        const float q = bf2f(proj[row * EVEN_IN + h * 64 + F.lane]);
        float acc = 0.f, later = 0.f;
        for (int s = t - 1; s >= 0; --s) {
            const size_t kr = ((size_t)b * SEQ + s) * EVEN_IN;
            const float kk = bf2f(proj[kr + 512 + h * 64 + F.lane]), vv = bf2f(proj[kr + 1024 + h * 64 + F.lane]);
            const float z = wave_sum(q * kk) * 0.125f;
            const float lp = logsig_f(z), ln_ = lp - z;
            acc += expf(lp + later) * vv; later += ln_;
            if (later < -110.f) break;
        }
        mix[row * DM + h * 64 + F.lane] = (bf16)f2bf(acc);
    }
}
__device__ __forceinline__ void p_lru_naive_wave(Frame& F, int unit, const bf16* proj, bf16* mix) {
    LAS float* wa = (LAS float*)F.lds; LAS float* wx = wa + 4096; LAS float* xcs = wx + 4096;
    const float* conv_w = inp(F, 10); const float* conv_b = inp(F, 11); const float* ga_w = inp(F, 12); const float* ga_b = inp(F, 13); const float* gx_w = inp(F, 14); const float* gx_b = inp(F, 15); const float* lam = inp(F, 16);
    const int b = unit / 8, g = unit % 8, j = F.lane, c = g * 64 + j;
    for (int i = j; i < 4096; i += 64) { wa[i] = ga_w[g * 4096 + i]; wx[i] = gx_w[g * 4096 + i]; }
    const float cw0 = conv_w[c], cw1 = conv_w[512 + c], cw2 = conv_w[1024 + c], cw3 = conv_w[1536 + c], cb = conv_b[c], ba = ga_b[c], bx = gx_b[c], lsl = logsig_f(lam[c]);
    float x1 = 0.f, x2 = 0.f, x3 = 0.f, hs = 0.f;
    LDS_WAIT();
    for (int t = 0; t < SEQ; ++t) {
        const size_t row = (size_t)b * SEQ + t;
        const float xb = bf2f(proj[row * EVEN_IN + 1536 + c]), gb = bf2f(proj[row * EVEN_IN + 2048 + c]);
        const float xc = cw0 * x3 + cw1 * x2 + cw2 * x1 + cw3 * xb + cb; x3 = x2; x2 = x1; x1 = xb;
        xcs[j] = xc; LDS_WAIT(); asm volatile("" ::: "memory");
        float ra = ba, rx = bx;
#pragma unroll 8
        for (int i = 0; i < 64; ++i) { const float xi = xcs[i]; ra += xi * wa[i * 64 + j]; rx += xi * wx[i * 64 + j]; }
        LDS_WAIT(); asm volatile("" ::: "memory");
        const float r = sigmoid_f(ra), ig = sigmoid_f(rx), log_a = 8.0f * r * lsl, aa = expf(log_a), u = sqrtf(-expm1f(2.0f * log_a)) * (ig * xc);
        hs = aa * hs + u;
        mix[row * DM + 512 + c] = (bf16)f2bf(hs * gelu_tanh_f(gb));
    }
}
__device__ __forceinline__ void p_diff_naive(Frame& F, const bf16* proj, bf16* o, float lambda_init) {
    LAS float* lut = (LAS float*)F.lds; LAS float* lam_s = lut + 132;
    const float* rel_bias = inp(F, 2); const float* lq1 = inp(F, 22); const float* lk1 = inp(F, 23); const float* lq2 = inp(F, 24); const float* lk2 = inp(F, 25); const float* subln = inp(F, 26);
    int k = 0;
    for (int u = blockIdx.x; u < NB * 8 * 32; u += F.G, ++k) {
        const int bh = u / 32, h = bh % 8, b = bh / 8; int tile = u % 32; if (k & 1) tile = 31 - tile;
        const int qi = F.tid >> 2, part = F.tid & 3, t = tile * 128 + qi;
        __syncthreads();
        if (F.tid < 129) { const int n = F.tid; int bk;
            if (n < 16) bk = n; else bk = 16 + (n >= 19) + (n >= 21) + (n >= 24) + (n >= 27) + (n >= 31) + (n >= 35) + (n >= 40) + (n >= 46) + (n >= 52) + (n >= 59) + (n >= 67) + (n >= 77) + (n >= 87) + (n >= 99) + (n >= 113);
            lut[n] = rel_bias[bk * 8 + h]; }
        if (F.tid == 0) { float s1 = 0.f, s2 = 0.f; for (int i = 0; i < 64; ++i) { s1 += lq1[i] * lk1[i]; s2 += lq2[i] * lk2[i]; } lam_s[0] = expf(s1) - expf(s2) + lambda_init; }
        __syncthreads();
        const float lam = lam_s[0];
        const size_t row = (size_t)b * SEQ + t;
        float q1[16], q2[16], a1[32], a2[32];
#pragma unroll
        for (int i = 0; i < 16; ++i) { q1[i] = bf2f(proj[row * ODD_IN + (2 * h) * 64 + part * 16 + i]); q2[i] = bf2f(proj[row * ODD_IN + (2 * h + 1) * 64 + part * 16 + i]); }
#pragma unroll
        for (int i = 0; i < 32; ++i) { a1[i] = 0.f; a2[i] = 0.f; }
        float m1 = -INFINITY, m2 = -INFINITY, l1 = 0.f, l2 = 0.f;
        const int tmax = tile * 128 + 127;
        for (int s = 0; s <= tmax; ++s) {
            const bf16* kr = proj + ((size_t)b * SEQ + s) * ODD_IN;
            const bf16x8 ka = *(const bf16x8*)(kr + 1024 + (2 * h) * 64 + part * 16), kb = *(const bf16x8*)(kr + 1024 + (2 * h) * 64 + part * 16 + 8);
            const bf16x8 kc = *(const bf16x8*)(kr + 1024 + (2 * h + 1) * 64 + part * 16), kd = *(const bf16x8*)(kr + 1024 + (2 * h + 1) * 64 + part * 16 + 8);
            float d1 = 0.f, d2 = 0.f;
#pragma unroll
            for (int i = 0; i < 8; ++i) { d1 += q1[i] * bf2f((bf16)ka[i]) + q1[8 + i] * bf2f((bf16)kb[i]); d2 += q2[i] * bf2f((bf16)kc[i]) + q2[8 + i] * bf2f((bf16)kd[i]); }
            d1 += __shfl_xor(d1, 1); d1 += __shfl_xor(d1, 2); d2 += __shfl_xor(d2, 1); d2 += __shfl_xor(d2, 2);
            if (s <= t) {
                const int rel = t - s; const float bias = lut[rel > 128 ? 128 : rel];
                const float z1 = d1 * 0.125f + bias, z2 = d2 * 0.125f + bias;
                const float n1 = fmaxf(m1, z1), n2 = fmaxf(m2, z2);
                const float s1 = expf(m1 - n1), s2 = expf(m2 - n2), p1 = expf(z1 - n1), p2 = expf(z2 - n2);
                l1 = l1 * s1 + p1; l2 = l2 * s2 + p2; m1 = n1; m2 = n2;
                const bf16* vr = kr + 2048 + h * 128 + part * 32;
#pragma unroll
                for (int c8 = 0; c8 < 4; ++c8) { const bf16x8 vv = *(const bf16x8*)(vr + 8 * c8);
#pragma unroll
                    for (int i = 0; i < 8; ++i) { const float vf = bf2f((bf16)vv[i]); a1[8 * c8 + i] = a1[8 * c8 + i] * s1 + p1 * vf; a2[8 * c8 + i] = a2[8 * c8 + i] * s2 + p2 * vf; } }
            }
        }
        const float r1 = 1.0f / l1, r2 = lam / l2; float ss = 0.f;
#pragma unroll
        for (int i = 0; i < 32; ++i) { a1[i] = a1[i] * r1 - a2[i] * r2; ss += a1[i] * a1[i]; }
        ss += __shfl_xor(ss, 1); ss += __shfl_xor(ss, 2);
        const float rstd = 1.0f / sqrtf(ss * (1.0f / 128.0f) + EPS) * (1.0f - lambda_init);
        bf16* op = o + row * DM + h * 128 + part * 32;
#pragma unroll
        for (int i = 0; i < 32; i += 2) *(unsigned*)(op + i) = pk2(a1[i] * rstd * subln[part * 32 + i], a1[i + 1] * rstd * subln[part * 32 + i + 1]);
    }
}

typedef float f32x16 __attribute__((ext_vector_type(16)));
typedef short v4i16_t __attribute__((ext_vector_type(4)));
constexpr float LOG2E = 1.4426950408889634f;
constexpr float QK_PRESCALE = 0.125f * LOG2E;
constexpr int ATTN_QSCALE_COLS = 1024; constexpr float ATTN_QSCALE = QK_PRESCALE;
__device__ __forceinline__ float max3f(float a, float b, float c) { float r; asm("v_max3_f32 %0, %1, %2, %3" : "=v"(r) : "v"(a), "v"(b), "v"(c)); return r; }
__device__ __forceinline__ float mov_s(float a) { float r; asm("v_mov_b32_e32 %0, %1" : "=v"(r) : "v"(a)); return r; }
__device__ __forceinline__ float fadd_s(float a, float b) { float r; asm("v_add_f32_e32 %0, %1, %2" : "=v"(r) : "v"(a), "v"(b)); return r; }
__device__ __forceinline__ int crow(int r, int hi) { return (r & 3) + 8 * (r >> 2) + 4 * hi; }
__device__ __forceinline__ float half_max(float v) { auto rr = __builtin_amdgcn_permlane32_swap(__float_as_uint(v), __float_as_uint(v), false, false); return fmaxf(__uint_as_float(rr[0]), __uint_as_float(rr[1])); }
__device__ __forceinline__ float half_sum(float v) { auto rr = __builtin_amdgcn_permlane32_swap(__float_as_uint(v), __float_as_uint(v), false, false); return __uint_as_float(rr[0]) + __uint_as_float(rr[1]); }
__device__ __forceinline__ unsigned cvtpk(float lo, float hi) { typedef float f2 __attribute__((ext_vector_type(2))); typedef __bf16 b2 __attribute__((ext_vector_type(2))); f2 v = {lo, hi}; b2 b = __builtin_convertvector(v, b2); return __builtin_bit_cast(unsigned, b); }
__device__ __forceinline__ bf16x8 vfrag(LAS const unsigned char* p0, LAS const unsigned char* p1) {
    const v4i16_t lo = __builtin_amdgcn_ds_read_tr16_b64_v4i16((LAS v4i16_t*)p0), hi = __builtin_amdgcn_ds_read_tr16_b64_v4i16((LAS v4i16_t*)p1);
    return (bf16x8){lo[0], lo[1], lo[2], lo[3], hi[0], hi[1], hi[2], hi[3]};
}
constexpr int DA_KRING = 0, DA_KSLOT = 16384, DA_VRING = 49152, DA_VSLOT = 16384, DA_LUT = 131072 + 1024, DA_SLN = 131072 + 2560, DA_QF = 98304, DA_OST = 65536, DA_OROW = 264;
constexpr float DA_THR = 8.0f;

#ifndef MK_DIAG_SEL
#define MK_DIAG_SEL -1
#endif
#if MK_DIAG_SEL >= 0
#define DIAG_T(v) do { v = __builtin_amdgcn_s_memtime(); } while (0)
#define DIAG_ACC(k, t1, t0) do { dg[k] += (t1) - (t0); } while (0)
#else
#define DIAG_T(v) do { } while (0)
#define DIAG_ACC(k, t1, t0) do { } while (0)
#endif
__device__ __forceinline__ float da_maxall(const f32x16& a, const f32x16& b) {
    float mxa = max3f(a[0], a[1], b[0]), mxb = max3f(a[2], a[3], b[1]); mxa = max3f(mxa, b[2], b[3]);
#pragma unroll
    for (int r = 4; r < 16; r += 4) { mxa = max3f(mxa, a[r], a[r + 1]); mxb = max3f(mxb, a[r + 2], a[r + 3]); mxa = max3f(mxa, b[r], b[r + 1]); mxb = max3f(mxb, b[r + 2], b[r + 3]); }
    return max3f(mxa, mxb, mxb);
}
#define DA_MAXALL(a, b) da_maxall(a, b)
__device__ __forceinline__ void p_diff_attn(Frame& F, const bf16* proj, bf16* o, float lambda_init) {
    unsigned long long dg[6] = {0, 0, 0, 0, 0, 0}; unsigned long long ta = 0, tb = 0, tc = 0, td = 0; (void)ta; (void)tb; (void)tc; (void)td; (void)dg;
    const float* rel_bias = inp(F, 2); const float* lq1 = inp(F, 22); const float* lk1 = inp(F, 23); const float* lq2 = inp(F, 24); const float* lk2 = inp(F, 25); const float* subln = inp(F, 26);
    const int lane0 = F.lane, wave = F.wave, w4 = wave & 3, map = wave >> 2;
    LAS unsigned char* L = F.lds;
    LAS float* lut = (LAS float*)(L + DA_LUT) + 128;
    float lam;
    { float s1 = lq1[lane0] * lk1[lane0], s2 = lq2[lane0] * lk2[lane0]; s1 = wave_sum(s1); s2 = wave_sum(s2); lam = expf(s1) - expf(s2) + lambda_init; }
    const int G = F.G; const int bx = blockIdx.x; const int vcu0 = (G % 8 == 0) ? (bx % 8) * (G / 8) + bx / 8 : bx;
#define DA_WAITBAR(n) do { asm volatile("s_waitcnt vmcnt(" #n ") lgkmcnt(0)" ::: "memory"); __builtin_amdgcn_s_barrier(); asm volatile("" ::: "memory"); } while (0)
#define DA_WAITBAR_N(cnt) do { if ((cnt) >= 6) DA_WAITBAR(6); else if ((cnt) == 4) DA_WAITBAR(4); else if ((cnt) == 2) DA_WAITBAR(2); else DA_WAITBAR(0); } while (0)
    LAS float* sln = (LAS float*)(L + DA_SLN);
    __syncthreads();
    if (F.tid < 128) sln[F.tid] = subln[F.tid];
    for (int vcu = vcu0; vcu < 256; vcu += G) {
        const int xg = vcu >> 5, jl = vcu & 31;
        for (int k = 0; k < 8; ++k) {
            const int bh = xg * 8 + k, h = bh & 7, b = bh >> 3, qb = (k & 1) ? 31 - jl : jl;
            int lane_u = lane0; asm volatile("" : "+v"(lane_u));
            const int lane = lane_u, r32 = lane & 31, hi = lane >> 5;
            const int q4 = (lane & 15) >> 2, p4 = lane & 3, blk = (lane >> 4) & 1;
            const int vb0 = 64 * (4 * hi + q4) + 16 * ((2 * blk + (p4 >> 1)) ^ hi) + 8 * (p4 & 1);
            const int vb1 = 2048 + 64 * (4 * hi + q4) + 16 * ((2 * blk + (p4 >> 1)) ^ (2 + hi)) + 8 * (p4 & 1);
            const int vkey = 8 * wave + ((lane >> 2) & 7);
            const int vch0 = 4 * (lane >> 5) + ((lane & 3) ^ (2 * (wave & 1) + ((lane >> 4) & 1)));
            const int q0w = qb * 128 + 32 * w4, head = 2 * h + map;
            const int nkt = 2 * qb + 2, my_last = 2 * qb + (w4 >= 2 ? 1 : 0);
            __syncthreads();
            if (F.tid < 384) { int n = F.tid - 128; asm volatile("" : "+v"(n)); int bk;
                if (n < 16) bk = max(n, 0); else bk = 16 + (n >= 19) + (n >= 21) + (n >= 24) + (n >= 27) + (n >= 31) + (n >= 35) + (n >= 40) + (n >= 46) + (n >= 52) + (n >= 59) + (n >= 67) + (n >= 77) + (n >= 87) + (n >= 99) + (n >= 113);
                const float bv = rel_bias[bk * 8 + h] * LOG2E; lut[n] = n < 0 ? -INFINITY : bv; }
            const bf16* kvbase = proj + (size_t)b * SEQ * ODD_IN;
            bf16x8 qf[4];
            { const bf16* qp = kvbase + (size_t)(q0w + r32) * ODD_IN + head * 64 + 8 * hi;
#pragma unroll
              for (int d0 = 0; d0 < 4; ++d0) qf[d0] = *(const bf16x8*)(qp + 16 * d0); }
            const int krow = 8 * wave + (lane >> 3), kch = (lane & 7) ^ ((krow >> 1) & 7);
            const unsigned ko0 = (unsigned)(krow * ODD_IN + 1024 + (2 * h) * 64 + 8 * kch) * 2u, ko1 = ko0 + 128u;
            const unsigned vo0 = (unsigned)(vkey * ODD_IN + 2048 + h * 128 + 8 * vch0) * 2u, vo1 = vo0 + 128u;
#define DA_ISSUE_K(kt) do { const char* gb_ = (const char*)kvbase + (size_t)(kt) * 64 * ODD_IN * 2; LAS unsigned char* sb_ = L + DA_KRING + ((kt) % 3) * DA_KSLOT; \
            __builtin_amdgcn_global_load_lds((const unsigned*)(gb_ + ko0), (LAS unsigned*)(sb_ + wave * 1024), 16, 0, 0); \
            __builtin_amdgcn_global_load_lds((const unsigned*)(gb_ + ko1), (LAS unsigned*)(sb_ + 8192 + wave * 1024), 16, 0, 0); } while (0)
#define DA_ISSUE_V(kt) do { const char* gb_ = (const char*)kvbase + (size_t)(kt) * 64 * ODD_IN * 2; LAS unsigned char* sb_ = L + DA_VRING + ((kt) % 3) * DA_VSLOT; \
            __builtin_amdgcn_global_load_lds((const unsigned*)(gb_ + vo0), (LAS unsigned*)(sb_ + wave * 2048), 16, 0, 0); \
            __builtin_amdgcn_global_load_lds((const unsigned*)(gb_ + vo1), (LAS unsigned*)(sb_ + wave * 2048 + 1024), 16, 0, 0); } while (0)
            DA_ISSUE_K(0); DA_ISSUE_V(0); DA_ISSUE_K(1); DA_ISSUE_V(1); if (2 < nkt) DA_ISSUE_K(2);
            f32x16 oacc[4];
#pragma unroll
            for (int c = 0; c < 4; ++c)
#pragma unroll
                for (int r = 0; r < 16; ++r) oacc[c][r] = 0.f;
            float mref = 0.f, lrun = 0.f; bool first = true;
            f32x16 s0, s1;
#define DA_SB() __builtin_amdgcn_sched_barrier(0)
#define DA_LDKQ(t) do { LAS const unsigned char* kb_ = L + DA_KRING + ((t) % 3) * DA_KSLOT + map * 8192 + r32 * 128; const int sw_ = (r32 >> 1) & 7; \
                _Pragma("unroll") for (int d0 = 0; d0 < 4; ++d0) { const int co_ = ((2 * d0 + hi) ^ sw_) << 4; kf[2 * d0] = *(LAS const bf16x8*)(kb_ + co_); kf[2 * d0 + 1] = *(LAS const bf16x8*)(kb_ + co_ + 4096); } } while (0)
#define DA_QKM(t, S0, S1) do { const bool farq_ = (q0w - (64 * (t) + 63) >= 128); const float ci_ = (farq_ ? lut[128] : 0.f) - mref; \
                _Pragma("unroll") for (int r = 0; r < 16; ++r) { S0[r] = ci_; S1[r] = ci_; } \
                _Pragma("unroll") for (int d0 = 0; d0 < 4; ++d0) { \
                    S0 = __builtin_amdgcn_mfma_f32_32x32x16_bf16(kf[2 * d0], qf[d0], S0, 0, 0, 0); \
                    S1 = __builtin_amdgcn_mfma_f32_32x32x16_bf16(kf[2 * d0 + 1], qf[d0], S1, 0, 0, 0); } } while (0)
#define DA_LDV(c, dst) do { _Pragma("unroll") for (int s = 0; s < 4; ++s) { \
                asm volatile("ds_read_b64_tr_b16 %0, %1 offset:%c2" : "=&v"(dst##l[s]) : "v"(vp0u), "i"(4096 * s + 512 * (c)) : "memory"); \
                asm volatile("ds_read_b64_tr_b16 %0, %1 offset:%c2" : "=&v"(dst##h[s]) : "v"(vp1u), "i"(4096 * s + 512 * (c)) : "memory"); } } while (0)
#define DA_VF(dst, s) (bf16x8){dst##l[s][0], dst##l[s][1], dst##l[s][2], dst##l[s][3], dst##h[s][0], dst##h[s][1], dst##h[s][2], dst##h[s][3]}
#define DA_LWAIT(n) do { asm volatile("s_waitcnt lgkmcnt(" #n ")" ::: "memory"); DA_SB(); } while (0)
            bf16x8 kf[8];
            DA_WAITBAR(0);
            DA_LDKQ(0); DA_SB(); DA_QKM(0, s0, s1); DA_SB();
            asm volatile("s_nop 15\n\ts_nop 7" : "+v"(s0), "+v"(s1));
            float mx_pre = DA_MAXALL(s0, s1);
#pragma unroll 1
            for (int t = 0; t < nkt; ++t) {
                if (t > 0) { const int fly = 2 * ((t + 2 < nkt ? 1 : 0) + (t + 1 < nkt ? 1 : 0)); DA_WAITBAR_N(fly); }
                if (t + 3 < nkt) DA_ISSUE_K(t + 3);
                if (t + 2 < nkt) DA_ISSUE_V(t + 2);
                DA_LDKQ(t + 1);
                DA_SB();
                const int k0_ = 64 * t;
                float mx;
                if (!(q0w - (k0_ + 63) >= 128)) { int lq_ = lane; asm volatile("" : "+v"(lq_));
                    const int relb = q0w + (lq_ & 31) - k0_ - 4 * (lq_ >> 5);
                    LAS const float* bp = lut + (relb - 59); { unsigned bpu = (unsigned)(size_t)bp; asm volatile("" : "+v"(bpu)); bp = (LAS const float*)bpu; }
#pragma unroll
                    for (int r = 0; r < 16; ++r) { const int c = (r & 3) + 8 * (r >> 2); s0[r] += bp[59 - c]; s1[r] += bp[27 - c]; }
                    mx = DA_MAXALL(s0, s1); }
                else mx = mx_pre;
                mx = half_max(mx);
                if (first || __any(mx > DA_THR)) {
                    const float dl = first ? mx : fmaxf(mx, 0.f); const float al = __builtin_amdgcn_exp2f(-dl);
                    mref += dl; lrun *= al;
#pragma unroll
                    for (int c = 0; c < 4; ++c)
#pragma unroll
                        for (int r = 0; r < 16; ++r) oacc[c][r] *= al;
#pragma unroll
                    for (int r = 0; r < 16; ++r) { s0[r] -= dl; s1[r] -= dl; }
                    first = false; }
                DA_SB();
                f32x16 n0, n1;
                DA_QKM(t + 1, n0, n1);
#pragma unroll
                for (int r = 0; r < 16; ++r) { s0[r] = __builtin_amdgcn_exp2f(s0[r]); s1[r] = __builtin_amdgcn_exp2f(s1[r]); }
#pragma unroll
                for (int i = 0; i < 8; ++i) { __builtin_amdgcn_sched_group_barrier(0x008, 1, 0); __builtin_amdgcn_sched_group_barrier(0x400, 4, 0); }
                DA_SB();
                asm volatile("s_nop 1" : "+v"(s0), "+v"(s1));
                unsigned vp0u = (unsigned)(size_t)(L + DA_VRING + (t % 3) * DA_VSLOT) + (unsigned)vb0, vp1u = vp0u - (unsigned)vb0 + (unsigned)vb1;
                asm volatile("" : "+v"(vp0u), "+v"(vp1u));
                v4i16_t val[4], vah[4], vnl[4], vnh[4], vml[4], vmh[4];
                DA_LDV(0, va); DA_LDV(1, vn);
                DA_SB();
                bf16x8 pw[4];
                { v4u w;
                  w.x = cvtpk(s0[0], s0[1]); w.y = cvtpk(s0[2], s0[3]); w.z = cvtpk(s0[4], s0[5]); w.w = cvtpk(s0[6], s0[7]); pw[0] = __builtin_bit_cast(bf16x8, w);
                  w.x = cvtpk(s0[8], s0[9]); w.y = cvtpk(s0[10], s0[11]); w.z = cvtpk(s0[12], s0[13]); w.w = cvtpk(s0[14], s0[15]); pw[1] = __builtin_bit_cast(bf16x8, w); }
                DA_SB();
                float lsa = 0.f, lsb = 0.f, mxa, mxb;
#define DA_PVA(acc, vf, s, r, EXTRA) do { acc = __builtin_amdgcn_mfma_f32_32x32x16_bf16(DA_VF(vf, s), pw[s], acc, 0, 0, 0); lsa = fadd_s(lsa, s0[r]); lsb = fadd_s(lsb, s1[r]); EXTRA; if ((r) > 0) { s0[(r) - 1] = mov_s(n0[(r) - 1]); s1[(r) - 1] = mov_s(n1[(r) - 1]); } DA_SB(); } while (0)
                DA_LDV(2, vm); DA_LWAIT(15);
                DA_PVA(oacc[0], va, 0, 0, { v4u w; w.x = cvtpk(s1[0], s1[1]); w.y = cvtpk(s1[2], s1[3]); w.z = cvtpk(s1[4], s1[5]); w.w = cvtpk(s1[6], s1[7]); pw[2] = __builtin_bit_cast(bf16x8, w); });
                DA_PVA(oacc[0], va, 1, 1, { v4u w; w.x = cvtpk(s1[8], s1[9]); w.y = cvtpk(s1[10], s1[11]); w.z = cvtpk(s1[12], s1[13]); w.w = cvtpk(s1[14], s1[15]); pw[3] = __builtin_bit_cast(bf16x8, w); });
                DA_PVA(oacc[0], va, 2, 2, );
                DA_PVA(oacc[0], va, 3, 3, { mxa = max3f(n0[0], n0[1], n1[0]); mxb = max3f(n0[2], n0[3], n1[1]); });
                DA_LDV(3, va); DA_LWAIT(15);
                DA_PVA(oacc[1], vn, 0, 4, { mxa = max3f(mxa, n1[2], n1[3]); mxb = max3f(mxb, n0[6], n0[7]); });
                DA_PVA(oacc[1], vn, 1, 5, { mxa = max3f(mxa, n0[4], n0[5]); mxb = max3f(mxb, n1[6], n1[7]); });
                DA_PVA(oacc[1], vn, 2, 6, { mxa = max3f(mxa, n1[4], n1[5]); });
                DA_PVA(oacc[1], vn, 3, 7, { mxb = max3f(mxb, n0[10], n0[11]); });
                DA_LWAIT(8);
                DA_PVA(oacc[2], vm, 0, 8, { mxa = max3f(mxa, n0[8], n0[9]); });
                DA_PVA(oacc[2], vm, 1, 9, { mxb = max3f(mxb, n1[10], n1[11]); });
                DA_PVA(oacc[2], vm, 2, 10, { mxa = max3f(mxa, n1[8], n1[9]); });
                DA_PVA(oacc[2], vm, 3, 11, { mxb = max3f(mxb, n0[14], n0[15]); });
                DA_LWAIT(0);
                DA_PVA(oacc[3], va, 0, 12, { mxa = max3f(mxa, n0[12], n0[13]); });
                DA_PVA(oacc[3], va, 1, 13, { mxb = max3f(mxb, n1[14], n1[15]); });
                DA_PVA(oacc[3], va, 2, 14, { mxa = max3f(mxa, n1[12], n1[13]); });
                DA_PVA(oacc[3], va, 3, 15, { mx_pre = max3f(mxa, mxb, mxb); });
#undef DA_PVA
                lrun = fadd_s(lrun, fadd_s(lsa, lsb));
                s0[15] = mov_s(n0[15]); s1[15] = mov_s(n1[15]);
            }
#undef DA_SB
#undef DA_LDKQ
#undef DA_QKM
#undef DA_LDV
#undef DA_VF
#undef DA_LWAIT
#undef DA_ISSUE_K
#undef DA_ISSUE_V
            {
            int lane_e = lane; asm volatile("" : "+v"(lane_e));
            const int r32 = lane_e & 31, hi = lane_e >> 5, lane = lane_e;
            const float ltot = half_sum(lrun);
            const float rl = (map == 0 ? 1.0f : lam) / ltot;
#pragma unroll
            for (int c = 0; c < 4; ++c)
#pragma unroll
                for (int r = 0; r < 16; ++r) oacc[c][r] *= rl;
            __syncthreads();
            LAS f32x4* cb = (LAS f32x4*)(L + w4 * 16384) + lane;
            if (map == 1) {
#pragma unroll
                for (int c = 0; c < 4; ++c)
#pragma unroll
                    for (int g = 0; g < 4; ++g) cb[(c * 4 + g) * 64] = (f32x4){oacc[c][4 * g], oacc[c][4 * g + 1], oacc[c][4 * g + 2], oacc[c][4 * g + 3]};
            }
            __syncthreads();
            if (map == 0) {
                float ss = 0.f;
#pragma unroll
                for (int c = 0; c < 4; ++c)
#pragma unroll
                    for (int g = 0; g < 4; ++g) { const f32x4 tq = cb[(c * 4 + g) * 64];
                        oacc[c][4 * g] -= tq.x; oacc[c][4 * g + 1] -= tq.y; oacc[c][4 * g + 2] -= tq.z; oacc[c][4 * g + 3] -= tq.w;
                        ss += (oacc[c][4 * g] * oacc[c][4 * g] + oacc[c][4 * g + 1] * oacc[c][4 * g + 1]) + (oacc[c][4 * g + 2] * oacc[c][4 * g + 2] + oacc[c][4 * g + 3] * oacc[c][4 * g + 3]); }
                ss = half_sum(ss);
                const float rstd = (1.0f - lambda_init) / sqrtf(ss * (1.0f / 128.0f) + EPS);
                LAS unsigned char* st = L + DA_OST + w4 * (32 * DA_OROW);
#pragma unroll
                for (int c = 0; c < 4; ++c)
#pragma unroll
                    for (int g = 0; g < 4; ++g) { const int d = 32 * c + 8 * g + 4 * hi; const f32x4 sg = *(const LAS f32x4*)(sln + d);
                        const unsigned lo = cvtpk(oacc[c][4 * g] * rstd * sg.x, oacc[c][4 * g + 1] * rstd * sg.y), hi2 = cvtpk(oacc[c][4 * g + 2] * rstd * sg.z, oacc[c][4 * g + 3] * rstd * sg.w);
                        *(LAS unsigned long long*)(st + r32 * DA_OROW + d * 2) = (unsigned long long)lo | ((unsigned long long)hi2 << 32); }
                LDS_WAIT(); asm volatile("" ::: "memory");
                bf16* orow = o + ((size_t)b * SEQ + q0w) * DM + h * 128;
#pragma unroll
                for (int i = 0; i < 8; ++i) { const int idx = i * 64 + lane, row = idx >> 4, ch = idx & 15;
                    const unsigned long long a = *(LAS const unsigned long long*)(st + row * DA_OROW + ch * 16), bq = *(LAS const unsigned long long*)(st + row * DA_OROW + ch * 16 + 8);
                    v4u w; w.x = (unsigned)a; w.y = (unsigned)(a >> 32); w.z = (unsigned)bq; w.w = (unsigned)(bq >> 32);
                    *(GAS v4u*)(orow + (size_t)row * DM + ch * 8) = w; }
            }
            }
        }
    }
#undef DA_WAITBAR
#undef DA_WAITBAR_N
#if MK_DIAG_SEL >= 0
    if (blockIdx.x == 0 && F.wave == 0 && lane0 == 0) { float* dgo = (float*)(F.ws + WS_CTL + 65536); const float n = (float)dg[4];
        dgo[0] = (float)dg[0] / n; dgo[1] = (float)dg[1] / n; dgo[2] = (float)dg[2] / n; dgo[3] = (float)dg[3] / n; dgo[4] = n; }
#endif
}

constexpr size_t WS_HL = WS_H, WS_AC = WS_H + 32 * MiB;
constexpr size_t WS_SUMM = 3 * MiB;
constexpr int LRU_W = 512, NSEG = 32;
__device__ __forceinline__ float expm1_fast(float x) { const float p = x * (1.0f + x * (0.5f + x * (0.16666667f + x * (0.041666668f + x * 0.0083333338f)))); return x > -0.1f ? p : __expf(x) - 1.0f; }
__device__ __forceinline__ float fast_sigmoid(float z) { return __builtin_amdgcn_rcpf(1.0f + __expf(-z)); }
__device__ __forceinline__ void p_lru_local(Frame& F, const bf16* proj) {
    const float* conv_w = inp(F, 10); const float* conv_b = inp(F, 11); const float* ga_w = inp(F, 12); const float* ga_b = inp(F, 13); const float* gx_w = inp(F, 14); const float* gx_b = inp(F, 15); const float* lamp = inp(F, 16);
    const int lane = F.lane, r32 = lane & 31, hi = lane >> 5;
    const int g = blockIdx.x & 7;
    LAS unsigned char* WAl = F.lds;
    LAS float* Lc = (LAS float*)(F.lds + 16384);
    LAS float* cw = Lc; LAS float* cb = Lc + 256; LAS float* gab = Lc + 320; LAS float* gxb = Lc + 384; LAS float* lsl = Lc + 448;
    LAS float* hcs = (LAS float*)(F.lds + 20480 + F.wave * 512); LAS float* Acs = hcs + 64;
    __syncthreads();
    if (F.wave == 0) { const int c = g * 64 + lane;
      cw[lane] = conv_w[c]; cw[64 + lane] = conv_w[512 + c]; cw[128 + lane] = conv_w[1024 + c]; cw[192 + lane] = conv_w[1536 + c];
      cb[lane] = conv_b[c]; gab[lane] = ga_b[c]; gxb[lane] = gx_b[c]; lsl[lane] = logsig_f(lamp[c]); }
#pragma unroll
    for (int f2 = 0; f2 < 2; ++f2) { const int fi = 2 * F.wave + f2, rt = fi >> 2, ks = fi & 3;
        const float* wp = (rt < 2 ? ga_w : gx_w) + (size_t)g * 4096 + 32 * (rt & 1) + r32 + (16 * ks + 8 * hi) * 64; v4u w;
        w.x = cvtpk(wp[0], wp[64]); w.y = cvtpk(wp[128], wp[192]); w.z = cvtpk(wp[256], wp[320]); w.w = cvtpk(wp[384], wp[448]);
        *(LAS v4u*)(WAl + (fi * 64 + lane) * 16) = w; }
    __syncthreads();
    bf16x8 idf[2];
#pragma unroll
    for (int kk = 0; kk < 2; ++kk)
#pragma unroll
        for (int jj = 0; jj < 8; ++jj) idf[kk][jj] = (r32 == (16 * kk + 8 * hi + jj)) ? (short)0x3F80 : (short)0;
#define LRU_WA(rt, ks) (*(const LAS bf16x8*)(WAl + (((rt) * 4 + (ks)) * 64 + lane) * 16))
    bf16* HL = (bf16*)(F.ws + WS_HL); bf16* AC = (bf16*)(F.ws + WS_AC); float* SUMM = (float*)(F.ws + WS_SUMM);
    for (int item = (blockIdx.x >> 3) * 8 + F.wave; item < NB * NSEG; item += (F.G >> 3) * 8) {
        const int b = item / NSEG, seg = item % NSEG;
        hcs[lane] = 0.f; Acs[lane] = 1.f;
        LDS_WAIT(); asm volatile("" ::: "memory");
#pragma unroll 1
        for (int tile = 0; tile < 4; ++tile) {
            const int t = seg * 128 + tile * 32 + r32; const size_t row = (size_t)b * SEQ + t;
            bf16x8 Bf[4];
#pragma unroll
            for (int ks = 0; ks < 4; ++ks) { const int i0 = 16 * ks + 8 * hi; const bf16* xp = proj + row * EVEN_IN + 1536 + g * 64 + i0;
                float xc[8];
                { const f32x4 c0 = *(const LAS f32x4*)(cb + i0), c1 = *(const LAS f32x4*)(cb + i0 + 4); xc[0] = c0.x; xc[1] = c0.y; xc[2] = c0.z; xc[3] = c0.w; xc[4] = c1.x; xc[5] = c1.y; xc[6] = c1.z; xc[7] = c1.w; }
#pragma unroll
                for (int w = 0; w < 4; ++w) { const int back = 3 - w;
                    const bool inb = (t - back >= 0);
                    bf16x8 xv = *(const bf16x8*)(xp - (size_t)(inb ? back : 0) * EVEN_IN);
                    if (!inb) xv = (bf16x8){0, 0, 0, 0, 0, 0, 0, 0};
                    const f32x4 w0 = *(const LAS f32x4*)(cw + 64 * w + i0), w1 = *(const LAS f32x4*)(cw + 64 * w + i0 + 4);
                    xc[0] += w0.x * bf2f((bf16)xv[0]); xc[1] += w0.y * bf2f((bf16)xv[1]); xc[2] += w0.z * bf2f((bf16)xv[2]); xc[3] += w0.w * bf2f((bf16)xv[3]);
                    xc[4] += w1.x * bf2f((bf16)xv[4]); xc[5] += w1.y * bf2f((bf16)xv[5]); xc[6] += w1.z * bf2f((bf16)xv[6]); xc[7] += w1.w * bf2f((bf16)xv[7]); }
                v4u pk; pk.x = cvtpk(xc[0], xc[1]); pk.y = cvtpk(xc[2], xc[3]); pk.z = cvtpk(xc[4], xc[5]); pk.w = cvtpk(xc[6], xc[7]); Bf[ks] = __builtin_bit_cast(bf16x8, pk);
                __builtin_amdgcn_sched_barrier(0); }
#pragma unroll 1
            for (int rt2 = 0; rt2 < 2; ++rt2) {
                f32x16 Dr, Di, Dx;
#pragma unroll
                for (int r = 0; r < 16; ++r) { Dr[r] = 0.f; Di[r] = 0.f; Dx[r] = 0.f; }
#pragma unroll
                for (int ks = 0; ks < 4; ++ks) {
                    Dr = __builtin_amdgcn_mfma_f32_32x32x16_bf16(LRU_WA(rt2, ks), Bf[ks], Dr, 0, 0, 0);
                    Di = __builtin_amdgcn_mfma_f32_32x32x16_bf16(LRU_WA(2 + rt2, ks), Bf[ks], Di, 0, 0, 0);
                    if ((ks >> 1) == rt2) Dx = __builtin_amdgcn_mfma_f32_32x32x16_bf16(idf[ks & 1], Bf[ks], Dx, 0, 0, 0); }
                float av[16], hv[16];
#pragma unroll
                for (int a4 = 0; a4 < 4; ++a4) { const int ch = 32 * rt2 + 8 * a4 + 4 * hi;
                    const f32x4 ba = *(const LAS f32x4*)(gab + ch), bx = *(const LAS f32x4*)(gxb + ch), ls = *(const LAS f32x4*)(lsl + ch);
#pragma unroll
                    for (int q = 0; q < 4; ++q) { const int r = 4 * a4 + q;
                        const float rg = fast_sigmoid(Dr[r] + ba[q]), ig = fast_sigmoid(Di[r] + bx[q]);
                        const float log_a = 8.0f * rg * ls[q];
                        av[r] = __expf(log_a); hv[r] = __builtin_amdgcn_sqrtf(-expm1_fast(2.0f * log_a)) * (ig * Dx[r]); }
                    __builtin_amdgcn_sched_barrier(0); }
#define LRU_DPP(oldv, v, ctrl, rmask) __builtin_bit_cast(float, __builtin_amdgcn_update_dpp(__builtin_bit_cast(int, (float)(oldv)), __builtin_bit_cast(int, (float)(v)), (ctrl), (rmask), 0xf, false))
#define LRU_STEP(ctrl, rmask) do { _Pragma("unroll") for (int r = 0; r < 16; ++r) { const float ap = LRU_DPP(1.0f, av[r], ctrl, rmask), hp = LRU_DPP(0.0f, hv[r], ctrl, rmask); \
                        hv[r] = av[r] * hp + hv[r]; av[r] = av[r] * ap; } } while (0)
                LRU_STEP(0x111, 0xf); LRU_STEP(0x112, 0xf); LRU_STEP(0x114, 0xf); LRU_STEP(0x118, 0xf); LRU_STEP(0x142, 0xa);
#undef LRU_STEP
#undef LRU_DPP
                unsigned hp[4][2], ap[4][2];
#pragma unroll
                for (int a4 = 0; a4 < 4; ++a4) { const int ch = 32 * rt2 + 8 * a4 + 4 * hi;
                    const f32x4 hc = *(const LAS f32x4*)(hcs + ch), Ac = *(const LAS f32x4*)(Acs + ch);
                    f32x4 ho, ao;
#pragma unroll
                    for (int q = 0; q < 4; ++q) { const int r = 4 * a4 + q; ho[q] = hv[r] + av[r] * hc[q]; ao[q] = av[r] * Ac[q]; }
                    asm volatile("" ::: "memory");
                    if (r32 == 31) { *(LAS f32x4*)(hcs + ch) = ho; *(LAS f32x4*)(Acs + ch) = ao; }
                    hp[a4][0] = cvtpk(ho[0], ho[1]); hp[a4][1] = cvtpk(ho[2], ho[3]); ap[a4][0] = cvtpk(ao[0], ao[1]); ap[a4][1] = cvtpk(ao[2], ao[3]); }
#pragma unroll
                for (int k = 0; k < 2; ++k) {
#pragma unroll
                    for (int j = 0; j < 2; ++j) {
                        { auto r = __builtin_amdgcn_permlane32_swap(hp[2 * k][j], hp[2 * k + 1][j], false, false); hp[2 * k][j] = r[0]; hp[2 * k + 1][j] = r[1]; }
                        { auto r = __builtin_amdgcn_permlane32_swap(ap[2 * k][j], ap[2 * k + 1][j], false, false); ap[2 * k][j] = r[0]; ap[2 * k + 1][j] = r[1]; } }
                    const size_t o = row * LRU_W + g * 64 + 32 * rt2 + 16 * k + 8 * hi;
                    v4u wh, wa; wh.x = hp[2 * k][0]; wh.y = hp[2 * k][1]; wh.z = hp[2 * k + 1][0]; wh.w = hp[2 * k + 1][1];
                    wa.x = ap[2 * k][0]; wa.y = ap[2 * k][1]; wa.z = ap[2 * k + 1][0]; wa.w = ap[2 * k + 1][1];
                    *(GAS v4u*)(HL + o) = wh; *(GAS v4u*)(AC + o) = wa; }
                LDS_WAIT(); asm volatile("" ::: "memory");
            }
        }
        { float* sp = SUMM + ((size_t)(b * NSEG + seg) * 2) * LRU_W + g * 64; sp[lane] = Acs[lane]; sp[LRU_W + lane] = hcs[lane]; }
    }
#undef LRU_WA
}
__device__ __forceinline__ void p_lru_fix(Frame& F, const bf16* proj, bf16* mix) {
    const bf16* HL = (const bf16*)(F.ws + WS_HL); const bf16* AC = (const bf16*)(F.ws + WS_AC); const float* SUMM = (const float*)(F.ws + WS_SUMM);
    const int lane = F.lane;
    for (int u = F.gw; u < NB * NSEG * 8; u += F.NGW) {
        const int qt = u & 7, bs = u >> 3, b = bs / NSEG, seg = bs % NSEG;
        float c[8];
#pragma unroll
        for (int j = 0; j < 8; ++j) c[j] = 0.f;
        const float* sp0 = SUMM + ((size_t)(b * NSEG) * 2) * LRU_W + 8 * lane;
        int s = 0;
        for (; s + 4 <= seg; s += 4) {
            f32x4 a0[4], a1[4], h0[4], h1[4];
#pragma unroll
            for (int k = 0; k < 4; ++k) { const float* sp = sp0 + (size_t)(s + k) * 2 * LRU_W; a0[k] = *(const GAS f32x4*)sp; a1[k] = *(const GAS f32x4*)(sp + 4); h0[k] = *(const GAS f32x4*)(sp + LRU_W); h1[k] = *(const GAS f32x4*)(sp + LRU_W + 4); }
#pragma unroll
            for (int k = 0; k < 4; ++k) {
                c[0] = a0[k].x * c[0] + h0[k].x; c[1] = a0[k].y * c[1] + h0[k].y; c[2] = a0[k].z * c[2] + h0[k].z; c[3] = a0[k].w * c[3] + h0[k].w;
                c[4] = a1[k].x * c[4] + h1[k].x; c[5] = a1[k].y * c[5] + h1[k].y; c[6] = a1[k].z * c[6] + h1[k].z; c[7] = a1[k].w * c[7] + h1[k].w; } }
        for (; s < seg; ++s) { const float* sp = sp0 + (size_t)s * 2 * LRU_W;
            const f32x4 a0 = *(const GAS f32x4*)sp, a1 = *(const GAS f32x4*)(sp + 4), h0 = *(const GAS f32x4*)(sp + LRU_W), h1 = *(const GAS f32x4*)(sp + LRU_W + 4);
            c[0] = a0.x * c[0] + h0.x; c[1] = a0.y * c[1] + h0.y; c[2] = a0.z * c[2] + h0.z; c[3] = a0.w * c[3] + h0.w;
            c[4] = a1.x * c[4] + h1.x; c[5] = a1.y * c[5] + h1.y; c[6] = a1.z * c[6] + h1.z; c[7] = a1.w * c[7] + h1.w; }
#pragma unroll 4
        for (int i = 0; i < 16; ++i) {
            const size_t row = (size_t)b * SEQ + seg * 128 + qt * 16 + i;
            const bf16x8 hl = *(const bf16x8*)(HL + row * LRU_W + 8 * lane), ac = *(const bf16x8*)(AC + row * LRU_W + 8 * lane), gb = *(const bf16x8*)(proj + row * EVEN_IN + 2048 + 8 * lane);
            float y[8];
#pragma unroll
            for (int j = 0; j < 8; ++j) { const float g = bf2f((bf16)gb[j]); const float u2 = 1.5957691216057308f * (g + 0.044715f * g * g * g);
                y[j] = (bf2f((bf16)hl[j]) + bf2f((bf16)ac[j]) * c[j]) * (g * __builtin_amdgcn_rcpf(1.0f + __expf(-u2))); }
            v4u w; w.x = cvtpk(y[0], y[1]); w.y = cvtpk(y[2], y[3]); w.z = cvtpk(y[4], y[5]); w.w = cvtpk(y[6], y[7]);
            *(GAS v4u*)(mix + row * DM + 512 + 8 * lane) = w;
        }
    }
}

constexpr int SB_LDS0 = 32768;
constexpr float LN2 = 0.6931471805599453f;
#define SB_QSCALE_COLS 512
#define SB_QSCALE (0.125f * LOG2E)
constexpr float SB_STOP = -40.0f * LOG2E;
__device__ __forceinline__ void p_sb_attn(Frame& F, const bf16* proj, bf16* mix) {
    const int lane = F.lane, wave = F.wave, r32 = lane & 31, hi = lane >> 5;
    LAS unsigned char* Vw = F.lds + SB_LDS0 + wave * 8192;
    const int q4 = (lane & 15) >> 2, p4 = lane & 3, blk = (lane >> 4) & 1;
    const int vb0 = 64 * (4 * hi + q4) + 16 * ((2 * blk + (p4 >> 1)) ^ hi) + 8 * (p4 & 1);
    const int vb1 = 1024 + 64 * (4 * hi + q4) + 16 * ((2 * blk + (p4 >> 1)) ^ (2 + hi)) + 8 * (p4 & 1);
    const int vkl = (lane >> 2) & 7, vchE = 4 * (lane >> 5) + ((lane & 3) ^ ((lane >> 4) & 1)), vchO = 4 * (lane >> 5) + ((lane & 3) ^ (2 + ((lane >> 4) & 1)));
    const unsigned voE = (unsigned)(vkl * EVEN_IN + 8 * vchE) * 2u, voO = (unsigned)(vkl * EVEN_IN + 8 * vchO) * 2u;
    bf16x8 Tp[2], ONES;
#pragma unroll
    for (int ks = 0; ks < 2; ++ks)
#pragma unroll
        for (int jj = 0; jj < 8; ++jj) Tp[ks][jj] = ((16 * ks + 8 * (jj >> 2) + 4 * hi + (jj & 3)) > r32) ? (short)0x3F80 : (short)0;
#pragma unroll
    for (int jj = 0; jj < 8; ++jj) ONES[jj] = (short)0x3F80;
    for (int u = F.gw; u < NB * 8 * (SEQ / 32); u += F.NGW) {
        const int qt = u % (SEQ / 32), h = (u / (SEQ / 32)) % 8, b = u / (8 * (SEQ / 32)), qw = qt * 32;
        const bf16* base = proj + (size_t)b * SEQ * EVEN_IN;
        bf16x8 qf[4];
        { const bf16* qp = base + (size_t)(qw + r32) * EVEN_IN + h * 64 + 8 * hi;
#pragma unroll
          for (int d0 = 0; d0 < 4; ++d0) qf[d0] = *(const bf16x8*)(qp + 16 * d0); }
        f32x16 oacc[2];
#pragma unroll
        for (int c = 0; c < 2; ++c)
#pragma unroll
            for (int r = 0; r < 16; ++r) oacc[c][r] = 0.f;
        float R = 0.f;
        const int qpos = qw + r32;
#pragma unroll 1
        for (int k0 = ((qw + 30) >> 6) << 6; k0 >= 0; k0 -= 64) {
            LDS_WAIT();
            { const char* vg = (const char*)(base + (size_t)k0 * EVEN_IN + 1024 + h * 64);
#pragma unroll
              for (int p = 0; p < 8; ++p)
                  __builtin_amdgcn_global_load_lds((const unsigned*)(vg + (size_t)(8 * p) * EVEN_IN * 2 + ((p & 1) ? voO : voE)), (LAS unsigned*)(Vw + p * 1024), 16, 0, 0); }
            f32x16 p0, p1;
#pragma unroll
            for (int r = 0; r < 16; ++r) { p0[r] = 0.f; p1[r] = 0.f; }
            { const bf16* kp = base + (size_t)(k0 + r32) * EVEN_IN + 512 + h * 64 + 8 * hi;
#pragma unroll
              for (int d0 = 0; d0 < 4; ++d0) { const bf16x8 a0 = *(const bf16x8*)(kp + 16 * d0), a1 = *(const bf16x8*)(kp + (size_t)32 * EVEN_IN + 16 * d0);
                  p0 = __builtin_amdgcn_mfma_f32_32x32x16_bf16(a0, qf[d0], p0, 0, 0, 0);
                  p1 = __builtin_amdgcn_mfma_f32_32x32x16_bf16(a1, qf[d0], p1, 0, 0, 0); } }
            float Lsum = 0.f; bf16x8 Lh[4], Ll[4];
#define SB_SOFT(MASKED) \
            _Pragma("unroll") for (int half = 0; half < 2; ++half) { \
                float Lv[16]; \
                _Pragma("unroll") for (int r = 0; r < 16; ++r) { const float z = half ? p1[r] : p0[r]; \
                    const float sp = __builtin_amdgcn_logf(1.0f + __builtin_amdgcn_exp2f(-fabsf(z))); \
                    float lp = fminf(z, 0.f) - sp, lv = -fmaxf(z, 0.f) - sp; \
                    if (MASKED) { const bool valid = (k0 + 32 * half + crow(r, hi)) < qpos; lv = valid ? lv : 0.f; lp = valid ? lp : -INFINITY; } \
                    Lv[r] = lv; Lsum += lv; if (half) p1[r] = lp; else p0[r] = lp; } \
                _Pragma("unroll") for (int s = 0; s < 2; ++s) { v4u wh, wl; unsigned hv[4], lv[4]; \
                    _Pragma("unroll") for (int i = 0; i < 4; ++i) { const float x0 = Lv[8 * s + 2 * i], x1 = Lv[8 * s + 2 * i + 1]; hv[i] = cvtpk(x0, x1); \
                        const float r0 = x0 - __uint_as_float(hv[i] << 16), r1 = x1 - __uint_as_float(hv[i] & 0xffff0000u); lv[i] = cvtpk(r0, r1); } \
                    wh.x = hv[0]; wh.y = hv[1]; wh.z = hv[2]; wh.w = hv[3]; wl.x = lv[0]; wl.y = lv[1]; wl.z = lv[2]; wl.w = lv[3]; \
                    Lh[2 * half + s] = __builtin_bit_cast(bf16x8, wh); Ll[2 * half + s] = __builtin_bit_cast(bf16x8, wl); } }
            if (k0 + 63 >= qw) { SB_SOFT(1) } else { SB_SOFT(0) }
#undef SB_SOFT
            __builtin_amdgcn_sched_barrier(0);
            f32x16 l0, l1;
#pragma unroll
            for (int r = 0; r < 16; ++r) { l0[r] = R + p0[r]; l1[r] = R + p1[r]; }
#pragma unroll
            for (int ks = 0; ks < 2; ++ks) {
                l0 = __builtin_amdgcn_mfma_f32_32x32x16_bf16(Tp[ks], Lh[ks], l0, 0, 0, 0); l0 = __builtin_amdgcn_mfma_f32_32x32x16_bf16(Tp[ks], Ll[ks], l0, 0, 0, 0);
                l0 = __builtin_amdgcn_mfma_f32_32x32x16_bf16(ONES, Lh[2 + ks], l0, 0, 0, 0); l0 = __builtin_amdgcn_mfma_f32_32x32x16_bf16(ONES, Ll[2 + ks], l0, 0, 0, 0);
                l1 = __builtin_amdgcn_mfma_f32_32x32x16_bf16(Tp[ks], Lh[2 + ks], l1, 0, 0, 0); l1 = __builtin_amdgcn_mfma_f32_32x32x16_bf16(Tp[ks], Ll[2 + ks], l1, 0, 0, 0); }
            R += half_sum(Lsum);
            bf16x8 pw[4];
            { v4u w;
#define SBW(P, Lx, r) __builtin_amdgcn_exp2f(Lx[r])
              w.x = cvtpk(SBW(p0, l0, 0), SBW(p0, l0, 1)); w.y = cvtpk(SBW(p0, l0, 2), SBW(p0, l0, 3)); w.z = cvtpk(SBW(p0, l0, 4), SBW(p0, l0, 5)); w.w = cvtpk(SBW(p0, l0, 6), SBW(p0, l0, 7)); pw[0] = __builtin_bit_cast(bf16x8, w);
              w.x = cvtpk(SBW(p0, l0, 8), SBW(p0, l0, 9)); w.y = cvtpk(SBW(p0, l0, 10), SBW(p0, l0, 11)); w.z = cvtpk(SBW(p0, l0, 12), SBW(p0, l0, 13)); w.w = cvtpk(SBW(p0, l0, 14), SBW(p0, l0, 15)); pw[1] = __builtin_bit_cast(bf16x8, w);
              w.x = cvtpk(SBW(p1, l1, 0), SBW(p1, l1, 1)); w.y = cvtpk(SBW(p1, l1, 2), SBW(p1, l1, 3)); w.z = cvtpk(SBW(p1, l1, 4), SBW(p1, l1, 5)); w.w = cvtpk(SBW(p1, l1, 6), SBW(p1, l1, 7)); pw[2] = __builtin_bit_cast(bf16x8, w);
              w.x = cvtpk(SBW(p1, l1, 8), SBW(p1, l1, 9)); w.y = cvtpk(SBW(p1, l1, 10), SBW(p1, l1, 11)); w.z = cvtpk(SBW(p1, l1, 12), SBW(p1, l1, 13)); w.w = cvtpk(SBW(p1, l1, 14), SBW(p1, l1, 15)); pw[3] = __builtin_bit_cast(bf16x8, w);
#undef SBW
            }
            asm volatile("s_waitcnt vmcnt(0)" ::: "memory");
#pragma unroll
            for (int c = 0; c < 2; ++c) {
                bf16x8 va[4];
#pragma unroll
                for (int s = 0; s < 4; ++s) va[s] = vfrag(Vw + vb0 + 2048 * s + 512 * c, Vw + vb1 + 2048 * s + 512 * c);
#pragma unroll
                for (int s = 0; s < 4; ++s) oacc[c] = __builtin_amdgcn_mfma_f32_32x32x16_bf16(va[s], pw[s], oacc[c], 0, 0, 0);
            }
            if (__all(R < SB_STOP)) break;
        }
        bf16* op = mix + ((size_t)b * SEQ + qpos) * DM + h * 64 + 8 * hi;
#pragma unroll
        for (int c = 0; c < 2; ++c)
#pragma unroll
            for (int k = 0; k < 2; ++k) {
                unsigned ax = cvtpk(oacc[c][8 * k], oacc[c][8 * k + 1]), ay = cvtpk(oacc[c][8 * k + 2], oacc[c][8 * k + 3]);
                unsigned bx = cvtpk(oacc[c][8 * k + 4], oacc[c][8 * k + 5]), by = cvtpk(oacc[c][8 * k + 6], oacc[c][8 * k + 7]);
                { auto r = __builtin_amdgcn_permlane32_swap(ax, bx, false, false); ax = r[0]; bx = r[1]; }
                { auto r = __builtin_amdgcn_permlane32_swap(ay, by, false, false); ay = r[0]; by = r[1]; }
                v4u w; w.x = ax; w.y = ay; w.z = bx; w.w = by;
                *(GAS v4u*)(op + 32 * c + 16 * k) = w; }
    }
}

#ifndef MK_NAIVE_DIFF
#define MK_NAIVE_DIFF 0
#endif
constexpr int NPHASE = 19;
#ifndef MK_REP3_SUB
#define MK_REP3_SUB 0
#endif
#ifndef MK_REPEAT_PHASE
#define MK_REPEAT_PHASE -1
#endif
#ifndef MK_REPEAT_COUNT
#define MK_REPEAT_COUNT 2
#endif
#ifndef MK_NAIVE_MIX0
#define MK_NAIVE_MIX0 0
#endif
struct Args { const float* in[32]; float* out; unsigned char* ws; int ph_lo, ph_hi; float lambda_init; int pad; };
__global__ void __launch_bounds__(NWAVES * 64, 2) mk_fwd(Args args) {
    extern __shared__ __attribute__((aligned(16))) unsigned char lds[];
    Frame F;
    F.lds = (LAS unsigned char*)lds; F.MISC = (volatile LAS unsigned*)(F.lds + MISC_OFF);
    F.wave = __builtin_amdgcn_readfirstlane(threadIdx.x >> 6); F.lane = mk_lane(); F.tid = F.wave * 64 + F.lane;
    F.G = gridDim.x; F.gw = blockIdx.x * NWAVES + F.wave; F.NGW = F.G * NWAVES;
    F.out = args.out; F.ws = args.ws; F.ctl = (gu32*)(args.ws + WS_CTL);
    for (int u = F.tid; u < (LDS_BYTES - MISC_OFF) / 4; u += NWAVES * 64) ((LAS unsigned*)(F.lds + MISC_OFF))[u] = 0u;
    __syncthreads();
    if (F.tid < 32) ((LAS unsigned long long*)(F.lds + MISC_OFF + 512))[F.tid] = (unsigned long long)args.in[F.tid];
    __syncthreads();
    const int lo = args.ph_lo, hi = args.ph_hi;
    const bool one = (hi - lo) > 1;
    XcdBarrier bar; bar.bar = (unsigned*)(F.ctl + CW_BAR); bar.x = 0; bar.st = nullptr; bar.wave = F.wave;
    if (one) bar = xcd_barrier_post((unsigned*)(F.ctl + CW_BAR), F.MISC + 8, F.wave);
#define IN(k) (lo <= (k) && (k) < hi && ((F.lane = mk_lane()), (F.tid = F.wave * 64 + F.lane), true))
#define SEAM(k) do { if (IN(k) && IN((k) + 1)) xcd_barrier(bar); } while (0)
    unsigned char* ws = args.ws;
    float* xo = args.out;
    const float* mod0 = (const float*)(ws + WS_MOD); const float* mod1 = mod0 + (size_t)NB * 6144;
    bf16* H = (bf16*)(ws + WS_H); bf16* PROJ = (bf16*)(ws + WS_PROJ); bf16* MIX = (bf16*)args.out;                   bf16* ACT = (bf16*)(ws + WS_ACT); bf16* XB = (bf16*)(ws + WS_XB);
    const int G = F.G, cid = (int)blockIdx.x;

    if (IN(0)) for (int rep_ = 0; rep_ < ((MK_REPEAT_PHASE == 0) ? MK_REPEAT_COUNT : 1); ++rep_) { if (rep_ > 0) __syncthreads();  p_prologue(F); } SEAM(0);
    if (IN(1)) for (int rep_ = 0; rep_ < ((MK_REPEAT_PHASE == 1) ? MK_REPEAT_COUNT : 1); ++rep_) { if (rep_ > 0) __syncthreads();  p_norm_mod<false>(F, inp(F, 0), H, inp(F, 5), mod0, 0, 1024); } SEAM(1);
    if (IN(2)) for (int rep_ = 0; rep_ < ((MK_REPEAT_PHASE == 2) ? MK_REPEAT_COUNT : 1); ++rep_) { if (rep_ > 0) __syncthreads();  pg8::SchedPlain S; S.init(H, ws + WS_WIN0, MTOK, EVEN_IN, DM, G, cid); pg8::EpiStore E{(pg8::bf16_t*)PROJ, EVEN_IN, SB_QSCALE_COLS, SB_QSCALE};
                 pg8::gphase<pg8::EpiStore, pg8::SchedPlain, false>(F.lds, DM, S, E, F.wave, F.lane); } SEAM(2);
    if (IN(3)) for (int rep_ = 0; rep_ < ((MK_REPEAT_PHASE == 3) ? MK_REPEAT_COUNT : 1); ++rep_) { if (rep_ > 0) __syncthreads();
#if MK_NAIVE_MIX0
        if (F.wave == 0) { if (cid < NB * 8) p_lru_naive_wave(F, cid, PROJ, MIX); } else p_sb_naive(F, PROJ, MIX);
#else
        if (rep_ == 0 || MK_REP3_SUB != 2) p_lru_local(F, PROJ);
        if (rep_ == 0 || MK_REP3_SUB != 1) p_sb_attn(F, PROJ, MIX);
#endif
    } SEAM(3);
    if (IN(4)) for (int rep_ = 0; rep_ < ((MK_REPEAT_PHASE == 4) ? MK_REPEAT_COUNT : 1); ++rep_) { if (rep_ > 0) __syncthreads();
#if !MK_NAIVE_MIX0
        p_lru_fix(F, PROJ, MIX);
#endif
    } SEAM(4);

    if (IN(5)) for (int rep_ = 0; rep_ < ((MK_REPEAT_PHASE == 5) ? MK_REPEAT_COUNT : 1); ++rep_) { if (rep_ > 0) __syncthreads();  pg8::SchedPlain S; S.init(MIX, ws + WS_WOUT0, MTOK, DM, DM, G, cid); pg8::EpiResid<false> E{inp(F, 0), (pg8::bf16_t*)XB, mod0 + 2048, 6144, SEQ, DM, 0};
                 pg8::gphase<pg8::EpiResid<false>, pg8::SchedPlain, false>(F.lds, DM, S, E, F.wave, F.lane); } SEAM(5);
    if (IN(6)) for (int rep_ = 0; rep_ < ((MK_REPEAT_PHASE == 6) ? MK_REPEAT_COUNT : 1); ++rep_) { if (rep_ > 0) __syncthreads();  p_norm_mod<true>(F, XB, H, inp(F, 6), mod0, 3072, 4096); } SEAM(6);
    if (IN(7)) for (int rep_ = 0; rep_ < ((MK_REPEAT_PHASE == 7) ? MK_REPEAT_COUNT : 1); ++rep_) { if (rep_ > 0) __syncthreads();  pg8::SchedPlain S; S.init(H, ws + WS_WGU0, MTOK, 2 * FFD, DM, G, cid); pg8::EpiSwiglu E{(pg8::bf16_t*)ACT, FFD, 0};
                 pg8::gphase<pg8::EpiSwiglu, pg8::SchedPlain, false>(F.lds, DM, S, E, F.wave, F.lane); } SEAM(7);
    if (IN(8)) for (int rep_ = 0; rep_ < ((MK_REPEAT_PHASE == 8) ? MK_REPEAT_COUNT : 1); ++rep_) { if (rep_ > 0) __syncthreads();  pg8::SchedPlain S; S.init(ACT, ws + WS_WD0, MTOK, DM, FFD, G, cid); pg8::EpiResid<true> E{XB, (pg8::bf16_t*)XB, mod0 + 5120, 6144, SEQ, DM, 0};
                 pg8::gphase<pg8::EpiResid<true>, pg8::SchedPlain, false>(F.lds, FFD, S, E, F.wave, F.lane); } SEAM(8);
    if (IN(9)) for (int rep_ = 0; rep_ < ((MK_REPEAT_PHASE == 9) ? MK_REPEAT_COUNT : 1); ++rep_) { if (rep_ > 0) __syncthreads();  p_norm_mod<true>(F, XB, H, inp(F, 5) + DM, mod1, 0, 1024); } SEAM(9);
    if (IN(10)) for (int rep_ = 0; rep_ < ((MK_REPEAT_PHASE == 10) ? MK_REPEAT_COUNT : 1); ++rep_) { if (rep_ > 0) __syncthreads();  pg8::SchedPlain S; S.init(H, ws + WS_WIN1, MTOK, ODD_IN, DM, G, cid); pg8::EpiStore E{(pg8::bf16_t*)PROJ, ODD_IN, ATTN_QSCALE_COLS, ATTN_QSCALE};
                 pg8::gphase<pg8::EpiStore, pg8::SchedPlain, false>(F.lds, DM, S, E, F.wave, F.lane); } SEAM(10);
    if (IN(11)) for (int rep_ = 0; rep_ < ((MK_REPEAT_PHASE == 11) ? MK_REPEAT_COUNT : 1); ++rep_) { if (rep_ > 0) __syncthreads();
#if MK_NAIVE_DIFF
        p_diff_naive(F, PROJ, MIX, args.lambda_init);
#else
#ifdef MK_ATTN_VAR
        if (rep_ == 0) p_diff_attn(F, PROJ, MIX, args.lambda_init); else p_diff_attn_t<MK_ATTN_VAR>(F, PROJ, H, args.lambda_init);
#else
        p_diff_attn(F, PROJ, MIX, args.lambda_init);
#endif
#endif
    } SEAM(11);
    if (IN(12)) for (int rep_ = 0; rep_ < ((MK_REPEAT_PHASE == 12) ? MK_REPEAT_COUNT : 1); ++rep_) { if (rep_ > 0) __syncthreads();  pg8::SchedPlain S; S.init(MIX, ws + WS_WOUT1, MTOK, DM, DM, G, cid); pg8::EpiResid<true> E{XB, (pg8::bf16_t*)XB, mod1 + 2048, 6144, SEQ, DM, 0};
                  pg8::gphase<pg8::EpiResid<true>, pg8::SchedPlain, false>(F.lds, DM, S, E, F.wave, F.lane); } SEAM(12);
    if (IN(13)) for (int rep_ = 0; rep_ < ((MK_REPEAT_PHASE == 13) ? MK_REPEAT_COUNT : 1); ++rep_) { if (rep_ > 0) __syncthreads();  p_router(F, XB, H, inp(F, 6) + DM, mod1, 3072, 4096); } SEAM(13);
    int ntiles = 0;
    LAS int* mtab = (LAS int*)(F.lds + MISC_OFF + 256);
    if (hi > 14 && lo < 18) {
        int acc_t = 0;
#pragma unroll
        for (int e = 0; e < NEXP; ++e) { const int c = (int)__builtin_amdgcn_readfirstlane(__hip_atomic_load(F.ctl + CW_CNT + 64 * e, RLX_AGENT));
            if (F.tid == 0) { mtab[e] = acc_t; mtab[16 + e] = c; } acc_t += (c + 255) >> 8; }
        if (F.tid == 0) mtab[8] = acc_t;
        ntiles = acc_t;
        __syncthreads();
    }
    const int nA = ntiles < MOE_CHUNK_TILES ? ntiles : MOE_CHUNK_TILES, nAB = ntiles < 2 * MOE_CHUNK_TILES ? ntiles : 2 * MOE_CHUNK_TILES, nB = nAB - nA, nO = ntiles - nAB;
    const bool fancy = (G == 256) && nO > 0 && nB == MOE_CHUNK_TILES;
    const int nd = fancy ? 4 * nO : 0;
    const int* list = (const int*)(ws + WS_LIST);
#define MOE_SCHED(S, Aptr, Wptr, Kk, gat, t0_, nM_, nN_, ovfat_, mode_) pg8::SchedMoe S; S.A = (const char*)(Aptr); S.W = (const char*)(Wptr); S.wstride = WMOE_STRIDE; S.list = list; S.cap = LIST_CAP; S.tab = mtab; \
        S.t0 = (t0_); S.K = (Kk); S.gather = (gat); S.ovf_at = (ovfat_); S.ovf_tile0 = 2 * MOE_CHUNK_TILES; S.mode = (mode_); S.nd = nd; S.rounds = ((nM_) * (nN_) + G - 1) / G; S.so.init((nM_) * 256, (nN_) * 256, G, cid)
    if (IN(14)) for (int rep_ = 0; rep_ < ((MK_REPEAT_PHASE == 14) ? MK_REPEAT_COUNT : 1); ++rep_) { if (rep_ > 0) __syncthreads();  MOE_SCHED(S, H, ws + WS_WMOE, DM, 1, 0, nA + (fancy ? nO : 0), 2 * FFE / 256, nA, 0);
                  pg8::EpiSwiglu E{(pg8::bf16_t*)ACT, FFE, 0};
                  pg8::gphase<pg8::EpiSwiglu, pg8::SchedMoe, true>(F.lds, DM, S, E, F.wave, F.lane); } SEAM(14);
    if (IN(15)) for (int rep_ = 0; rep_ < ((MK_REPEAT_PHASE == 15) ? MK_REPEAT_COUNT : 1); ++rep_) { if (rep_ > 0) __syncthreads();  MOE_SCHED(S, ACT, ws + WS_WMOE + WMOE_D_OFF, FFE, 0, 0, nA, DM / 256, 1 << 30, 0);
                  pg8::EpiMoeDown E{(pg8::bf16_t*)xo, list, LIST_CAP};
                  pg8::gphase<pg8::EpiMoeDown, pg8::SchedMoe, false>(F.lds, FFE, S, E, F.wave, F.lane); } SEAM(15);
    if (IN(16)) for (int rep_ = 0; rep_ < ((MK_REPEAT_PHASE == 16) ? MK_REPEAT_COUNT : 1); ++rep_) { if (rep_ > 0) __syncthreads();  if (fancy) { MOE_SCHED(S, ACT, ws + WS_WMOE + WMOE_D_OFF, FFE, 0, 0, nO, DM / 256, MOE_CHUNK_TILES, 2);
                      pg8::EpiMoeDown E{(pg8::bf16_t*)xo, list, LIST_CAP};
                      pg8::gphase<pg8::EpiMoeDown, pg8::SchedMoe, false>(F.lds, FFE, S, E, F.wave, F.lane); }
                  { MOE_SCHED(S, H, ws + WS_WMOE, DM, 1, nA, nB + (fancy ? 0 : nO), 2 * FFE / 256, 1 << 30, fancy ? 1 : 0);
                    pg8::EpiSwiglu E{(pg8::bf16_t*)ACT, FFE, 0};
                    pg8::gphase<pg8::EpiSwiglu, pg8::SchedMoe, true>(F.lds, DM, S, E, F.wave, F.lane); } } SEAM(16);
    if (IN(17)) for (int rep_ = 0; rep_ < ((MK_REPEAT_PHASE == 17) ? MK_REPEAT_COUNT : 1); ++rep_) { if (rep_ > 0) __syncthreads();  MOE_SCHED(S, ACT, ws + WS_WMOE + WMOE_D_OFF, FFE, 0, nA, nB + (fancy ? 0 : nO), DM / 256, 1 << 30, 0);
                  pg8::EpiMoeDown E{(pg8::bf16_t*)xo, list, LIST_CAP};
                  pg8::gphase<pg8::EpiMoeDown, pg8::SchedMoe, false>(F.lds, FFE, S, E, F.wave, F.lane); } SEAM(17);
#undef MOE_SCHED
    if (IN(18)) for (int rep_ = 0; rep_ < ((MK_REPEAT_PHASE == 18) ? MK_REPEAT_COUNT : 1); ++rep_) { if (rep_ > 0) __syncthreads();  p_final(F, XB, mod1 + 5120, inp(F, 7)); }
#undef IN
#undef SEAM
}

#ifndef MK_ONE_LAUNCH
#define MK_ONE_LAUNCH 1
#endif
extern "C" void kernel_launch(void* const* d_in, const int* in_sizes, int n_in, void* d_out, int out_size, void* d_ws, size_t ws_size, hipStream_t stream) {
    static int grid = 0;
    if (grid == 0) {
        int dev = 0, cus = 0;
        if (hipGetDevice(&dev) != hipSuccess || hipDeviceGetAttribute(&cus, hipDeviceAttributeMultiprocessorCount, dev) != hipSuccess) { grid = -1; return; }
        if (n_in != 32 || ws_size < WS_END) { fprintf(stderr, "kernel_launch: unexpected n_in %d / ws %zu\n", n_in, ws_size); grid = -1; return; }
        if (hipFuncSetAttribute((const void*)mk_fwd, hipFuncAttributeMaxDynamicSharedMemorySize, LDS_BYTES) != hipSuccess) { grid = -1; return; }
        grid = cus;
    }
    if (grid < 0) return;
    (void)hipMemsetAsync((char*)d_ws + WS_CTL, 0, CTL_ZERO_BYTES, stream);
    Args a{};
    for (int i = 0; i < 32; ++i) a.in[i] = (const float*)d_in[i];
    a.out = (float*)d_out; a.ws = (unsigned char*)d_ws; a.lambda_init = (float)(0.8 - 0.6 * exp(-0.3 * 1.0)); a.pad = 0;
#if MK_ONE_LAUNCH
    a.ph_lo = 0; a.ph_hi = NPHASE;
    hipLaunchKernelGGL(mk_fwd, dim3(grid), dim3(NWAVES * 64), LDS_BYTES, stream, a);
#else
    for (int p = 0; p < NPHASE; ++p) { a.ph_lo = p; a.ph_hi = p + 1; hipLaunchKernelGGL(mk_fwd, dim3(grid), dim3(NWAVES * 64), LDS_BYTES, stream, a); }
#endif
}
```

```cpp
#include <hip/hip_runtime.h>
#include <cstdio>
#include <cstdint>
#include <cmath>
namespace pg8 {
#define PG8_LAS __attribute__((address_space(3)))
typedef unsigned short bf16_t;
typedef short bf16x8 __attribute__((ext_vector_type(8)));
typedef float f32x4 __attribute__((ext_vector_type(4)));
typedef unsigned u32x4 __attribute__((ext_vector_type(4)));
constexpr int BM = 256, BK = 64, HALF = 128, HTB = HALF * BK * 2  , STAGE_BYTES = 8 * HTB, NXCD = 8, WGM = 8;

__host__ __device__ __forceinline__ int lds_byte(int r, int c) { const int st = (r >> 4) * 2 + (c >> 5), rr = r & 15, cc = c & 31, ob = rr * 64 + cc * 2; return st * 1024 + (ob ^ (((ob >> 9) & 1) << 5)); }
__host__ __device__ __forceinline__ void stage_rc(int b, int& R, int& C) { const int st = b / 1024, sb = b % 1024, swz = sb ^ (((sb >> 9) & 1) << 5); R = (st >> 1) * 16 + swz / 64; C = (st & 1) * 32 + (swz % 64) / 2; }
__host__ __device__ __forceinline__ int perm32(int rho) { const int n = rho >> 4, i = rho & 15; return 8 * (i >> 2) + 4 * n + (i & 3); }

struct Unit { int pm, pn; };
struct Gemm { const bf16_t* A; const bf16_t* Bt; int M, N, K, pad; };

struct StaticOrder {
    int nM, nN, nwg, G, c;
    __host__ __device__ void init(int M, int N, int G_, int c_) { nM = M / BM; nN = N / BM; nwg = nM * nN; G = G_; c = c_; }
    __host__ __device__ bool next(int i, Unit& u) const {
        const long L = (long)i * G + c; if (L >= nwg) return false;
        int wgid = (int)L; { const int q = nwg / NXCD, r = nwg % NXCD, xcd = wgid % NXCD, off = wgid / NXCD; wgid = (xcd < r ? xcd * (q + 1) : r * (q + 1) + (xcd - r) * q) + off; }
        const int nig = WGM * nN, gid = wgid / nig, fm = gid * WGM, gsz = (nM - fm) < WGM ? (nM - fm) : WGM;
        u.pm = fm + ((wgid % nig) % gsz); u.pn = (wgid % nig) / gsz; return true;
    }
    __device__ __forceinline__ void a_ready(const Unit&) const {}
    __device__ __forceinline__ void done(const Unit&) const {}
};

__device__ __forceinline__ unsigned cvt_pk_bf16(float lo, float hi) { typedef float f2_ __attribute__((ext_vector_type(2))); typedef __bf16 b2_ __attribute__((ext_vector_type(2))); const f2_ v = {lo, hi}; const b2_ b = __builtin_convertvector(v, b2_); return __builtin_bit_cast(unsigned, b); }
typedef float f32x2 __attribute__((ext_vector_type(2)));
__device__ __forceinline__ f32x2 gelu_pk(f32x2 v) {
    const f32x2 av = __builtin_elementwise_abs(v), d = av * 0.2316418882f + 1.0f;
    f32x2 t; t.x = __builtin_amdgcn_rcpf(d.x); t.y = __builtin_amdgcn_rcpf(d.y);
    f32x2 q = t * 0.5307027145f + (-0.7265760135f); q = q * t + 0.7107068705f; q = q * t + (-0.142248368f); q = q * t + 0.127414796f; q = q * t;
    const f32x2 s = (v * v) * (-0.72134752044f);
    f32x2 e; e.x = __builtin_amdgcn_exp2f(s.x); e.y = __builtin_amdgcn_exp2f(s.y);
    const f32x2 m = v * (q * e), r = v - m;
    f32x2 o; o.x = v.x < 0.f ? m.x : r.x; o.y = v.y < 0.f ? m.y : r.y; return o;
}

template <int ACT  > struct EpiBf16 {
    static constexpr bool PERM = true, AFTER_DRAIN = false; static_assert(ACT == 0 || ACT == 1, "EpiBf16: ACT is 0 (none) or 1 (gelu_pk)");
    bf16_t* O; int ldc; const float* bias; int split_cols; size_t split_stride; float scale0;
    __device__ __forceinline__ void operator()(const f32x4 (&acc)[2][2][4][2], const Unit& u, int wr, int wc, int fr, int fq) const {
        const int row0 = u.pm * BM + wr * 64 + fr; int colt = u.pn * BM; bf16_t* base = O;
        float sc = 1.f; if (split_cols) { const int t = colt / split_cols; base += (size_t)t * split_stride; colt -= t * split_cols; if (t == 0) sc = scale0; }
        const int col0 = colt + wc * 32 + 8 * fq, bcol0 = u.pn * BM + wc * 32 + 8 * fq;
        f32x4 bv[2][2];
#pragma unroll
        for (int bj = 0; bj < 2; ++bj)
#pragma unroll
            for (int n = 0; n < 2; ++n) bv[bj][n] = bias ? *(const f32x4*)(bias + bcol0 + bj * HALF + 4 * n) : (f32x4){0.f, 0.f, 0.f, 0.f};
#pragma unroll
        for (int ai = 0; ai < 2; ++ai)
#pragma unroll
            for (int m = 0; m < 4; ++m) { bf16_t* rowp = base + (size_t)(row0 + ai * HALF + m * 16) * ldc + col0;
#pragma unroll
                for (int bj = 0; bj < 2; ++bj) { f32x4 v0 = acc[ai][bj][m][0] + bv[bj][0], v1 = acc[ai][bj][m][1] + bv[bj][1];
                    if (ACT == 1) { f32x2 a = gelu_pk((f32x2){v0[0], v0[1]}), b = gelu_pk((f32x2){v0[2], v0[3]}), c = gelu_pk((f32x2){v1[0], v1[1]}), d = gelu_pk((f32x2){v1[2], v1[3]});
                        v0 = (f32x4){a.x, a.y, b.x, b.y}; v1 = (f32x4){c.x, c.y, d.x, d.y}; }
                    v0 = v0 * sc; v1 = v1 * sc; u32x4 w; w.x = cvt_pk_bf16(v0[0], v0[1]); w.y = cvt_pk_bf16(v0[2], v0[3]); w.z = cvt_pk_bf16(v1[0], v1[1]); w.w = cvt_pk_bf16(v1[2], v1[3]);
                    *(u32x4*)(rowp + bj * HALF) = w; } }
    }
};
struct UnitX { int pm, pn; const char* A; const char* B; int e, nvalid, r0, pad; };
__device__ __forceinline__ float silu_f(float x) { return x * __builtin_amdgcn_rcpf(1.0f + __expf(-x)); }
template <bool XIN_BF16> struct EpiResid {
    static constexpr bool PERM = true, AFTER_DRAIN = false;
    const void* xin; bf16_t* xout; const float* gate; int gate_ld; int rows_per_batch; int ldc; int pad;
    __device__ __forceinline__ void operator()(const f32x4 (&acc)[2][2][4][2], const UnitX& u, int wr, int wc, int fr, int fq) const {
        const int row0 = u.pm * BM + wr * 64 + fr, col0 = u.pn * BM + wc * 32 + 8 * fq;
        const int b = (u.pm * BM) / rows_per_batch;
        f32x4 gv[2][2];
#pragma unroll
        for (int bj = 0; bj < 2; ++bj)
#pragma unroll
            for (int n = 0; n < 2; ++n) gv[bj][n] = *(const f32x4*)(gate + (size_t)b * gate_ld + col0 + bj * HALF + 4 * n);
#pragma unroll
        for (int ai = 0; ai < 2; ++ai)
#pragma unroll
            for (int m = 0; m < 4; ++m) { const int row = row0 + ai * HALF + m * 16; const size_t off = (size_t)row * ldc + col0;
#pragma unroll
                for (int bj = 0; bj < 2; ++bj) {
                    f32x4 x0, x1;
                    if constexpr (XIN_BF16) { const u32x4 xw = *(const u32x4*)((const bf16_t*)xin + off + bj * HALF);
                        x0 = (f32x4){__uint_as_float(xw.x << 16), __uint_as_float(xw.x & 0xffff0000u), __uint_as_float(xw.y << 16), __uint_as_float(xw.y & 0xffff0000u)};
                        x1 = (f32x4){__uint_as_float(xw.z << 16), __uint_as_float(xw.z & 0xffff0000u), __uint_as_float(xw.w << 16), __uint_as_float(xw.w & 0xffff0000u)}; }
                    else { x0 = *(const f32x4*)((const float*)xin + off + bj * HALF); x1 = *(const f32x4*)((const float*)xin + off + bj * HALF + 4); }
                    const f32x4 y0 = x0 + gv[bj][0] * acc[ai][bj][m][0], y1 = x1 + gv[bj][1] * acc[ai][bj][m][1];
                    u32x4 w; w.x = cvt_pk_bf16(y0[0], y0[1]); w.y = cvt_pk_bf16(y0[2], y0[3]); w.z = cvt_pk_bf16(y1[0], y1[1]); w.w = cvt_pk_bf16(y1[2], y1[3]);
                    *(u32x4*)(xout + off + bj * HALF) = w; } }
    }
};
struct EpiSwiglu {
    static constexpr bool PERM = true, AFTER_DRAIN = false;
    bf16_t* O; int ldc; int pad;
    __device__ __forceinline__ void operator()(const f32x4 (&acc)[2][2][4][2], const UnitX& u, int wr, int wc, int fr, int fq) const {
        const int row0 = u.pm * BM + wr * 64 + fr, col0 = u.pn * HALF + wc * 32 + 8 * fq;
#pragma unroll
        for (int ai = 0; ai < 2; ++ai)
#pragma unroll
            for (int m = 0; m < 4; ++m) { bf16_t* rowp = O + (size_t)(row0 + ai * HALF + m * 16) * ldc + col0;
                const f32x4 g0 = acc[ai][0][m][0], g1 = acc[ai][0][m][1], u0 = acc[ai][1][m][0], u1 = acc[ai][1][m][1];
                u32x4 w;
                w.x = cvt_pk_bf16(silu_f(g0[0]) * u0[0], silu_f(g0[1]) * u0[1]); w.y = cvt_pk_bf16(silu_f(g0[2]) * u0[2], silu_f(g0[3]) * u0[3]);
                w.z = cvt_pk_bf16(silu_f(g1[0]) * u1[0], silu_f(g1[1]) * u1[1]); w.w = cvt_pk_bf16(silu_f(g1[2]) * u1[2], silu_f(g1[3]) * u1[3]);
                *(u32x4*)rowp = w; }
    }
};
struct EpiStore {
    static constexpr bool PERM = true, AFTER_DRAIN = false;
    bf16_t* O; long ldc; int scale_cols; float scale;
    __device__ __forceinline__ void operator()(const f32x4 (&acc)[2][2][4][2], const UnitX& u, int wr, int wc, int fr, int fq) const {
        const int row0 = u.pm * BM + wr * 64 + fr, col0 = u.pn * BM + wc * 32 + 8 * fq;
        const float sc = (u.pn * BM < scale_cols) ? scale : 1.0f;
#pragma unroll
        for (int ai = 0; ai < 2; ++ai)
#pragma unroll
            for (int m = 0; m < 4; ++m) { bf16_t* rowp = O + (size_t)(row0 + ai * HALF + m * 16) * ldc + col0;
#pragma unroll
                for (int bj = 0; bj < 2; ++bj) { const f32x4 v0 = acc[ai][bj][m][0] * sc, v1 = acc[ai][bj][m][1] * sc; u32x4 w;
                    w.x = cvt_pk_bf16(v0[0], v0[1]); w.y = cvt_pk_bf16(v0[2], v0[3]); w.z = cvt_pk_bf16(v1[0], v1[1]); w.w = cvt_pk_bf16(v1[2], v1[3]);
                    *(u32x4*)(rowp + bj * HALF) = w; } }
    }
};
struct EpiMoeDown {
    static constexpr bool PERM = true, AFTER_DRAIN = false;
    bf16_t* Y; const int* list; long cap;
    __device__ __forceinline__ void operator()(const f32x4 (&acc)[2][2][4][2], const UnitX& u, int wr, int wc, int fr, int fq) const {
        const int col0 = u.pn * BM + wc * 32 + 8 * fq;
        const int* lp = list + (size_t)u.e * cap + u.r0;
#pragma unroll
        for (int ai = 0; ai < 2; ++ai)
#pragma unroll
            for (int m = 0; m < 4; ++m) { const int r = ai * HALF + wr * 64 + m * 16 + fr;
                if (r < u.nvalid) { const int entry = lp[r]; bf16_t* rowp = Y + (size_t)entry * 1024 + col0;
#pragma unroll
                    for (int bj = 0; bj < 2; ++bj) { const f32x4 v0 = acc[ai][bj][m][0], v1 = acc[ai][bj][m][1]; u32x4 w;
                        w.x = cvt_pk_bf16(v0[0], v0[1]); w.y = cvt_pk_bf16(v0[2], v0[3]); w.z = cvt_pk_bf16(v1[0], v1[1]); w.w = cvt_pk_bf16(v1[2], v1[3]);
                        *(u32x4*)(rowp + bj * HALF) = w; } } }
    }
};
struct SchedPlain {
    const char* A; const char* Bt; int K; StaticOrder so;
    __device__ __forceinline__ void init(const void* A_, const void* Bt_, int M, int N, int K_, int G, int c) { A = (const char*)A_; Bt = (const char*)Bt_; K = K_; so.init(M, N, G, c); }
    __device__ __forceinline__ bool next(int i, UnitX& u) const { Unit t; if (!so.next(i, t)) return false; u.pm = t.pm; u.pn = t.pn; u.A = A + (size_t)t.pm * BM * K * 2; u.B = Bt + (size_t)t.pn * BM * K * 2; u.e = 0; u.nvalid = BM; u.r0 = 0; u.pad = 0; return true; }
};
struct SchedMoe {
    const char* A; const char* W; size_t wstride; const int* list; long cap; const PG8_LAS int* tab; int t0, K, gather, ovf_at, ovf_tile0, mode, nd, rounds; StaticOrder so;
    static constexpr int ND_DROP = 3;
    __device__ __forceinline__ bool deal(int i, Unit& t) const {
        if (mode == 0) return so.next(i, t);
        if (mode == 2) { if (i != 0 || so.c >= nd) return false; t.pm = ovf_at + (so.c >> 2); t.pn = so.c & 3; return true; }
        if (so.c < nd) return i < rounds - ND_DROP ? so.next(i, t) : false;
        if (i < rounds) return so.next(i, t);
        const int j = so.c - nd; if (i != rounds || j >= ND_DROP * nd) return false;
        StaticOrder o2 = so; o2.c = j % nd; return o2.next(rounds - ND_DROP + j / nd, t);
    }
    __device__ __forceinline__ bool next(int i, UnitX& u) const {
        Unit t; if (!deal(i, t)) return false;
        const int tile = t.pm < ovf_at ? t0 + t.pm : ovf_tile0 + (t.pm - ovf_at); int e = 0;
#pragma unroll
        for (int j = 1; j < 8; ++j) e += (tile >= tab[j]) ? 1 : 0;
        const int tse = tab[e], ce = tab[16 + e];
        u.pm = t.pm; u.pn = t.pn; u.e = e; u.r0 = (tile - tse) * BM; u.nvalid = ce - u.r0 < BM ? ce - u.r0 : BM; u.pad = 0;
        u.A = gather ? A : A + (size_t)t.pm * BM * K * 2; u.B = W + (size_t)e * wstride + (size_t)t.pn * BM * K * 2; return true;
    }
    __device__ __forceinline__ void a_tok_async(const UnitX& u, const int (&R)[2], int (&tok)[2][2]) const {
        const int* lp = list + (size_t)u.e * cap + u.r0;
#pragma unroll
        for (int h = 0; h < 2; ++h)
#pragma unroll
            for (int i = 0; i < 2; ++i) { const int r = h * HALF + R[i]; const int* ap = lp + (r < u.nvalid ? r : u.nvalid - 1);
                asm volatile("global_load_dword %0, %1, off" : "=v"(tok[h][i]) : "v"(ap) : "memory"); }
    }
    __device__ __forceinline__ void a_off(const UnitX& u, const int (&R)[2], const int (&C2)[2], unsigned (&go)[2][2]) const {
        const int* lp = list + (size_t)u.e * cap + u.r0; int tok[2][2];
#pragma unroll
        for (int h = 0; h < 2; ++h)
#pragma unroll
            for (int i = 0; i < 2; ++i) { const int r = h * HALF + R[i]; tok[h][i] = lp[r < u.nvalid ? r : u.nvalid - 1] >> 1; }
#pragma unroll
        for (int h = 0; h < 2; ++h)
#pragma unroll
            for (int i = 0; i < 2; ++i) go[h][i] = (unsigned)tok[h][i] * (unsigned)(K * 2) + (unsigned)C2[i];
    }
};
template <class Epi, class Sched, bool GATHER, bool ALIGN_EPI = true>
__device__ __forceinline__ void gphase(PG8_LAS unsigned char* lds, const int K, const Sched& S, const Epi& E, const int wid, const int lane) {
    const int tid = wid * 64 + lane, wr = wid >> 2, wc = wid & 3, fr = lane & 15, fq = lane >> 4;
    const int nt = K / BK;
    unsigned voffB[2]; int RA[2], CA2[2];
#pragma unroll
    for (int i = 0; i < 2; ++i) { int R, C; stage_rc(tid * 16 + i * 8192, R, C); const int Rb = Epi::PERM ? ((R & ~31) + perm32(R & 31)) : R;
        RA[i] = R; CA2[i] = C * 2; voffB[i] = (unsigned)(Rb * K + C) * 2u; }
    const size_t kstep = (size_t)(BK * 2);
    const size_t hstep = (size_t)HALF * K * 2;
    const unsigned ldsw = (unsigned)wid * 1024u;
    const int aoff = lds_byte(wr * 64 + fr, fq * 8), boff = lds_byte(wc * 32 + fr, fq * 8);
#define PG8_SA(b, h) (((b) * 2 + (h)) * HTB)
#define PG8_SB(b, h) ((4 + (b) * 2 + (h)) * HTB)
#define PG8_STAGE(bufoff, gbase, voff) do { _Pragma("unroll") for (int _i = 0; _i < 2; ++_i) \
        __builtin_amdgcn_global_load_lds((const unsigned*)((const char*)(gbase) + (voff)[_i]), (PG8_LAS unsigned*)(lds + (bufoff) + ldsw + _i * 8192), 16, 0, 0); } while (0)
#define PG8_LDA(dst, b, h) do { _Pragma("unroll") for (int m = 0; m < 4; ++m) _Pragma("unroll") for (int k = 0; k < 2; ++k) dst[m][k] = *(const PG8_LAS bf16x8*)(lds + PG8_SA(b, h) + aoff + m * 2048 + k * 1024); } while (0)
#define PG8_LDB(dst, b, h) do { _Pragma("unroll") for (int n = 0; n < 2; ++n) _Pragma("unroll") for (int k = 0; k < 2; ++k) dst[n][k] = *(const PG8_LAS bf16x8*)(lds + PG8_SB(b, h) + boff + n * 2048 + k * 1024); } while (0)
#define PG8_MMA(ai, bj, At, Bt) do { __builtin_amdgcn_s_setprio(1); _Pragma("unroll") for (int m = 0; m < 4; ++m) _Pragma("unroll") for (int n = 0; n < 2; ++n) _Pragma("unroll") for (int k = 0; k < 2; ++k) \
        acc[ai][bj][m][n] = __builtin_amdgcn_mfma_f32_16x16x32_bf16(Bt[n][k], At[m][k], acc[ai][bj][m][n], 0, 0, 0); __builtin_amdgcn_s_setprio(0); } while (0)
#define PG8_WAIT_V(n) asm volatile("s_waitcnt vmcnt(" #n ")" ::: "memory")
#define PG8_WAIT_L(n) asm volatile("s_waitcnt lgkmcnt(" #n ")" ::: "memory")
#define PG8_BAR __builtin_amdgcn_s_barrier()
#define PG8_SCHED __builtin_amdgcn_sched_barrier(0)
    UnitX cur, nxt; int ui = 0;
    if (!S.next(0, cur)) return;
    unsigned goC[2][2], goN[2][2];
    if constexpr (GATHER) { S.a_off(cur, RA, CA2, goC); }
    else {
#pragma unroll
        for (int h = 0; h < 2; ++h)
#pragma unroll
            for (int i = 0; i < 2; ++i) goC[h][i] = (unsigned)(RA[i] * K * 2 + CA2[i]) + (unsigned)h * (unsigned)hstep; }
#pragma unroll
    for (int h = 0; h < 2; ++h)
#pragma unroll
        for (int i = 0; i < 2; ++i) goN[h][i] = goC[h][i];
    f32x4 acc[2][2][4][2];
#pragma unroll
    for (int a = 0; a < 2; ++a)
#pragma unroll
        for (int b = 0; b < 2; ++b)
#pragma unroll
            for (int m = 0; m < 4; ++m)
#pragma unroll
                for (int n = 0; n < 2; ++n) acc[a][b][m][n] = (f32x4){0.f, 0.f, 0.f, 0.f};
    bf16x8 At[4][2], B0[2][2], B1[2][2];
    const char* cA = cur.A; const char* cB = cur.B;
    PG8_STAGE(PG8_SB(0, 0), cB, voffB); PG8_STAGE(PG8_SB(0, 1), cB + hstep, voffB); PG8_STAGE(PG8_SA(0, 0), cA, goC[0]); PG8_STAGE(PG8_SA(0, 1), cA, goC[1]);
    if (wr == 1) PG8_BAR;
    PG8_WAIT_V(2); PG8_BAR;
    PG8_STAGE(PG8_SB(1, 0), cB + kstep, voffB); PG8_STAGE(PG8_SA(1, 0), cA + kstep, goC[0]); PG8_STAGE(PG8_SB(1, 1), cB + hstep + kstep, voffB);
    PG8_WAIT_V(6); PG8_BAR;
    for (;;) {
        const bool has_next = S.next(ui + 1, nxt);
        int tokN[2][2] = {{0, 0}, {0, 0}};
        if constexpr (GATHER) { if (has_next) S.a_tok_async(nxt, RA, tokN); }
        const char* nA = has_next ? nxt.A : cA; const char* nB = has_next ? nxt.B : cB;
        for (int t = 0; t < nt; t += 2) {
            const bool last = (t == nt - 2);
            const char* a1 = cA + (size_t)(t + 1) * kstep;
            const char* a2 = last ? nA : cA + (size_t)(t + 2) * kstep; const char* b2 = last ? nB : cB + (size_t)(t + 2) * kstep;
            const char* a3 = a2 + kstep; const char* b3 = b2 + kstep;
            unsigned g2[2][2];
#pragma unroll
            for (int h = 0; h < 2; ++h)
#pragma unroll
                for (int i = 0; i < 2; ++i) { if constexpr (GATHER) { asm volatile("" : "+v"(tokN[h][i])); goN[h][i] = (unsigned)(tokN[h][i] >> 1) * (unsigned)(K * 2) + (unsigned)CA2[i]; }
                    g2[h][i] = (GATHER && last && has_next) ? goN[h][i] : goC[h][i]; }
            PG8_LDB(B0, 0, 0); PG8_LDB(B1, 0, 1); PG8_SCHED; PG8_LDA(At, 0, 0); PG8_STAGE(PG8_SA(1, 1), a1, goC[1]);
            PG8_WAIT_V(8); PG8_WAIT_L(0); PG8_BAR; PG8_MMA(0, 0, At, B0); PG8_MMA(0, 1, At, B1); PG8_BAR; PG8_SCHED;
            PG8_LDA(At, 0, 1); PG8_STAGE(PG8_SB(0, 0), b2, voffB); PG8_STAGE(PG8_SB(0, 1), b2 + hstep, voffB); PG8_STAGE(PG8_SA(0, 0), a2, g2[0]);
            PG8_WAIT_V(8); PG8_WAIT_L(0); PG8_BAR; PG8_MMA(1, 0, At, B0); PG8_MMA(1, 1, At, B1); PG8_BAR; PG8_SCHED;
            PG8_LDB(B0, 1, 0); PG8_LDB(B1, 1, 1); PG8_SCHED; PG8_LDA(At, 1, 0); PG8_STAGE(PG8_SA(0, 1), a2, g2[1]);
            PG8_WAIT_V(8); PG8_WAIT_L(0); PG8_BAR; PG8_MMA(0, 0, At, B0); PG8_MMA(0, 1, At, B1); PG8_BAR; PG8_SCHED;
            PG8_LDA(At, 1, 1); PG8_STAGE(PG8_SB(1, 0), b3, voffB); PG8_STAGE(PG8_SB(1, 1), b3 + hstep, voffB); PG8_STAGE(PG8_SA(1, 0), a3, g2[0]);
            PG8_WAIT_V(8); PG8_WAIT_L(0); PG8_BAR; PG8_MMA(1, 0, At, B0); PG8_MMA(1, 1, At, B1); PG8_BAR; PG8_SCHED;
        }
        if constexpr (ALIGN_EPI) { if (wr == 0) PG8_BAR; }
        E(acc, cur, wr, wc, fr, fq);
        if (!has_next) break;
#pragma unroll
        for (int a = 0; a < 2; ++a)
#pragma unroll
            for (int b = 0; b < 2; ++b)
#pragma unroll
                for (int m = 0; m < 4; ++m)
#pragma unroll
                    for (int n = 0; n < 2; ++n) acc[a][b][m][n] = (f32x4){0.f, 0.f, 0.f, 0.f};
        cur = nxt; cA = nA; cB = nB; ++ui;
#pragma unroll
        for (int h = 0; h < 2; ++h)
#pragma unroll
            for (int i = 0; i < 2; ++i) goC[h][i] = goN[h][i];
        if constexpr (ALIGN_EPI) { if (wr == 1) PG8_BAR; }
    }
    PG8_WAIT_V(0);
    if constexpr (!ALIGN_EPI) { if (wr == 0) PG8_BAR; }
    PG8_BAR;
#undef PG8_SA
#undef PG8_SB
#undef PG8_STAGE
#undef PG8_LDA
#undef PG8_LDB
#undef PG8_MMA
#undef PG8_WAIT_V
#undef PG8_WAIT_L
#undef PG8_BAR
#undef PG8_SCHED
}
}
#define GAS __attribute__((address_space(1)))
#define LAS __attribute__((address_space(3)))
typedef unsigned short bf16;
typedef unsigned v4u __attribute__((ext_vector_type(4)));
typedef float f32x4 __attribute__((ext_vector_type(4)));
typedef short bf16x8 __attribute__((ext_vector_type(8)));
typedef GAS unsigned gu32;
typedef GAS unsigned long long gu64;
#define RLX_AGENT __ATOMIC_RELAXED, __HIP_MEMORY_SCOPE_AGENT
#define LDS_WAIT() asm volatile("s_waitcnt lgkmcnt(0)" ::: "memory")
#define VM_WAIT() asm volatile("s_waitcnt vmcnt(0)" ::: "memory")
__device__ __forceinline__ unsigned long long rt() { return __builtin_amdgcn_s_memrealtime(); }
__device__ __forceinline__ unsigned f2bf(float f) { unsigned u = __builtin_bit_cast(unsigned, f); return (u + 0x7fffu + ((u >> 16) & 1u)) >> 16; }
__device__ __forceinline__ unsigned pk2(float lo, float hi) { typedef float f2v_ __attribute__((ext_vector_type(2))); typedef __bf16 b2v_ __attribute__((ext_vector_type(2))); f2v_ v = {lo, hi}; b2v_ b = __builtin_convertvector(v, b2v_); return __builtin_bit_cast(unsigned, b); }

#define XB_TMO      128
#define XB_XCNT(j)  (256  + 64 * (j))
#define XB_XSUB(j)  (1280 + 64 * (j))
#define XB_XGEN(j)  (2304 + 64 * (j))
#define XB_TOP      3328
#define XB_TOPGEN   3392
#define XCD_BAR_WORDS 3456
#define XB_SPIN_CAP (1u << 18)

__device__ __forceinline__ unsigned xb_ld(unsigned* p)              { return __hip_atomic_load(p, __ATOMIC_RELAXED, __HIP_MEMORY_SCOPE_AGENT); }
__device__ __forceinline__ unsigned xb_add(unsigned* p, unsigned v) { return __hip_atomic_fetch_add(p, v, __ATOMIC_RELAXED, __HIP_MEMORY_SCOPE_AGENT); }
__device__ __forceinline__ unsigned xb_xcc_id() { return (unsigned)__builtin_amdgcn_s_getreg((3 << 11) | 20) & 0xFu; }
#define XB_SPIN(cond, bar) do { unsigned _sp = 0; while (cond) { __builtin_amdgcn_s_sleep(1); \
    if ((++_sp & 255u) == 0u) { if (xb_ld(&(bar)[XB_TMO])) break; if (_sp > XB_SPIN_CAP) { atomicAdd(&(bar)[XB_TMO], 1u); break; } } } } while (0)

__device__ __forceinline__ int mk_lane() { int l; asm volatile("v_mbcnt_lo_u32_b32 %0, -1, 0\n\tv_mbcnt_hi_u32_b32 %0, -1, %0" : "=v"(l)); return l; }
struct XcdBarrier {
    unsigned* bar; unsigned x; int wave;
    volatile LAS unsigned* st;
};

__device__ __forceinline__ XcdBarrier xcd_barrier_post(unsigned* bar, volatile LAS unsigned* st, int wave) {
    XcdBarrier b; b.bar = bar; b.x = xb_xcc_id(); b.st = st; b.wave = wave;
    if (wave == 0 && mk_lane() == 0) (void)xb_add(&bar[XB_XCNT(b.x)], 1u);
    return b;
}
__device__ __forceinline__ void xcd_barrier_complete(unsigned* bar, unsigned x, unsigned& nloc, unsigned& nx) {
    const unsigned G = gridDim.x * gridDim.y * gridDim.z;
    unsigned sum, cnt, mine, sp = 0u;
    for (;;) {
        sum = 0u; cnt = 0u; mine = 0u;
#pragma unroll
        for (unsigned j = 0; j < 16; ++j) { const unsigned c = xb_ld(&bar[XB_XCNT(j)]); sum += c; cnt += (c > 0u) ? 1u : 0u; mine = (j == x) ? c : mine; }
        if (sum == G) break;
        __builtin_amdgcn_s_sleep(1);
        if ((++sp & 255u) == 0u) { if (xb_ld(&bar[XB_TMO])) break; if (sp > XB_SPIN_CAP) { atomicAdd(&bar[XB_TMO], 1u); break; } }
    }
    nloc = mine > 0u ? mine : 1u; nx = cnt > 0u ? cnt : 1u;
}

__device__ __forceinline__ void xcd_barrier(const XcdBarrier& b) {
    asm volatile("s_waitcnt vmcnt(0)" ::: "memory");
    __syncthreads();
    if (b.wave == 0 && mk_lane() == 0) {
        unsigned* bar = b.bar;
        __builtin_amdgcn_s_waitcnt(0);
        unsigned nloc = b.st[0], nx = b.st[1];
        if (nloc == 0u) { xcd_barrier_complete(bar, b.x, nloc, nx); b.st[0] = nloc; b.st[1] = nx; }
        const unsigned old = xb_add(&bar[XB_XSUB(b.x)], 1u);
        const unsigned gen = old / nloc;
        if (old + 1u == (gen + 1u) * nloc) {
            __builtin_amdgcn_fence(__ATOMIC_RELEASE, "agent");
            asm volatile("s_waitcnt vmcnt(0)" ::: "memory");
            const unsigned og = xb_add(&bar[XB_TOP], 1u);
            const unsigned tg = og / nx;
            if (og + 1u == (tg + 1u) * nx) xb_add(&bar[XB_TOPGEN], 1u);
            else XB_SPIN(xb_ld(&bar[XB_TOPGEN]) == tg, bar);
            __builtin_amdgcn_fence(__ATOMIC_ACQUIRE, "agent");
            xb_add(&bar[XB_XGEN(b.x)], 1u);
            asm volatile("s_waitcnt vmcnt(0)" ::: "memory");
        } else {
            XB_SPIN(xb_ld(&bar[XB_XGEN(b.x)]) == gen, bar);
            __builtin_amdgcn_fence(__ATOMIC_ACQUIRE, "agent");
            asm volatile("s_waitcnt vmcnt(0)" ::: "memory");
        }
    }
    __syncthreads();
}
#ifndef MK_DIAG_SEL
#define MK_DIAG_SEL -1
#endif
#ifndef MK_DIAG_SCALE
#define MK_DIAG_SCALE 1e-5f
#endif
constexpr int NB = 8, SEQ = 4096, DM = 1024, MTOK = NB * SEQ;
constexpr int EVEN_IN = 2560, ODD_IN = 3072, FFD = 2816, FFE = 3584, NEXP = 8;
constexpr float EPS = 1e-6f;
constexpr size_t MiB = 1u << 20;
constexpr int NWAVES = 8;
constexpr size_t WS_CTL = 0, CTL_ZERO_BYTES = 1 * MiB;
constexpr size_t WS_MOD = 1 * MiB;
constexpr size_t WS_TOPW = 2 * MiB;
constexpr size_t WS_LIST = 3 * MiB;
constexpr size_t WS_WIN0 = 4 * MiB, WS_WOUT0 = 9 * MiB, WS_WGU0 = 11 * MiB, WS_WD0 = 22 * MiB, WS_WIN1 = 28 * MiB, WS_WOUT1 = 34 * MiB;
constexpr size_t WS_WMOE = 40 * MiB, WMOE_STRIDE = 21 * MiB, WMOE_D_OFF = 14 * MiB;
constexpr size_t WS_H = 208 * MiB;
constexpr size_t WS_PROJ = 272 * MiB;
constexpr size_t WS_MIX = 464 * MiB;
constexpr size_t WS_ACT = 272 * MiB;
constexpr size_t WS_XB = 510 * MiB;
constexpr size_t WS_END = 574 * MiB;
constexpr long LIST_CAP = 32768;
constexpr int MOE_CHUNK_TILES = 128;
constexpr int CW_BAR = 4096;
constexpr int CW_CNT = 8192;
constexpr int RING_BYTES = 131072, MISC_OFF = RING_BYTES, LDS_BYTES = 135168;

__device__ __forceinline__ float bf2f(bf16 v) { return __builtin_bit_cast(float, (unsigned)v << 16); }
__device__ __forceinline__ float wave_sum(float v) {
#pragma unroll
    for (int o = 1; o < 64; o <<= 1) v += __shfl_xor(v, o);
    return v;
}
__device__ __forceinline__ float logsig_f(float z) { return fminf(z, 0.f) - log1pf(expf(-fabsf(z))); }
__device__ __forceinline__ float sigmoid_f(float z) { return 1.0f / (1.0f + expf(-z)); }
__device__ __forceinline__ float gelu_tanh_f(float x) { const float t = tanhf(0.7978845608028654f * (x + 0.044715f * x * x * x)); return 0.5f * x * (1.0f + t); }

struct Frame {
    LAS unsigned char* lds; volatile LAS unsigned* MISC; gu32* ctl;
    int tid, lane, wave, G, gw, NGW;
    float* out; unsigned char* ws;
};
__device__ __forceinline__ const float* inp(const Frame& F, int i) {
    const unsigned long long v = ((const LAS unsigned long long*)(F.lds + MISC_OFF + 512))[i];
    const unsigned lo = __builtin_amdgcn_readfirstlane((unsigned)v), hi = __builtin_amdgcn_readfirstlane((unsigned)(v >> 32));
    return (const float*)(((unsigned long long)hi << 32) | lo);
}

typedef short v4i16p __attribute__((ext_vector_type(4)));
constexpr int TR_ROW = 288;
__device__ __forceinline__ void transpose_item(const float* W, int N, int k0, int n0, bf16* dst, int ldk, LAS unsigned char* scr, int lane) {
    const int l32 = lane & 31, rh = lane >> 5;
    const GAS f32x4* src = (const GAS f32x4*)(W + (size_t)(k0 + rh) * N + n0) + l32;
    const size_t rs2 = (size_t)(N >> 1);
    {
        f32x4 v[16];
#pragma unroll
        for (int i = 0; i < 16; ++i) v[i] = src[(size_t)i * rs2];
#pragma unroll
        for (int i = 0; i < 16; ++i) *(LAS unsigned long long*)(scr + (2 * i + rh) * TR_ROW + 8 * l32) = (unsigned long long)pk2(v[i].x, v[i].y) | ((unsigned long long)pk2(v[i].z, v[i].w) << 32);
    }
    LDS_WAIT(); asm volatile("" ::: "memory");
    const int kc = lane >> 4, li = lane & 15, q = li >> 2, p = li & 3;
    LAS unsigned char* rb = scr + (8 * kc + q) * TR_ROW + 8 * p;
#pragma unroll
    for (int j = 0; j < 8; ++j) {
        const v4i16p lo = __builtin_amdgcn_ds_read_tr16_b64_v4i16((LAS v4i16p*)(rb + 32 * j)), hi = __builtin_amdgcn_ds_read_tr16_b64_v4i16((LAS v4i16p*)(rb + 4 * TR_ROW + 32 * j));
        v4u o; o.x = (unsigned)(unsigned short)lo[0] | ((unsigned)(unsigned short)lo[1] << 16); o.y = (unsigned)(unsigned short)lo[2] | ((unsigned)(unsigned short)lo[3] << 16);
        o.z = (unsigned)(unsigned short)hi[0] | ((unsigned)(unsigned short)hi[1] << 16); o.w = (unsigned)(unsigned short)hi[2] | ((unsigned)(unsigned short)hi[3] << 16);
        *(GAS v4u*)(dst + (size_t)(16 * j + li) * ldk + k0 + 8 * kc) = o; }
    LDS_WAIT(); asm volatile("" ::: "memory");
}
__device__ __forceinline__ bool tr_plain(int& r, const float* W, int K, int N, bf16* Wt, LAS unsigned char* scr, int lane) {
    const int nblk = N / 128, items = (K / 32) * nblk;
    if (r >= items) { r -= items; return false; }
    const int kb = r / nblk, nb = r % nblk;
    transpose_item(W, N, 32 * kb, 128 * nb, Wt + (size_t)(128 * nb) * K, K, scr, lane); return true;
}
__device__ __forceinline__ bool tr_gu(int& r, const float* Wg, const float* Wu, int K, int F, bf16* Wt, LAS unsigned char* scr, int lane) {
    const int nblk = F / 128, items = (K / 32) * nblk;
    if (r >= 2 * items) { r -= 2 * items; return false; }
    const int up = r >= items ? 1 : 0; const int q = r - up * items; const int kb = q / nblk, nb = q % nblk;
    transpose_item(up ? Wu : Wg, F, 32 * kb, 128 * nb, Wt + (size_t)(256 * nb + 128 * up) * K, K, scr, lane); return true;
}
__device__ __forceinline__ void p_prologue(Frame& F) {
    LAS float* cond = (LAS float*)F.lds;
    const float* cin = inp(F, 1);
    for (int i = F.tid; i < NB * DM; i += 512) { const float c = cin[i]; cond[i] = c / (1.0f + expf(-c)); }
    __syncthreads();
    float* mod = (float*)(F.ws + WS_MOD);
    const float* ada_w = inp(F, 3); const float* ada_b = inp(F, 4);
    for (int it = F.gw; it < 768; it += F.NGW) {
        const int layer = it / 384, j0 = (it % 384) * 16, cj = F.lane & 15, kp = F.lane >> 4;
        float acc[NB];
#pragma unroll
        for (int b = 0; b < NB; ++b) acc[b] = 0.f;
        const float* wp = ada_w + (size_t)layer * DM * 6144 + j0 + cj;
#pragma unroll 16
        for (int k = kp; k < DM; k += 4) { const float w = wp[(size_t)k * 6144];
#pragma unroll
            for (int b = 0; b < NB; ++b) acc[b] += cond[b * DM + k] * w; }
#pragma unroll
        for (int b = 0; b < NB; ++b) { acc[b] += __shfl_xor(acc[b], 16); acc[b] += __shfl_xor(acc[b], 32); }
        if (kp == 0) {
            const float bias = ada_b[layer * 6144 + j0 + cj];
#pragma unroll
            for (int b = 0; b < NB; ++b) mod[(size_t)(layer * NB + b) * 6144 + j0 + cj] = acc[b] + bias; }
    }
    __syncthreads();
    LAS unsigned char* scr = F.lds + F.wave * 16384;
    constexpr int ITEMS_MOE_E = 3 * (DM / 32) * (FFE / 128);
    constexpr int ITEMS_FIX = (DM / 32) * (EVEN_IN / 128) + (DM / 32) * (DM / 128) + 2 * (DM / 32) * (FFD / 128) + (FFD / 32) * (DM / 128) + (DM / 32) * (ODD_IN / 128) + (DM / 32) * (DM / 128);
    constexpr int NITEMS = ITEMS_FIX + NEXP * ITEMS_MOE_E;
    unsigned char* ws = F.ws;
    for (int it = F.gw; it < NITEMS; it += F.NGW) {
        int r = it;
        if (tr_plain(r, inp(F, 8), DM, EVEN_IN, (bf16*)(ws + WS_WIN0), scr, F.lane)) continue;
        if (tr_plain(r, inp(F, 9), DM, DM, (bf16*)(ws + WS_WOUT0), scr, F.lane)) continue;
        if (tr_gu(r, inp(F, 17), inp(F, 18), DM, FFD, (bf16*)(ws + WS_WGU0), scr, F.lane)) continue;
        if (tr_plain(r, inp(F, 19), FFD, DM, (bf16*)(ws + WS_WD0), scr, F.lane)) continue;
        if (tr_plain(r, inp(F, 20), DM, ODD_IN, (bf16*)(ws + WS_WIN1), scr, F.lane)) continue;
        if (tr_plain(r, inp(F, 21), DM, DM, (bf16*)(ws + WS_WOUT1), scr, F.lane)) continue;
        const int e = r / ITEMS_MOE_E; r -= e * ITEMS_MOE_E;
        unsigned char* we = ws + WS_WMOE + (size_t)e * WMOE_STRIDE;
        if (tr_gu(r, inp(F, 29) + (size_t)e * DM * FFE, inp(F, 30) + (size_t)e * DM * FFE, DM, FFE, (bf16*)we, scr, F.lane)) continue;
        tr_plain(r, inp(F, 31) + (size_t)e * FFE * DM, FFE, DM, (bf16*)(we + WMOE_D_OFF), scr, F.lane);
    }
}

__device__ __forceinline__ f32x4 bf4_to_f32(unsigned long long w) { return (f32x4){__uint_as_float((unsigned)w << 16), __uint_as_float((unsigned)w & 0xffff0000u), __uint_as_float((unsigned)(w >> 32) << 16), __uint_as_float((unsigned)(w >> 32) & 0xffff0000u)}; }
template <bool X_BF16> __device__ __forceinline__ void p_norm_mod(Frame& F, const void* X, bf16* H, const float* ln, const float* modl, int sh_off, int sc_off) {
    for (int m = F.gw; m < MTOK; m += F.NGW) {
        const int b = m / SEQ;
        const GAS f32x4* xr = (const GAS f32x4*)((const float*)X + (size_t)m * DM) + F.lane;
        const GAS unsigned long long* xb8 = (const GAS unsigned long long*)((const bf16*)X + (size_t)m * DM) + F.lane;
        f32x4 v[4]; float ss = 0.f;
#pragma unroll
        for (int j = 0; j < 4; ++j) { if constexpr (X_BF16) v[j] = bf4_to_f32(xb8[64 * j]); else v[j] = xr[64 * j]; ss += (v[j].x * v[j].x + v[j].y * v[j].y) + (v[j].z * v[j].z + v[j].w * v[j].w); }
        const float rstd = 1.0f / sqrtf(wave_sum(ss) * (1.f / DM) + EPS);
        GAS unsigned long long* o8 = (GAS unsigned long long*)(H + (size_t)m * DM) + F.lane;
#pragma unroll
        for (int j = 0; j < 4; ++j) { const int col = 4 * F.lane + 256 * j;
            const f32x4 g = *(const GAS f32x4*)(ln + col), sc = *(const GAS f32x4*)(modl + (size_t)b * 6144 + sc_off + col), sh = *(const GAS f32x4*)(modl + (size_t)b * 6144 + sh_off + col);
            const f32x4 h = v[j] * rstd * g * (sc + 1.0f) + sh;
            o8[64 * j] = (unsigned long long)pk2(h.x, h.y) | ((unsigned long long)pk2(h.z, h.w) << 32); }
    }
}
__device__ __forceinline__ void p_router(Frame& F, const bf16* X, bf16* H, const float* ln, const float* modl, int sh_off, int sc_off) {
    LAS float* rws = (LAS float*)F.lds;
    LAS int* sel = (LAS int*)(F.lds + 32768);
    const float* rw = inp(F, 27); const float* rb = inp(F, 28);
    float* topw = (float*)(F.ws + WS_TOPW); int* list = (int*)(F.ws + WS_LIST);
    for (int i = F.tid; i < DM * NEXP; i += 512) rws[i] = rw[i];
    __syncthreads();
    for (int chunk = blockIdx.x; chunk < MTOK / 128; chunk += F.G) {
        for (int i = 0; i < 16; ++i) {
            const int lt = F.wave * 16 + i, m = chunk * 128 + lt, b = m / SEQ;
            const GAS unsigned long long* xb8 = (const GAS unsigned long long*)(X + (size_t)m * DM) + F.lane;
            f32x4 v[4]; float ss = 0.f;
#pragma unroll
            for (int j = 0; j < 4; ++j) { v[j] = bf4_to_f32(xb8[64 * j]); ss += (v[j].x * v[j].x + v[j].y * v[j].y) + (v[j].z * v[j].z + v[j].w * v[j].w); }
            const float rstd = 1.0f / sqrtf(wave_sum(ss) * (1.f / DM) + EPS);
            GAS unsigned long long* o8 = (GAS unsigned long long*)(H + (size_t)m * DM) + F.lane;
            float lg[NEXP];
#pragma unroll
            for (int e = 0; e < NEXP; ++e) lg[e] = 0.f;
#pragma unroll
            for (int j = 0; j < 4; ++j) { const int col = 4 * F.lane + 256 * j;
                const f32x4 g = *(const GAS f32x4*)(ln + col), sc = *(const GAS f32x4*)(modl + (size_t)b * 6144 + sc_off + col), sh = *(const GAS f32x4*)(modl + (size_t)b * 6144 + sh_off + col);
                const f32x4 h = v[j] * rstd * g * (sc + 1.0f) + sh;
                o8[64 * j] = (unsigned long long)pk2(h.x, h.y) | ((unsigned long long)pk2(h.z, h.w) << 32);
#pragma unroll
                for (int q = 0; q < 4; ++q) { const f32x4 w0 = *(const LAS f32x4*)(rws + (col + q) * 8), w1 = *(const LAS f32x4*)(rws + (col + q) * 8 + 4); const float hv = h[q];
                    lg[0] += hv * w0.x; lg[1] += hv * w0.y; lg[2] += hv * w0.z; lg[3] += hv * w0.w; lg[4] += hv * w1.x; lg[5] += hv * w1.y; lg[6] += hv * w1.z; lg[7] += hv * w1.w; } }
#pragma unroll
            for (int e = 0; e < NEXP; ++e) lg[e] = wave_sum(lg[e]) + rb[e];
            int i0 = 0; float v0 = lg[0];
#pragma unroll
            for (int e = 1; e < NEXP; ++e) if (lg[e] > v0) { v0 = lg[e]; i0 = e; }
            int i1 = (i0 == 0) ? 1 : 0; float v1 = (i0 == 0) ? lg[1] : lg[0];
#pragma unroll
            for (int e = 1; e < NEXP; ++e) if (e != i0 && lg[e] > v1) { v1 = lg[e]; i1 = e; }
            const float w0 = 1.0f / (1.0f + expf(v1 - v0)), w1 = 1.0f - w0;
            if (F.lane == 0) { sel[2 * lt] = i0; sel[2 * lt + 1] = i1; topw[(size_t)m * 2] = w0; topw[(size_t)m * 2 + 1] = w1; }
        }
        __syncthreads();
        {
            const int e = F.wave; bool mt[4]; int rk[4]; int total = 0;
#pragma unroll
            for (int r = 0; r < 4; ++r) { mt[r] = (sel[r * 64 + F.lane] == e); const unsigned long long mask = __ballot(mt[r]);
                rk[r] = total + __popcll(mask & ((1ull << F.lane) - 1ull)); total += __popcll(mask); }
            int base = 0;
            if (F.lane == 0 && total > 0) base = (int)__hip_atomic_fetch_add((unsigned*)(F.ctl + CW_CNT + 64 * e), (unsigned)total, RLX_AGENT);
            base = __builtin_amdgcn_readfirstlane(base);
#pragma unroll
            for (int r = 0; r < 4; ++r) if (mt[r]) list[(size_t)e * LIST_CAP + base + rk[r]] = (chunk * 128) * 2 + r * 64 + F.lane;
        }
        __syncthreads();
    }
}
__device__ __forceinline__ void p_final(Frame& F, const bf16* XB, const float* gate, const float* ln) {
    const float* topw = (const float*)(F.ws + WS_TOPW);
    for (int m = F.gw; m < MTOK; m += F.NGW) {
        const int b = m / SEQ;
        const GAS unsigned long long* x8 = (const GAS unsigned long long*)(XB + (size_t)m * DM) + F.lane;
        const GAS unsigned long long* y0 = (const GAS unsigned long long*)((const bf16*)F.out + (size_t)(2 * m) * DM) + F.lane;
        const GAS unsigned long long* y1 = (const GAS unsigned long long*)((const bf16*)F.out + (size_t)(2 * m + 1) * DM) + F.lane;
        const float w0 = topw[(size_t)m * 2], w1 = topw[(size_t)m * 2 + 1];
        f32x4 v[4]; float ss = 0.f;
#pragma unroll
        for (int j = 0; j < 4; ++j) { const unsigned long long xa = x8[64 * j], ya = y0[64 * j], yb = y1[64 * j];
            const f32x4 g = *(const GAS f32x4*)(gate + (size_t)b * 6144 + 4 * F.lane + 256 * j);
            f32x4 xv, y0v, y1v;
            xv.x = bf2f((bf16)(xa & 0xffff)); xv.y = bf2f((bf16)((xa >> 16) & 0xffff)); xv.z = bf2f((bf16)((xa >> 32) & 0xffff)); xv.w = bf2f((bf16)(xa >> 48));
            y0v.x = bf2f((bf16)(ya & 0xffff)); y0v.y = bf2f((bf16)((ya >> 16) & 0xffff)); y0v.z = bf2f((bf16)((ya >> 32) & 0xffff)); y0v.w = bf2f((bf16)(ya >> 48));
            y1v.x = bf2f((bf16)(yb & 0xffff)); y1v.y = bf2f((bf16)((yb >> 16) & 0xffff)); y1v.z = bf2f((bf16)((yb >> 32) & 0xffff)); y1v.w = bf2f((bf16)(yb >> 48));
            v[j] = xv + g * (y0v * w0 + y1v * w1);
            ss += (v[j].x * v[j].x + v[j].y * v[j].y) + (v[j].z * v[j].z + v[j].w * v[j].w); }
        float rstd = 1.0f / sqrtf(wave_sum(ss) * (1.f / DM) + EPS);
#if MK_DIAG_SEL >= 0
        rstd *= 1.0f + ((const float*)(F.ws + WS_CTL + 65536))[MK_DIAG_SEL] * MK_DIAG_SCALE;
#endif
        asm volatile("" ::: "memory");
        GAS f32x4* orow = (GAS f32x4*)(F.out + (size_t)m * DM) + F.lane;
#pragma unroll
        for (int j = 0; j < 4; ++j) { const f32x4 g = *(const GAS f32x4*)(ln + 4 * F.lane + 256 * j); orow[64 * j] = v[j] * rstd * g; }
    }
}

__device__ __forceinline__ void p_sb_naive(Frame& F, const bf16* proj, bf16* mix) {
    for (int w = blockIdx.x * 7 + (F.wave - 1); w < NB * 8 * SEQ; w += F.G * 7) {
        const int t = w % SEQ, bh = w / SEQ, h = bh % 8, b = bh / 8;
        const size_t row = (size_t)b * SEQ + t;
        const float q = bf2f(proj[row * EVEN_IN + h * 64 + F.lane]);
        float acc = 0.f, later = 0.f;
        for (int s = t - 1; s >= 0; --s) {
            const size_t kr = ((size_t)b * SEQ + s) * EVEN_IN;
            const float kk = bf2f(proj[kr + 512 + h * 64 + F.lane]), vv = bf2f(proj[kr + 1024 + h * 64 + F.lane]);
            const float z = wave_sum(q * kk) * 0.125f;
            const float lp = logsig_f(z), ln_ = lp - z;
            acc += expf(lp + later) * vv; later += ln_;
            if (later < -110.f) break;
        }
        mix[row * DM + h * 64 + F.lane] = (bf16)f2bf(acc);
    }
}
__device__ __forceinline__ void p_lru_naive_wave(Frame& F, int unit, const bf16* proj, bf16* mix) {
    LAS float* wa = (LAS float*)F.lds; LAS float* wx = wa + 4096; LAS float* xcs = wx + 4096;
    const float* conv_w = inp(F, 10); const float* conv_b = inp(F, 11); const float* ga_w = inp(F, 12); const float* ga_b = inp(F, 13); const float* gx_w = inp(F, 14); const float* gx_b = inp(F, 15); const float* lam = inp(F, 16);
    const int b = unit / 8, g = unit % 8, j = F.lane, c = g * 64 + j;
    for (int i = j; i < 4096; i += 64) { wa[i] = ga_w[g * 4096 + i]; wx[i] = gx_w[g * 4096 + i]; }
    const float cw0 = conv_w[c], cw1 = conv_w[512 + c], cw2 = conv_w[1024 + c], cw3 = conv_w[1536 + c], cb = conv_b[c], ba = ga_b[c], bx = gx_b[c], lsl = logsig_f(lam[c]);
    float x1 = 0.f, x2 = 0.f, x3 = 0.f, hs = 0.f;
    LDS_WAIT();
    for (int t = 0; t < SEQ; ++t) {
        const size_t row = (size_t)b * SEQ + t;
        const float xb = bf2f(proj[row * EVEN_IN + 1536 + c]), gb = bf2f(proj[row * EVEN_IN + 2048 + c]);
        const float xc = cw0 * x3 + cw1 * x2 + cw2 * x1 + cw3 * xb + cb; x3 = x2; x2 = x1; x1 = xb;
        xcs[j] = xc; LDS_WAIT(); asm volatile("" ::: "memory");
        float ra = ba, rx = bx;
#pragma unroll 8
        for (int i = 0; i < 64; ++i) { const float xi = xcs[i]; ra += xi * wa[i * 64 + j]; rx += xi * wx[i * 64 + j]; }
        LDS_WAIT(); asm volatile("" ::: "memory");
        const float r = sigmoid_f(ra), ig = sigmoid_f(rx), log_a = 8.0f * r * lsl, aa = expf(log_a), u = sqrtf(-expm1f(2.0f * log_a)) * (ig * xc);
        hs = aa * hs + u;
        mix[row * DM + 512 + c] = (bf16)f2bf(hs * gelu_tanh_f(gb));
    }
}
__device__ __forceinline__ void p_diff_naive(Frame& F, const bf16* proj, bf16* o, float lambda_init) {
    LAS float* lut = (LAS float*)F.lds; LAS float* lam_s = lut + 132;
    const float* rel_bias = inp(F, 2); const float* lq1 = inp(F, 22); const float* lk1 = inp(F, 23); const float* lq2 = inp(F, 24); const float* lk2 = inp(F, 25); const float* subln = inp(F, 26);
    int k = 0;
    for (int u = blockIdx.x; u < NB * 8 * 32; u += F.G, ++k) {
        const int bh = u / 32, h = bh % 8, b = bh / 8; int tile = u % 32; if (k & 1) tile = 31 - tile;
        const int qi = F.tid >> 2, part = F.tid & 3, t = tile * 128 + qi;
        __syncthreads();
        if (F.tid < 129) { const int n = F.tid; int bk;
            if (n < 16) bk = n; else bk = 16 + (n >= 19) + (n >= 21) + (n >= 24) + (n >= 27) + (n >= 31) + (n >= 35) + (n >= 40) + (n >= 46) + (n >= 52) + (n >= 59) + (n >= 67) + (n >= 77) + (n >= 87) + (n >= 99) + (n >= 113);
            lut[n] = rel_bias[bk * 8 + h]; }
        if (F.tid == 0) { float s1 = 0.f, s2 = 0.f; for (int i = 0; i < 64; ++i) { s1 += lq1[i] * lk1[i]; s2 += lq2[i] * lk2[i]; } lam_s[0] = expf(s1) - expf(s2) + lambda_init; }
        __syncthreads();
        const float lam = lam_s[0];
        const size_t row = (size_t)b * SEQ + t;
        float q1[16], q2[16], a1[32], a2[32];
#pragma unroll
        for (int i = 0; i < 16; ++i) { q1[i] = bf2f(proj[row * ODD_IN + (2 * h) * 64 + part * 16 + i]); q2[i] = bf2f(proj[row * ODD_IN + (2 * h + 1) * 64 + part * 16 + i]); }
#pragma unroll
        for (int i = 0; i < 32; ++i) { a1[i] = 0.f; a2[i] = 0.f; }
        float m1 = -INFINITY, m2 = -INFINITY, l1 = 0.f, l2 = 0.f;
        const int tmax = tile * 128 + 127;
        for (int s = 0; s <= tmax; ++s) {
            const bf16* kr = proj + ((size_t)b * SEQ + s) * ODD_IN;
            const bf16x8 ka = *(const bf16x8*)(kr + 1024 + (2 * h) * 64 + part * 16), kb = *(const bf16x8*)(kr + 1024 + (2 * h) * 64 + part * 16 + 8);
            const bf16x8 kc = *(const bf16x8*)(kr + 1024 + (2 * h + 1) * 64 + part * 16), kd = *(const bf16x8*)(kr + 1024 + (2 * h + 1) * 64 + part * 16 + 8);
            float d1 = 0.f, d2 = 0.f;
#pragma unroll
            for (int i = 0; i < 8; ++i) { d1 += q1[i] * bf2f((bf16)ka[i]) + q1[8 + i] * bf2f((bf16)kb[i]); d2 += q2[i] * bf2f((bf16)kc[i]) + q2[8 + i] * bf2f((bf16)kd[i]); }
            d1 += __shfl_xor(d1, 1); d1 += __shfl_xor(d1, 2); d2 += __shfl_xor(d2, 1); d2 += __shfl_xor(d2, 2);
            if (s <= t) {
                const int rel = t - s; const float bias = lut[rel > 128 ? 128 : rel];
                const float z1 = d1 * 0.125f + bias, z2 = d2 * 0.125f + bias;
                const float n1 = fmaxf(m1, z1), n2 = fmaxf(m2, z2);
                const float s1 = expf(m1 - n1), s2 = expf(m2 - n2), p1 = expf(z1 - n1), p2 = expf(z2 - n2);
                l1 = l1 * s1 + p1; l2 = l2 * s2 + p2; m1 = n1; m2 = n2;
                const bf16* vr = kr + 2048 + h * 128 + part * 32;
#pragma unroll
                for (int c8 = 0; c8 < 4; ++c8) { const bf16x8 vv = *(const bf16x8*)(vr + 8 * c8);
#pragma unroll
                    for (int i = 0; i < 8; ++i) { const float vf = bf2f((bf16)vv[i]); a1[8 * c8 + i] = a1[8 * c8 + i] * s1 + p1 * vf; a2[8 * c8 + i] = a2[8 * c8 + i] * s2 + p2 * vf; } }
            }
        }
        const float r1 = 1.0f / l1, r2 = lam / l2; float ss = 0.f;
#pragma unroll
        for (int i = 0; i < 32; ++i) { a1[i] = a1[i] * r1 - a2[i] * r2; ss += a1[i] * a1[i]; }
        ss += __shfl_xor(ss, 1); ss += __shfl_xor(ss, 2);
        const float rstd = 1.0f / sqrtf(ss * (1.0f / 128.0f) + EPS) * (1.0f - lambda_init);
        bf16* op = o + row * DM + h * 128 + part * 32;
#pragma unroll
        for (int i = 0; i < 32; i += 2) *(unsigned*)(op + i) = pk2(a1[i] * rstd * subln[part * 32 + i], a1[i + 1] * rstd * subln[part * 32 + i + 1]);
    }
}

typedef float f32x16 __attribute__((ext_vector_type(16)));
typedef short v4i16_t __attribute__((ext_vector_type(4)));
constexpr float LOG2E = 1.4426950408889634f;
constexpr float QK_PRESCALE = 0.125f * LOG2E;
constexpr int ATTN_QSCALE_COLS = 1024; constexpr float ATTN_QSCALE = QK_PRESCALE;
__device__ __forceinline__ float max3f(float a, float b, float c) { float r; asm("v_max3_f32 %0, %1, %2, %3" : "=v"(r) : "v"(a), "v"(b), "v"(c)); return r; }
__device__ __forceinline__ float mov_s(float a) { float r; asm("v_mov_b32_e32 %0, %1" : "=v"(r) : "v"(a)); return r; }
__device__ __forceinline__ float fadd_s(float a, float b) { float r; asm("v_add_f32_e32 %0, %1, %2" : "=v"(r) : "v"(a), "v"(b)); return r; }
__device__ __forceinline__ int crow(int r, int hi) { return (r & 3) + 8 * (r >> 2) + 4 * hi; }
__device__ __forceinline__ float half_max(float v) { auto rr = __builtin_amdgcn_permlane32_swap(__float_as_uint(v), __float_as_uint(v), false, false); return fmaxf(__uint_as_float(rr[0]), __uint_as_float(rr[1])); }
__device__ __forceinline__ float half_sum(float v) { auto rr = __builtin_amdgcn_permlane32_swap(__float_as_uint(v), __float_as_uint(v), false, false); return __uint_as_float(rr[0]) + __uint_as_float(rr[1]); }
__device__ __forceinline__ unsigned cvtpk(float lo, float hi) { typedef float f2 __attribute__((ext_vector_type(2))); typedef __bf16 b2 __attribute__((ext_vector_type(2))); f2 v = {lo, hi}; b2 b = __builtin_convertvector(v, b2); return __builtin_bit_cast(unsigned, b); }
__device__ __forceinline__ bf16x8 vfrag(LAS const unsigned char* p0, LAS const unsigned char* p1) {
    const v4i16_t lo = __builtin_amdgcn_ds_read_tr16_b64_v4i16((LAS v4i16_t*)p0), hi = __builtin_amdgcn_ds_read_tr16_b64_v4i16((LAS v4i16_t*)p1);
    return (bf16x8){lo[0], lo[1], lo[2], lo[3], hi[0], hi[1], hi[2], hi[3]};
}
constexpr int DA_KRING = 0, DA_KSLOT = 16384, DA_VRING = 49152, DA_VSLOT = 16384, DA_LUT = 131072 + 1024, DA_SLN = 131072 + 2560, DA_QF = 98304, DA_OST = 65536, DA_OROW = 264;
constexpr float DA_THR = 8.0f;

#ifndef MK_DIAG_SEL
#define MK_DIAG_SEL -1
#endif
#if MK_DIAG_SEL >= 0
#define DIAG_T(v) do { v = __builtin_amdgcn_s_memtime(); } while (0)
#define DIAG_ACC(k, t1, t0) do { dg[k] += (t1) - (t0); } while (0)
#else
#define DIAG_T(v) do { } while (0)
#define DIAG_ACC(k, t1, t0) do { } while (0)
#endif
__device__ __forceinline__ float da_maxall(const f32x16& a, const f32x16& b) {
    float mxa = max3f(a[0], a[1], b[0]), mxb = max3f(a[2], a[3], b[1]); mxa = max3f(mxa, b[2], b[3]);
#pragma unroll
    for (int r = 4; r < 16; r += 4) { mxa = max3f(mxa, a[r], a[r + 1]); mxb = max3f(mxb, a[r + 2], a[r + 3]); mxa = max3f(mxa, b[r], b[r + 1]); mxb = max3f(mxb, b[r + 2], b[r + 3]); }
    return max3f(mxa, mxb, mxb);
}
#define DA_MAXALL(a, b) da_maxall(a, b)
__device__ __forceinline__ void p_diff_attn(Frame& F, const bf16* proj, bf16* o, float lambda_init) {
    unsigned long long dg[6] = {0, 0, 0, 0, 0, 0}; unsigned long long ta = 0, tb = 0, tc = 0, td = 0; (void)ta; (void)tb; (void)tc; (void)td; (void)dg;
    const float* rel_bias = inp(F, 2); const float* lq1 = inp(F, 22); const float* lk1 = inp(F, 23); const float* lq2 = inp(F, 24); const float* lk2 = inp(F, 25); const float* subln = inp(F, 26);
    const int lane0 = F.lane, wave = F.wave, w4 = wave & 3, map = wave >> 2;
    LAS unsigned char* L = F.lds;
    LAS float* lut = (LAS float*)(L + DA_LUT) + 128;
    float lam;
    { float s1 = lq1[lane0] * lk1[lane0], s2 = lq2[lane0] * lk2[lane0]; s1 = wave_sum(s1); s2 = wave_sum(s2); lam = expf(s1) - expf(s2) + lambda_init; }
    const int G = F.G; const int bx = blockIdx.x; const int vcu0 = (G % 8 == 0) ? (bx % 8) * (G / 8) + bx / 8 : bx;
#define DA_WAITBAR(n) do { asm volatile("s_waitcnt vmcnt(" #n ") lgkmcnt(0)" ::: "memory"); __builtin_amdgcn_s_barrier(); asm volatile("" ::: "memory"); } while (0)
#define DA_WAITBAR_N(cnt) do { if ((cnt) >= 6) DA_WAITBAR(6); else if ((cnt) == 4) DA_WAITBAR(4); else if ((cnt) == 2) DA_WAITBAR(2); else DA_WAITBAR(0); } while (0)
    LAS float* sln = (LAS float*)(L + DA_SLN);
    __syncthreads();
    if (F.tid < 128) sln[F.tid] = subln[F.tid];
    for (int vcu = vcu0; vcu < 256; vcu += G) {
        const int xg = vcu >> 5, jl = vcu & 31;
        for (int k = 0; k < 8; ++k) {
            const int bh = xg * 8 + k, h = bh & 7, b = bh >> 3, qb = (k & 1) ? 31 - jl : jl;
            int lane_u = lane0; asm volatile("" : "+v"(lane_u));
            const int lane = lane_u, r32 = lane & 31, hi = lane >> 5;
            const int q4 = (lane & 15) >> 2, p4 = lane & 3, blk = (lane >> 4) & 1;
            const int vb0 = 64 * (4 * hi + q4) + 16 * ((2 * blk + (p4 >> 1)) ^ hi) + 8 * (p4 & 1);
            const int vb1 = 2048 + 64 * (4 * hi + q4) + 16 * ((2 * blk + (p4 >> 1)) ^ (2 + hi)) + 8 * (p4 & 1);
            const int vkey = 8 * wave + ((lane >> 2) & 7);
            const int vch0 = 4 * (lane >> 5) + ((lane & 3) ^ (2 * (wave & 1) + ((lane >> 4) & 1)));
            const int q0w = qb * 128 + 32 * w4, head = 2 * h + map;
            const int nkt = 2 * qb + 2, my_last = 2 * qb + (w4 >= 2 ? 1 : 0);
            __syncthreads();
            if (F.tid < 384) { int n = F.tid - 128; asm volatile("" : "+v"(n)); int bk;
                if (n < 16) bk = max(n, 0); else bk = 16 + (n >= 19) + (n >= 21) + (n >= 24) + (n >= 27) + (n >= 31) + (n >= 35) + (n >= 40) + (n >= 46) + (n >= 52) + (n >= 59) + (n >= 67) + (n >= 77) + (n >= 87) + (n >= 99) + (n >= 113);
                const float bv = rel_bias[bk * 8 + h] * LOG2E; lut[n] = n < 0 ? -INFINITY : bv; }
            const bf16* kvbase = proj + (size_t)b * SEQ * ODD_IN;
            bf16x8 qf[4];
            { const bf16* qp = kvbase + (size_t)(q0w + r32) * ODD_IN + head * 64 + 8 * hi;
#pragma unroll
              for (int d0 = 0; d0 < 4; ++d0) qf[d0] = *(const bf16x8*)(qp + 16 * d0); }
            const int krow = 8 * wave + (lane >> 3), kch = (lane & 7) ^ ((krow >> 1) & 7);
            const unsigned ko0 = (unsigned)(krow * ODD_IN + 1024 + (2 * h) * 64 + 8 * kch) * 2u, ko1 = ko0 + 128u;
            const unsigned vo0 = (unsigned)(vkey * ODD_IN + 2048 + h * 128 + 8 * vch0) * 2u, vo1 = vo0 + 128u;
#define DA_ISSUE_K(kt) do { const char* gb_ = (const char*)kvbase + (size_t)(kt) * 64 * ODD_IN * 2; LAS unsigned char* sb_ = L + DA_KRING + ((kt) % 3) * DA_KSLOT; \
            __builtin_amdgcn_global_load_lds((const unsigned*)(gb_ + ko0), (LAS unsigned*)(sb_ + wave * 1024), 16, 0, 0); \
            __builtin_amdgcn_global_load_lds((const unsigned*)(gb_ + ko1), (LAS unsigned*)(sb_ + 8192 + wave * 1024), 16, 0, 0); } while (0)
#define DA_ISSUE_V(kt) do { const char* gb_ = (const char*)kvbase + (size_t)(kt) * 64 * ODD_IN * 2; LAS unsigned char* sb_ = L + DA_VRING + ((kt) % 3) * DA_VSLOT; \
            __builtin_amdgcn_global_load_lds((const unsigned*)(gb_ + vo0), (LAS unsigned*)(sb_ + wave * 2048), 16, 0, 0); \
            __builtin_amdgcn_global_load_lds((const unsigned*)(gb_ + vo1), (LAS unsigned*)(sb_ + wave * 2048 + 1024), 16, 0, 0); } while (0)
            DA_ISSUE_K(0); DA_ISSUE_V(0); DA_ISSUE_K(1); DA_ISSUE_V(1); if (2 < nkt) DA_ISSUE_K(2);
            f32x16 oacc[4];
#pragma unroll
            for (int c = 0; c < 4; ++c)
#pragma unroll
                for (int r = 0; r < 16; ++r) oacc[c][r] = 0.f;
            float mref = 0.f, lrun = 0.f; bool first = true;
            f32x16 s0, s1;
#define DA_SB() __builtin_amdgcn_sched_barrier(0)
#define DA_LDKQ(t) do { LAS const unsigned char* kb_ = L + DA_KRING + ((t) % 3) * DA_KSLOT + map * 8192 + r32 * 128; const int sw_ = (r32 >> 1) & 7; \
                _Pragma("unroll") for (int d0 = 0; d0 < 4; ++d0) { const int co_ = ((2 * d0 + hi) ^ sw_) << 4; kf[2 * d0] = *(LAS const bf16x8*)(kb_ + co_); kf[2 * d0 + 1] = *(LAS const bf16x8*)(kb_ + co_ + 4096); } } while (0)
#define DA_QKM(t, S0, S1) do { const bool farq_ = (q0w - (64 * (t) + 63) >= 128); const float ci_ = (farq_ ? lut[128] : 0.f) - mref; \
                _Pragma("unroll") for (int r = 0; r < 16; ++r) { S0[r] = ci_; S1[r] = ci_; } \
                _Pragma("unroll") for (int d0 = 0; d0 < 4; ++d0) { \
                    S0 = __builtin_amdgcn_mfma_f32_32x32x16_bf16(kf[2 * d0], qf[d0], S0, 0, 0, 0); \
                    S1 = __builtin_amdgcn_mfma_f32_32x32x16_bf16(kf[2 * d0 + 1], qf[d0], S1, 0, 0, 0); } } while (0)
#define DA_LDV(c, dst) do { _Pragma("unroll") for (int s = 0; s < 4; ++s) { \
                asm volatile("ds_read_b64_tr_b16 %0, %1 offset:%c2" : "=&v"(dst##l[s]) : "v"(vp0u), "i"(4096 * s + 512 * (c)) : "memory"); \
                asm volatile("ds_read_b64_tr_b16 %0, %1 offset:%c2" : "=&v"(dst##h[s]) : "v"(vp1u), "i"(4096 * s + 512 * (c)) : "memory"); } } while (0)
#define DA_VF(dst, s) (bf16x8){dst##l[s][0], dst##l[s][1], dst##l[s][2], dst##l[s][3], dst##h[s][0], dst##h[s][1], dst##h[s][2], dst##h[s][3]}
#define DA_LWAIT(n) do { asm volatile("s_waitcnt lgkmcnt(" #n ")" ::: "memory"); DA_SB(); } while (0)
            bf16x8 kf[8];
            DA_WAITBAR(0);
            DA_LDKQ(0); DA_SB(); DA_QKM(0, s0, s1); DA_SB();
            asm volatile("s_nop 15\n\ts_nop 7" : "+v"(s0), "+v"(s1));
            float mx_pre = DA_MAXALL(s0, s1);
#pragma unroll 1
            for (int t = 0; t < nkt; ++t) {
                if (t > 0) { const int fly = 2 * ((t + 2 < nkt ? 1 : 0) + (t + 1 < nkt ? 1 : 0)); DA_WAITBAR_N(fly); }
                if (t + 3 < nkt) DA_ISSUE_K(t + 3);
                if (t + 2 < nkt) DA_ISSUE_V(t + 2);
                DA_LDKQ(t + 1);
                DA_SB();
                const int k0_ = 64 * t;
                float mx;
                if (!(q0w - (k0_ + 63) >= 128)) { int lq_ = lane; asm volatile("" : "+v"(lq_));
                    const int relb = q0w + (lq_ & 31) - k0_ - 4 * (lq_ >> 5);
                    LAS const float* bp = lut + (relb - 59); { unsigned bpu = (unsigned)(size_t)bp; asm volatile("" : "+v"(bpu)); bp = (LAS const float*)bpu; }
#pragma unroll
                    for (int r = 0; r < 16; ++r) { const int c = (r & 3) + 8 * (r >> 2); s0[r] += bp[59 - c]; s1[r] += bp[27 - c]; }
                    mx = DA_MAXALL(s0, s1); }
                else mx = mx_pre;
                mx = half_max(mx);
                if (first || __any(mx > DA_THR)) {
                    const float dl = first ? mx : fmaxf(mx, 0.f); const float al = __builtin_amdgcn_exp2f(-dl);
                    mref += dl; lrun *= al;
#pragma unroll
                    for (int c = 0; c < 4; ++c)
#pragma unroll
                        for (int r = 0; r < 16; ++r) oacc[c][r] *= al;
#pragma unroll
                    for (int r = 0; r < 16; ++r) { s0[r] -= dl; s1[r] -= dl; }
                    first = false; }
                DA_SB();
                f32x16 n0, n1;
                DA_QKM(t + 1, n0, n1);
#pragma unroll
                for (int r = 0; r < 16; ++r) { s0[r] = __builtin_amdgcn_exp2f(s0[r]); s1[r] = __builtin_amdgcn_exp2f(s1[r]); }
#pragma unroll
                for (int i = 0; i < 8; ++i) { __builtin_amdgcn_sched_group_barrier(0x008, 1, 0); __builtin_amdgcn_sched_group_barrier(0x400, 4, 0); }
                DA_SB();
                asm volatile("s_nop 1" : "+v"(s0), "+v"(s1));
                unsigned vp0u = (unsigned)(size_t)(L + DA_VRING + (t % 3) * DA_VSLOT) + (unsigned)vb0, vp1u = vp0u - (unsigned)vb0 + (unsigned)vb1;
                asm volatile("" : "+v"(vp0u), "+v"(vp1u));
                v4i16_t val[4], vah[4], vnl[4], vnh[4], vml[4], vmh[4];
                DA_LDV(0, va); DA_LDV(1, vn);
                DA_SB();
                bf16x8 pw[4];
                { v4u w;
                  w.x = cvtpk(s0[0], s0[1]); w.y = cvtpk(s0[2], s0[3]); w.z = cvtpk(s0[4], s0[5]); w.w = cvtpk(s0[6], s0[7]); pw[0] = __builtin_bit_cast(bf16x8, w);
                  w.x = cvtpk(s0[8], s0[9]); w.y = cvtpk(s0[10], s0[11]); w.z = cvtpk(s0[12], s0[13]); w.w = cvtpk(s0[14], s0[15]); pw[1] = __builtin_bit_cast(bf16x8, w); }
                DA_SB();
                float lsa = 0.f, lsb = 0.f, mxa, mxb;
#define DA_PVA(acc, vf, s, r, EXTRA) do { acc = __builtin_amdgcn_mfma_f32_32x32x16_bf16(DA_VF(vf, s), pw[s], acc, 0, 0, 0); lsa = fadd_s(lsa, s0[r]); lsb = fadd_s(lsb, s1[r]); EXTRA; if ((r) > 0) { s0[(r) - 1] = mov_s(n0[(r) - 1]); s1[(r) - 1] = mov_s(n1[(r) - 1]); } DA_SB(); } while (0)
                DA_LDV(2, vm); DA_LWAIT(15);
                DA_PVA(oacc[0], va, 0, 0, { v4u w; w.x = cvtpk(s1[0], s1[1]); w.y = cvtpk(s1[2], s1[3]); w.z = cvtpk(s1[4], s1[5]); w.w = cvtpk(s1[6], s1[7]); pw[2] = __builtin_bit_cast(bf16x8, w); });
                DA_PVA(oacc[0], va, 1, 1, { v4u w; w.x = cvtpk(s1[8], s1[9]); w.y = cvtpk(s1[10], s1[11]); w.z = cvtpk(s1[12], s1[13]); w.w = cvtpk(s1[14], s1[15]); pw[3] = __builtin_bit_cast(bf16x8, w); });
                DA_PVA(oacc[0], va, 2, 2, );
                DA_PVA(oacc[0], va, 3, 3, { mxa = max3f(n0[0], n0[1], n1[0]); mxb = max3f(n0[2], n0[3], n1[1]); });
                DA_LDV(3, va); DA_LWAIT(15);
                DA_PVA(oacc[1], vn, 0, 4, { mxa = max3f(mxa, n1[2], n1[3]); mxb = max3f(mxb, n0[6], n0[7]); });
                DA_PVA(oacc[1], vn, 1, 5, { mxa = max3f(mxa, n0[4], n0[5]); mxb = max3f(mxb, n1[6], n1[7]); });
                DA_PVA(oacc[1], vn, 2, 6, { mxa = max3f(mxa, n1[4], n1[5]); });
                DA_PVA(oacc[1], vn, 3, 7, { mxb = max3f(mxb, n0[10], n0[11]); });
                DA_LWAIT(8);
                DA_PVA(oacc[2], vm, 0, 8, { mxa = max3f(mxa, n0[8], n0[9]); });
                DA_PVA(oacc[2], vm, 1, 9, { mxb = max3f(mxb, n1[10], n1[11]); });
                DA_PVA(oacc[2], vm, 2, 10, { mxa = max3f(mxa, n1[8], n1[9]); });
                DA_PVA(oacc[2], vm, 3, 11, { mxb = max3f(mxb, n0[14], n0[15]); });
                DA_LWAIT(0);
                DA_PVA(oacc[3], va, 0, 12, { mxa = max3f(mxa, n0[12], n0[13]); });
                DA_PVA(oacc[3], va, 1, 13, { mxb = max3f(mxb, n1[14], n1[15]); });
                DA_PVA(oacc[3], va, 2, 14, { mxa = max3f(mxa, n1[12], n1[13]); });
                DA_PVA(oacc[3], va, 3, 15, { mx_pre = max3f(mxa, mxb, mxb); });
#undef DA_PVA
                lrun = fadd_s(lrun, fadd_s(lsa, lsb));
                s0[15] = mov_s(n0[15]); s1[15] = mov_s(n1[15]);
            }
#undef DA_SB
#undef DA_LDKQ
#undef DA_QKM
#undef DA_LDV
#undef DA_VF
#undef DA_LWAIT
#undef DA_ISSUE_K
#undef DA_ISSUE_V
            {
            int lane_e = lane; asm volatile("" : "+v"(lane_e));
            const int r32 = lane_e & 31, hi = lane_e >> 5, lane = lane_e;
            const float ltot = half_sum(lrun);
            const float rl = (map == 0 ? 1.0f : lam) / ltot;
#pragma unroll
            for (int c = 0; c < 4; ++c)
#pragma unroll
                for (int r = 0; r < 16; ++r) oacc[c][r] *= rl;
            __syncthreads();
            LAS f32x4* cb = (LAS f32x4*)(L + w4 * 16384) + lane;
            if (map == 1) {
#pragma unroll
                for (int c = 0; c < 4; ++c)
#pragma unroll
                    for (int g = 0; g < 4; ++g) cb[(c * 4 + g) * 64] = (f32x4){oacc[c][4 * g], oacc[c][4 * g + 1], oacc[c][4 * g + 2], oacc[c][4 * g + 3]};
            }
            __syncthreads();
            if (map == 0) {
                float ss = 0.f;
#pragma unroll
                for (int c = 0; c < 4; ++c)
#pragma unroll
                    for (int g = 0; g < 4; ++g) { const f32x4 tq = cb[(c * 4 + g) * 64];
                        oacc[c][4 * g] -= tq.x; oacc[c][4 * g + 1] -= tq.y; oacc[c][4 * g + 2] -= tq.z; oacc[c][4 * g + 3] -= tq.w;
                        ss += (oacc[c][4 * g] * oacc[c][4 * g] + oacc[c][4 * g + 1] * oacc[c][4 * g + 1]) + (oacc[c][4 * g + 2] * oacc[c][4 * g + 2] + oacc[c][4 * g + 3] * oacc[c][4 * g + 3]); }
                ss = half_sum(ss);
                const float rstd = (1.0f - lambda_init) / sqrtf(ss * (1.0f / 128.0f) + EPS);
                LAS unsigned char* st = L + DA_OST + w4 * (32 * DA_OROW);
#pragma unroll
                for (int c = 0; c < 4; ++c)
#pragma unroll
                    for (int g = 0; g < 4; ++g) { const int d = 32 * c + 8 * g + 4 * hi; const f32x4 sg = *(const LAS f32x4*)(sln + d);
                        const unsigned lo = cvtpk(oacc[c][4 * g] * rstd * sg.x, oacc[c][4 * g + 1] * rstd * sg.y), hi2 = cvtpk(oacc[c][4 * g + 2] * rstd * sg.z, oacc[c][4 * g + 3] * rstd * sg.w);
                        *(LAS unsigned long long*)(st + r32 * DA_OROW + d * 2) = (unsigned long long)lo | ((unsigned long long)hi2 << 32); }
                LDS_WAIT(); asm volatile("" ::: "memory");
                bf16* orow = o + ((size_t)b * SEQ + q0w) * DM + h * 128;
#pragma unroll
                for (int i = 0; i < 8; ++i) { const int idx = i * 64 + lane, row = idx >> 4, ch = idx & 15;
                    const unsigned long long a = *(LAS const unsigned long long*)(st + row * DA_OROW + ch * 16), bq = *(LAS const unsigned long long*)(st + row * DA_OROW + ch * 16 + 8);
                    v4u w; w.x = (unsigned)a; w.y = (unsigned)(a >> 32); w.z = (unsigned)bq; w.w = (unsigned)(bq >> 32);
                    *(GAS v4u*)(orow + (size_t)row * DM + ch * 8) = w; }
            }
            }
        }
    }
#undef DA_WAITBAR
#undef DA_WAITBAR_N
#if MK_DIAG_SEL >= 0
    if (blockIdx.x == 0 && F.wave == 0 && lane0 == 0) { float* dgo = (float*)(F.ws + WS_CTL + 65536); const float n = (float)dg[4];
        dgo[0] = (float)dg[0] / n; dgo[1] = (float)dg[1] / n; dgo[2] = (float)dg[2] / n; dgo[3] = (float)dg[3] / n; dgo[4] = n; }
#endif
}

constexpr size_t WS_HL = WS_H, WS_AC = WS_H + 32 * MiB;
constexpr size_t WS_SUMM = 3 * MiB;
constexpr int LRU_W = 512, NSEG = 32;
__device__ __forceinline__ float expm1_fast(float x) { const float p = x * (1.0f + x * (0.5f + x * (0.16666667f + x * (0.041666668f + x * 0.0083333338f)))); return x > -0.1f ? p : __expf(x) - 1.0f; }
__device__ __forceinline__ float fast_sigmoid(float z) { return __builtin_amdgcn_rcpf(1.0f + __expf(-z)); }
__device__ __forceinline__ void p_lru_local(Frame& F, const bf16* proj) {
    const float* conv_w = inp(F, 10); const float* conv_b = inp(F, 11); const float* ga_w = inp(F, 12); const float* ga_b = inp(F, 13); const float* gx_w = inp(F, 14); const float* gx_b = inp(F, 15); const float* lamp = inp(F, 16);
    const int lane = F.lane, r32 = lane & 31, hi = lane >> 5;
    const int g = blockIdx.x & 7;
    LAS unsigned char* WAl = F.lds;
    LAS float* Lc = (LAS float*)(F.lds + 16384);
    LAS float* cw = Lc; LAS float* cb = Lc + 256; LAS float* gab = Lc + 320; LAS float* gxb = Lc + 384; LAS float* lsl = Lc + 448;
    LAS float* hcs = (LAS float*)(F.lds + 20480 + F.wave * 512); LAS float* Acs = hcs + 64;
    __syncthreads();
    if (F.wave == 0) { const int c = g * 64 + lane;
      cw[lane] = conv_w[c]; cw[64 + lane] = conv_w[512 + c]; cw[128 + lane] = conv_w[1024 + c]; cw[192 + lane] = conv_w[1536 + c];
      cb[lane] = conv_b[c]; gab[lane] = ga_b[c]; gxb[lane] = gx_b[c]; lsl[lane] = logsig_f(lamp[c]); }
#pragma unroll
    for (int f2 = 0; f2 < 2; ++f2) { const int fi = 2 * F.wave + f2, rt = fi >> 2, ks = fi & 3;
        const float* wp = (rt < 2 ? ga_w : gx_w) + (size_t)g * 4096 + 32 * (rt & 1) + r32 + (16 * ks + 8 * hi) * 64; v4u w;
        w.x = cvtpk(wp[0], wp[64]); w.y = cvtpk(wp[128], wp[192]); w.z = cvtpk(wp[256], wp[320]); w.w = cvtpk(wp[384], wp[448]);
        *(LAS v4u*)(WAl + (fi * 64 + lane) * 16) = w; }
    __syncthreads();
    bf16x8 idf[2];
#pragma unroll
    for (int kk = 0; kk < 2; ++kk)
#pragma unroll
        for (int jj = 0; jj < 8; ++jj) idf[kk][jj] = (r32 == (16 * kk + 8 * hi + jj)) ? (short)0x3F80 : (short)0;
#define LRU_WA(rt, ks) (*(const LAS bf16x8*)(WAl + (((rt) * 4 + (ks)) * 64 + lane) * 16))
    bf16* HL = (bf16*)(F.ws + WS_HL); bf16* AC = (bf16*)(F.ws + WS_AC); float* SUMM = (float*)(F.ws + WS_SUMM);
    for (int item = (blockIdx.x >> 3) * 8 + F.wave; item < NB * NSEG; item += (F.G >> 3) * 8) {
        const int b = item / NSEG, seg = item % NSEG;
        hcs[lane] = 0.f; Acs[lane] = 1.f;
        LDS_WAIT(); asm volatile("" ::: "memory");
#pragma unroll 1
        for (int tile = 0; tile < 4; ++tile) {
            const int t = seg * 128 + tile * 32 + r32; const size_t row = (size_t)b * SEQ + t;
            bf16x8 Bf[4];
#pragma unroll
            for (int ks = 0; ks < 4; ++ks) { const int i0 = 16 * ks + 8 * hi; const bf16* xp = proj + row * EVEN_IN + 1536 + g * 64 + i0;
                float xc[8];
                { const f32x4 c0 = *(const LAS f32x4*)(cb + i0), c1 = *(const LAS f32x4*)(cb + i0 + 4); xc[0] = c0.x; xc[1] = c0.y; xc[2] = c0.z; xc[3] = c0.w; xc[4] = c1.x; xc[5] = c1.y; xc[6] = c1.z; xc[7] = c1.w; }
#pragma unroll
                for (int w = 0; w < 4; ++w) { const int back = 3 - w;
                    const bool inb = (t - back >= 0);
                    bf16x8 xv = *(const bf16x8*)(xp - (size_t)(inb ? back : 0) * EVEN_IN);
                    if (!inb) xv = (bf16x8){0, 0, 0, 0, 0, 0, 0, 0};
                    const f32x4 w0 = *(const LAS f32x4*)(cw + 64 * w + i0), w1 = *(const LAS f32x4*)(cw + 64 * w + i0 + 4);
                    xc[0] += w0.x * bf2f((bf16)xv[0]); xc[1] += w0.y * bf2f((bf16)xv[1]); xc[2] += w0.z * bf2f((bf16)xv[2]); xc[3] += w0.w * bf2f((bf16)xv[3]);
                    xc[4] += w1.x * bf2f((bf16)xv[4]); xc[5] += w1.y * bf2f((bf16)xv[5]); xc[6] += w1.z * bf2f((bf16)xv[6]); xc[7] += w1.w * bf2f((bf16)xv[7]); }
                v4u pk; pk.x = cvtpk(xc[0], xc[1]); pk.y = cvtpk(xc[2], xc[3]); pk.z = cvtpk(xc[4], xc[5]); pk.w = cvtpk(xc[6], xc[7]); Bf[ks] = __builtin_bit_cast(bf16x8, pk);
                __builtin_amdgcn_sched_barrier(0); }
#pragma unroll 1
            for (int rt2 = 0; rt2 < 2; ++rt2) {
                f32x16 Dr, Di, Dx;
#pragma unroll
                for (int r = 0; r < 16; ++r) { Dr[r] = 0.f; Di[r] = 0.f; Dx[r] = 0.f; }
#pragma unroll
                for (int ks = 0; ks < 4; ++ks) {
                    Dr = __builtin_amdgcn_mfma_f32_32x32x16_bf16(LRU_WA(rt2, ks), Bf[ks], Dr, 0, 0, 0);
                    Di = __builtin_amdgcn_mfma_f32_32x32x16_bf16(LRU_WA(2 + rt2, ks), Bf[ks], Di, 0, 0, 0);
                    if ((ks >> 1) == rt2) Dx = __builtin_amdgcn_mfma_f32_32x32x16_bf16(idf[ks & 1], Bf[ks], Dx, 0, 0, 0); }
                float av[16], hv[16];
#pragma unroll
                for (int a4 = 0; a4 < 4; ++a4) { const int ch = 32 * rt2 + 8 * a4 + 4 * hi;
                    const f32x4 ba = *(const LAS f32x4*)(gab + ch), bx = *(const LAS f32x4*)(gxb + ch), ls = *(const LAS f32x4*)(lsl + ch);
#pragma unroll
                    for (int q = 0; q < 4; ++q) { const int r = 4 * a4 + q;
                        const float rg = fast_sigmoid(Dr[r] + ba[q]), ig = fast_sigmoid(Di[r] + bx[q]);
                        const float log_a = 8.0f * rg * ls[q];
                        av[r] = __expf(log_a); hv[r] = __builtin_amdgcn_sqrtf(-expm1_fast(2.0f * log_a)) * (ig * Dx[r]); }
                    __builtin_amdgcn_sched_barrier(0); }
#define LRU_DPP(oldv, v, ctrl, rmask) __builtin_bit_cast(float, __builtin_amdgcn_update_dpp(__builtin_bit_cast(int, (float)(oldv)), __builtin_bit_cast(int, (float)(v)), (ctrl), (rmask), 0xf, false))
#define LRU_STEP(ctrl, rmask) do { _Pragma("unroll") for (int r = 0; r < 16; ++r) { const float ap = LRU_DPP(1.0f, av[r], ctrl, rmask), hp = LRU_DPP(0.0f, hv[r], ctrl, rmask); \
                        hv[r] = av[r] * hp + hv[r]; av[r] = av[r] * ap; } } while (0)
                LRU_STEP(0x111, 0xf); LRU_STEP(0x112, 0xf); LRU_STEP(0x114, 0xf); LRU_STEP(0x118, 0xf); LRU_STEP(0x142, 0xa);
#undef LRU_STEP
#undef LRU_DPP
                unsigned hp[4][2], ap[4][2];
#pragma unroll
                for (int a4 = 0; a4 < 4; ++a4) { const int ch = 32 * rt2 + 8 * a4 + 4 * hi;
                    const f32x4 hc = *(const LAS f32x4*)(hcs + ch), Ac = *(const LAS f32x4*)(Acs + ch);
                    f32x4 ho, ao;
#pragma unroll
                    for (int q = 0; q < 4; ++q) { const int r = 4 * a4 + q; ho[q] = hv[r] + av[r] * hc[q]; ao[q] = av[r] * Ac[q]; }
                    asm volatile("" ::: "memory");
                    if (r32 == 31) { *(LAS f32x4*)(hcs + ch) = ho; *(LAS f32x4*)(Acs + ch) = ao; }
                    hp[a4][0] = cvtpk(ho[0], ho[1]); hp[a4][1] = cvtpk(ho[2], ho[3]); ap[a4][0] = cvtpk(ao[0], ao[1]); ap[a4][1] = cvtpk(ao[2], ao[3]); }
#pragma unroll
                for (int k = 0; k < 2; ++k) {
#pragma unroll
                    for (int j = 0; j < 2; ++j) {
                        { auto r = __builtin_amdgcn_permlane32_swap(hp[2 * k][j], hp[2 * k + 1][j], false, false); hp[2 * k][j] = r[0]; hp[2 * k + 1][j] = r[1]; }
                        { auto r = __builtin_amdgcn_permlane32_swap(ap[2 * k][j], ap[2 * k + 1][j], false, false); ap[2 * k][j] = r[0]; ap[2 * k + 1][j] = r[1]; } }
                    const size_t o = row * LRU_W + g * 64 + 32 * rt2 + 16 * k + 8 * hi;
                    v4u wh, wa; wh.x = hp[2 * k][0]; wh.y = hp[2 * k][1]; wh.z = hp[2 * k + 1][0]; wh.w = hp[2 * k + 1][1];
                    wa.x = ap[2 * k][0]; wa.y = ap[2 * k][1]; wa.z = ap[2 * k + 1][0]; wa.w = ap[2 * k + 1][1];
                    *(GAS v4u*)(HL + o) = wh; *(GAS v4u*)(AC + o) = wa; }
                LDS_WAIT(); asm volatile("" ::: "memory");
            }
        }
        { float* sp = SUMM + ((size_t)(b * NSEG + seg) * 2) * LRU_W + g * 64; sp[lane] = Acs[lane]; sp[LRU_W + lane] = hcs[lane]; }
    }
#undef LRU_WA
}
__device__ __forceinline__ void p_lru_fix(Frame& F, const bf16* proj, bf16* mix) {
    const bf16* HL = (const bf16*)(F.ws + WS_HL); const bf16* AC = (const bf16*)(F.ws + WS_AC); const float* SUMM = (const float*)(F.ws + WS_SUMM);
    const int lane = F.lane;
    for (int u = F.gw; u < NB * NSEG * 8; u += F.NGW) {
        const int qt = u & 7, bs = u >> 3, b = bs / NSEG, seg = bs % NSEG;
        float c[8];
#pragma unroll
        for (int j = 0; j < 8; ++j) c[j] = 0.f;
        const float* sp0 = SUMM + ((size_t)(b * NSEG) * 2) * LRU_W + 8 * lane;
        int s = 0;
        for (; s + 4 <= seg; s += 4) {
            f32x4 a0[4], a1[4], h0[4], h1[4];
#pragma unroll
            for (int k = 0; k < 4; ++k) { const float* sp = sp0 + (size_t)(s + k) * 2 * LRU_W; a0[k] = *(const GAS f32x4*)sp; a1[k] = *(const GAS f32x4*)(sp + 4); h0[k] = *(const GAS f32x4*)(sp + LRU_W); h1[k] = *(const GAS f32x4*)(sp + LRU_W + 4); }
#pragma unroll
            for (int k = 0; k < 4; ++k) {
                c[0] = a0[k].x * c[0] + h0[k].x; c[1] = a0[k].y * c[1] + h0[k].y; c[2] = a0[k].z * c[2] + h0[k].z; c[3] = a0[k].w * c[3] + h0[k].w;
                c[4] = a1[k].x * c[4] + h1[k].x; c[5] = a1[k].y * c[5] + h1[k].y; c[6] = a1[k].z * c[6] + h1[k].z; c[7] = a1[k].w * c[7] + h1[k].w; } }
        for (; s < seg; ++s) { const float* sp = sp0 + (size_t)s * 2 * LRU_W;
            const f32x4 a0 = *(const GAS f32x4*)sp, a1 = *(const GAS f32x4*)(sp + 4), h0 = *(const GAS f32x4*)(sp + LRU_W), h1 = *(const GAS f32x4*)(sp + LRU_W + 4);
            c[0] = a0.x * c[0] + h0.x; c[1] = a0.y * c[1] + h0.y; c[2] = a0.z * c[2] + h0.z; c[3] = a0.w * c[3] + h0.w;
            c[4] = a1.x * c[4] + h1.x; c[5] = a1.y * c[5] + h1.y; c[6] = a1.z * c[6] + h1.z; c[7] = a1.w * c[7] + h1.w; }
#pragma unroll 4
        for (int i = 0; i < 16; ++i) {
            const size_t row = (size_t)b * SEQ + seg * 128 + qt * 16 + i;
            const bf16x8 hl = *(const bf16x8*)(HL + row * LRU_W + 8 * lane), ac = *(const bf16x8*)(AC + row * LRU_W + 8 * lane), gb = *(const bf16x8*)(proj + row * EVEN_IN + 2048 + 8 * lane);
            float y[8];
#pragma unroll
            for (int j = 0; j < 8; ++j) { const float g = bf2f((bf16)gb[j]); const float u2 = 1.5957691216057308f * (g + 0.044715f * g * g * g);
                y[j] = (bf2f((bf16)hl[j]) + bf2f((bf16)ac[j]) * c[j]) * (g * __builtin_amdgcn_rcpf(1.0f + __expf(-u2))); }
            v4u w; w.x = cvtpk(y[0], y[1]); w.y = cvtpk(y[2], y[3]); w.z = cvtpk(y[4], y[5]); w.w = cvtpk(y[6], y[7]);
            *(GAS v4u*)(mix + row * DM + 512 + 8 * lane) = w;
        }
    }
}

constexpr int SB_LDS0 = 32768;
constexpr float LN2 = 0.6931471805599453f;
#define SB_QSCALE_COLS 512
#define SB_QSCALE (0.125f * LOG2E)
constexpr float SB_STOP = -40.0f * LOG2E;
__device__ __forceinline__ void p_sb_attn(Frame& F, const bf16* proj, bf16* mix) {
    const int lane = F.lane, wave = F.wave, r32 = lane & 31, hi = lane >> 5;
    LAS unsigned char* Vw = F.lds + SB_LDS0 + wave * 8192;
    const int q4 = (lane & 15) >> 2, p4 = lane & 3, blk = (lane >> 4) & 1;
    const int vb0 = 64 * (4 * hi + q4) + 16 * ((2 * blk + (p4 >> 1)) ^ hi) + 8 * (p4 & 1);
    const int vb1 = 1024 + 64 * (4 * hi + q4) + 16 * ((2 * blk + (p4 >> 1)) ^ (2 + hi)) + 8 * (p4 & 1);
    const int vkl = (lane >> 2) & 7, vchE = 4 * (lane >> 5) + ((lane & 3) ^ ((lane >> 4) & 1)), vchO = 4 * (lane >> 5) + ((lane & 3) ^ (2 + ((lane >> 4) & 1)));
    const unsigned voE = (unsigned)(vkl * EVEN_IN + 8 * vchE) * 2u, voO = (unsigned)(vkl * EVEN_IN + 8 * vchO) * 2u;
    bf16x8 Tp[2], ONES;
#pragma unroll
    for (int ks = 0; ks < 2; ++ks)
#pragma unroll
        for (int jj = 0; jj < 8; ++jj) Tp[ks][jj] = ((16 * ks + 8 * (jj >> 2) + 4 * hi + (jj & 3)) > r32) ? (short)0x3F80 : (short)0;
#pragma unroll
    for (int jj = 0; jj < 8; ++jj) ONES[jj] = (short)0x3F80;
    for (int u = F.gw; u < NB * 8 * (SEQ / 32); u += F.NGW) {
        const int qt = u % (SEQ / 32), h = (u / (SEQ / 32)) % 8, b = u / (8 * (SEQ / 32)), qw = qt * 32;
        const bf16* base = proj + (size_t)b * SEQ * EVEN_IN;
        bf16x8 qf[4];
        { const bf16* qp = base + (size_t)(qw + r32) * EVEN_IN + h * 64 + 8 * hi;
#pragma unroll
          for (int d0 = 0; d0 < 4; ++d0) qf[d0] = *(const bf16x8*)(qp + 16 * d0); }
        f32x16 oacc[2];
#pragma unroll
        for (int c = 0; c < 2; ++c)
#pragma unroll
            for (int r = 0; r < 16; ++r) oacc[c][r] = 0.f;
        float R = 0.f;
        const int qpos = qw + r32;
#pragma unroll 1
        for (int k0 = ((qw + 30) >> 6) << 6; k0 >= 0; k0 -= 64) {
            LDS_WAIT();
            { const char* vg = (const char*)(base + (size_t)k0 * EVEN_IN + 1024 + h * 64);
#pragma unroll
              for (int p = 0; p < 8; ++p)
                  __builtin_amdgcn_global_load_lds((const unsigned*)(vg + (size_t)(8 * p) * EVEN_IN * 2 + ((p & 1) ? voO : voE)), (LAS unsigned*)(Vw + p * 1024), 16, 0, 0); }
            f32x16 p0, p1;
#pragma unroll
            for (int r = 0; r < 16; ++r) { p0[r] = 0.f; p1[r] = 0.f; }
            { const bf16* kp = base + (size_t)(k0 + r32) * EVEN_IN + 512 + h * 64 + 8 * hi;
#pragma unroll
              for (int d0 = 0; d0 < 4; ++d0) { const bf16x8 a0 = *(const bf16x8*)(kp + 16 * d0), a1 = *(const bf16x8*)(kp + (size_t)32 * EVEN_IN + 16 * d0);
                  p0 = __builtin_amdgcn_mfma_f32_32x32x16_bf16(a0, qf[d0], p0, 0, 0, 0);
                  p1 = __builtin_amdgcn_mfma_f32_32x32x16_bf16(a1, qf[d0], p1, 0, 0, 0); } }
            float Lsum = 0.f; bf16x8 Lh[4], Ll[4];
#define SB_SOFT(MASKED) \
            _Pragma("unroll") for (int half = 0; half < 2; ++half) { \
                float Lv[16]; \
                _Pragma("unroll") for (int r = 0; r < 16; ++r) { const float z = half ? p1[r] : p0[r]; \
                    const float sp = __builtin_amdgcn_logf(1.0f + __builtin_amdgcn_exp2f(-fabsf(z))); \
                    float lp = fminf(z, 0.f) - sp, lv = -fmaxf(z, 0.f) - sp; \
                    if (MASKED) { const bool valid = (k0 + 32 * half + crow(r, hi)) < qpos; lv = valid ? lv : 0.f; lp = valid ? lp : -INFINITY; } \
                    Lv[r] = lv; Lsum += lv; if (half) p1[r] = lp; else p0[r] = lp; } \
                _Pragma("unroll") for (int s = 0; s < 2; ++s) { v4u wh, wl; unsigned hv[4], lv[4]; \
                    _Pragma("unroll") for (int i = 0; i < 4; ++i) { const float x0 = Lv[8 * s + 2 * i], x1 = Lv[8 * s + 2 * i + 1]; hv[i] = cvtpk(x0, x1); \
                        const float r0 = x0 - __uint_as_float(hv[i] << 16), r1 = x1 - __uint_as_float(hv[i] & 0xffff0000u); lv[i] = cvtpk(r0, r1); } \
                    wh.x = hv[0]; wh.y = hv[1]; wh.z = hv[2]; wh.w = hv[3]; wl.x = lv[0]; wl.y = lv[1]; wl.z = lv[2]; wl.w = lv[3]; \
                    Lh[2 * half + s] = __builtin_bit_cast(bf16x8, wh); Ll[2 * half + s] = __builtin_bit_cast(bf16x8, wl); } }
            if (k0 + 63 >= qw) { SB_SOFT(1) } else { SB_SOFT(0) }
#undef SB_SOFT
            __builtin_amdgcn_sched_barrier(0);
            f32x16 l0, l1;
#pragma unroll
            for (int r = 0; r < 16; ++r) { l0[r] = R + p0[r]; l1[r] = R + p1[r]; }
#pragma unroll
            for (int ks = 0; ks < 2; ++ks) {
                l0 = __builtin_amdgcn_mfma_f32_32x32x16_bf16(Tp[ks], Lh[ks], l0, 0, 0, 0); l0 = __builtin_amdgcn_mfma_f32_32x32x16_bf16(Tp[ks], Ll[ks], l0, 0, 0, 0);
                l0 = __builtin_amdgcn_mfma_f32_32x32x16_bf16(ONES, Lh[2 + ks], l0, 0, 0, 0); l0 = __builtin_amdgcn_mfma_f32_32x32x16_bf16(ONES, Ll[2 + ks], l0, 0, 0, 0);
                l1 = __builtin_amdgcn_mfma_f32_32x32x16_bf16(Tp[ks], Lh[2 + ks], l1, 0, 0, 0); l1 = __builtin_amdgcn_mfma_f32_32x32x16_bf16(Tp[ks], Ll[2 + ks], l1, 0, 0, 0); }
            R += half_sum(Lsum);
            bf16x8 pw[4];
            { v4u w;
#define SBW(P, Lx, r) __builtin_amdgcn_exp2f(Lx[r])
              w.x = cvtpk(SBW(p0, l0, 0), SBW(p0, l0, 1)); w.y = cvtpk(SBW(p0, l0, 2), SBW(p0, l0, 3)); w.z = cvtpk(SBW(p0, l0, 4), SBW(p0, l0, 5)); w.w = cvtpk(SBW(p0, l0, 6), SBW(p0, l0, 7)); pw[0] = __builtin_bit_cast(bf16x8, w);
              w.x = cvtpk(SBW(p0, l0, 8), SBW(p0, l0, 9)); w.y = cvtpk(SBW(p0, l0, 10), SBW(p0, l0, 11)); w.z = cvtpk(SBW(p0, l0, 12), SBW(p0, l0, 13)); w.w = cvtpk(SBW(p0, l0, 14), SBW(p0, l0, 15)); pw[1] = __builtin_bit_cast(bf16x8, w);
              w.x = cvtpk(SBW(p1, l1, 0), SBW(p1, l1, 1)); w.y = cvtpk(SBW(p1, l1, 2), SBW(p1, l1, 3)); w.z = cvtpk(SBW(p1, l1, 4), SBW(p1, l1, 5)); w.w = cvtpk(SBW(p1, l1, 6), SBW(p1, l1, 7)); pw[2] = __builtin_bit_cast(bf16x8, w);
              w.x = cvtpk(SBW(p1, l1, 8), SBW(p1, l1, 9)); w.y = cvtpk(SBW(p1, l1, 10), SBW(p1, l1, 11)); w.z = cvtpk(SBW(p1, l1, 12), SBW(p1, l1, 13)); w.w = cvtpk(SBW(p1, l1, 14), SBW(p1, l1, 15)); pw[3] = __builtin_bit_cast(bf16x8, w);
#undef SBW
            }
            asm volatile("s_waitcnt vmcnt(0)" ::: "memory");
#pragma unroll
            for (int c = 0; c < 2; ++c) {
                bf16x8 va[4];
#pragma unroll
                for (int s = 0; s < 4; ++s) va[s] = vfrag(Vw + vb0 + 2048 * s + 512 * c, Vw + vb1 + 2048 * s + 512 * c);
#pragma unroll
                for (int s = 0; s < 4; ++s) oacc[c] = __builtin_amdgcn_mfma_f32_32x32x16_bf16(va[s], pw[s], oacc[c], 0, 0, 0);
            }
            if (__all(R < SB_STOP)) break;
        }
        bf16* op = mix + ((size_t)b * SEQ + qpos) * DM + h * 64 + 8 * hi;
#pragma unroll
        for (int c = 0; c < 2; ++c)
#pragma unroll
            for (int k = 0; k < 2; ++k) {
                unsigned ax = cvtpk(oacc[c][8 * k], oacc[c][8 * k + 1]), ay = cvtpk(oacc[c][8 * k + 2], oacc[c][8 * k + 3]);
                unsigned bx = cvtpk(oacc[c][8 * k + 4], oacc[c][8 * k + 5]), by = cvtpk(oacc[c][8 * k + 6], oacc[c][8 * k + 7]);
                { auto r = __builtin_amdgcn_permlane32_swap(ax, bx, false, false); ax = r[0]; bx = r[1]; }
                { auto r = __builtin_amdgcn_permlane32_swap(ay, by, false, false); ay = r[0]; by = r[1]; }
                v4u w; w.x = ax; w.y = ay; w.z = bx; w.w = by;
                *(GAS v4u*)(op + 32 * c + 16 * k) = w; }
    }
}

#ifndef MK_NAIVE_DIFF
#define MK_NAIVE_DIFF 0
#endif
constexpr int NPHASE = 19;
#ifndef MK_REP3_SUB
#define MK_REP3_SUB 0
#endif
#ifndef MK_REPEAT_PHASE
#define MK_REPEAT_PHASE -1
#endif
#ifndef MK_REPEAT_COUNT
#define MK_REPEAT_COUNT 2
#endif
#ifndef MK_NAIVE_MIX0
#define MK_NAIVE_MIX0 0
#endif
struct Args { const float* in[32]; float* out; unsigned char* ws; int ph_lo, ph_hi; float lambda_init; int pad; };
__global__ void __launch_bounds__(NWAVES * 64, 2) mk_fwd(Args args) {
    extern __shared__ __attribute__((aligned(16))) unsigned char lds[];
    Frame F;
    F.lds = (LAS unsigned char*)lds; F.MISC = (volatile LAS unsigned*)(F.lds + MISC_OFF);
    F.wave = __builtin_amdgcn_readfirstlane(threadIdx.x >> 6); F.lane = mk_lane(); F.tid = F.wave * 64 + F.lane;
    F.G = gridDim.x; F.gw = blockIdx.x * NWAVES + F.wave; F.NGW = F.G * NWAVES;
    F.out = args.out; F.ws = args.ws; F.ctl = (gu32*)(args.ws + WS_CTL);
    for (int u = F.tid; u < (LDS_BYTES - MISC_OFF) / 4; u += NWAVES * 64) ((LAS unsigned*)(F.lds + MISC_OFF))[u] = 0u;
    __syncthreads();
    if (F.tid < 32) ((LAS unsigned long long*)(F.lds + MISC_OFF + 512))[F.tid] = (unsigned long long)args.in[F.tid];
    __syncthreads();
    const int lo = args.ph_lo, hi = args.ph_hi;
    const bool one = (hi - lo) > 1;
    XcdBarrier bar; bar.bar = (unsigned*)(F.ctl + CW_BAR); bar.x = 0; bar.st = nullptr; bar.wave = F.wave;
    if (one) bar = xcd_barrier_post((unsigned*)(F.ctl + CW_BAR), F.MISC + 8, F.wave);
#define IN(k) (lo <= (k) && (k) < hi && ((F.lane = mk_lane()), (F.tid = F.wave * 64 + F.lane), true))
#define SEAM(k) do { if (IN(k) && IN((k) + 1)) xcd_barrier(bar); } while (0)
    unsigned char* ws = args.ws;
    float* xo = args.out;
    const float* mod0 = (const float*)(ws + WS_MOD); const float* mod1 = mod0 + (size_t)NB * 6144;
    bf16* H = (bf16*)(ws + WS_H); bf16* PROJ = (bf16*)(ws + WS_PROJ); bf16* MIX = (bf16*)args.out;                   bf16* ACT = (bf16*)(ws + WS_ACT); bf16* XB = (bf16*)(ws + WS_XB);
    const int G = F.G, cid = (int)blockIdx.x;

    if (IN(0)) for (int rep_ = 0; rep_ < ((MK_REPEAT_PHASE == 0) ? MK_REPEAT_COUNT : 1); ++rep_) { if (rep_ > 0) __syncthreads();  p_prologue(F); } SEAM(0);
    if (IN(1)) for (int rep_ = 0; rep_ < ((MK_REPEAT_PHASE == 1) ? MK_REPEAT_COUNT : 1); ++rep_) { if (rep_ > 0) __syncthreads();  p_norm_mod<false>(F, inp(F, 0), H, inp(F, 5), mod0, 0, 1024); } SEAM(1);
    if (IN(2)) for (int rep_ = 0; rep_ < ((MK_REPEAT_PHASE == 2) ? MK_REPEAT_COUNT : 1); ++rep_) { if (rep_ > 0) __syncthreads();  pg8::SchedPlain S; S.init(H, ws + WS_WIN0, MTOK, EVEN_IN, DM, G, cid); pg8::EpiStore E{(pg8::bf16_t*)PROJ, EVEN_IN, SB_QSCALE_COLS, SB_QSCALE};
                 pg8::gphase<pg8::EpiStore, pg8::SchedPlain, false>(F.lds, DM, S, E, F.wave, F.lane); } SEAM(2);
    if (IN(3)) for (int rep_ = 0; rep_ < ((MK_REPEAT_PHASE == 3) ? MK_REPEAT_COUNT : 1); ++rep_) { if (rep_ > 0) __syncthreads();
#if MK_NAIVE_MIX0
        if (F.wave == 0) { if (cid < NB * 8) p_lru_naive_wave(F, cid, PROJ, MIX); } else p_sb_naive(F, PROJ, MIX);
#else
        if (rep_ == 0 || MK_REP3_SUB != 2) p_lru_local(F, PROJ);
        if (rep_ == 0 || MK_REP3_SUB != 1) p_sb_attn(F, PROJ, MIX);
#endif
    } SEAM(3);
    if (IN(4)) for (int rep_ = 0; rep_ < ((MK_REPEAT_PHASE == 4) ? MK_REPEAT_COUNT : 1); ++rep_) { if (rep_ > 0) __syncthreads();
#if !MK_NAIVE_MIX0
        p_lru_fix(F, PROJ, MIX);
#endif
    } SEAM(4);

    if (IN(5)) for (int rep_ = 0; rep_ < ((MK_REPEAT_PHASE == 5) ? MK_REPEAT_COUNT : 1); ++rep_) { if (rep_ > 0) __syncthreads();  pg8::SchedPlain S; S.init(MIX, ws + WS_WOUT0, MTOK, DM, DM, G, cid); pg8::EpiResid<false> E{inp(F, 0), (pg8::bf16_t*)XB, mod0 + 2048, 6144, SEQ, DM, 0};
                 pg8::gphase<pg8::EpiResid<false>, pg8::SchedPlain, false>(F.lds, DM, S, E, F.wave, F.lane); } SEAM(5);
    if (IN(6)) for (int rep_ = 0; rep_ < ((MK_REPEAT_PHASE == 6) ? MK_REPEAT_COUNT : 1); ++rep_) { if (rep_ > 0) __syncthreads();  p_norm_mod<true>(F, XB, H, inp(F, 6), mod0, 3072, 4096); } SEAM(6);
    if (IN(7)) for (int rep_ = 0; rep_ < ((MK_REPEAT_PHASE == 7) ? MK_REPEAT_COUNT : 1); ++rep_) { if (rep_ > 0) __syncthreads();  pg8::SchedPlain S; S.init(H, ws + WS_WGU0, MTOK, 2 * FFD, DM, G, cid); pg8::EpiSwiglu E{(pg8::bf16_t*)ACT, FFD, 0};
                 pg8::gphase<pg8::EpiSwiglu, pg8::SchedPlain, false>(F.lds, DM, S, E, F.wave, F.lane); } SEAM(7);
    if (IN(8)) for (int rep_ = 0; rep_ < ((MK_REPEAT_PHASE == 8) ? MK_REPEAT_COUNT : 1); ++rep_) { if (rep_ > 0) __syncthreads();  pg8::SchedPlain S; S.init(ACT, ws + WS_WD0, MTOK, DM, FFD, G, cid); pg8::EpiResid<true> E{XB, (pg8::bf16_t*)XB, mod0 + 5120, 6144, SEQ, DM, 0};
                 pg8::gphase<pg8::EpiResid<true>, pg8::SchedPlain, false>(F.lds, FFD, S, E, F.wave, F.lane); } SEAM(8);
    if (IN(9)) for (int rep_ = 0; rep_ < ((MK_REPEAT_PHASE == 9) ? MK_REPEAT_COUNT : 1); ++rep_) { if (rep_ > 0) __syncthreads();  p_norm_mod<true>(F, XB, H, inp(F, 5) + DM, mod1, 0, 1024); } SEAM(9);
    if (IN(10)) for (int rep_ = 0; rep_ < ((MK_REPEAT_PHASE == 10) ? MK_REPEAT_COUNT : 1); ++rep_) { if (rep_ > 0) __syncthreads();  pg8::SchedPlain S; S.init(H, ws + WS_WIN1, MTOK, ODD_IN, DM, G, cid); pg8::EpiStore E{(pg8::bf16_t*)PROJ, ODD_IN, ATTN_QSCALE_COLS, ATTN_QSCALE};
                 pg8::gphase<pg8::EpiStore, pg8::SchedPlain, false>(F.lds, DM, S, E, F.wave, F.lane); } SEAM(10);
    if (IN(11)) for (int rep_ = 0; rep_ < ((MK_REPEAT_PHASE == 11) ? MK_REPEAT_COUNT : 1); ++rep_) { if (rep_ > 0) __syncthreads();
#if MK_NAIVE_DIFF
        p_diff_naive(F, PROJ, MIX, args.lambda_init);
#else
#ifdef MK_ATTN_VAR
        if (rep_ == 0) p_diff_attn(F, PROJ, MIX, args.lambda_init); else p_diff_attn_t<MK_ATTN_VAR>(F, PROJ, H, args.lambda_init);
#else
        p_diff_attn(F, PROJ, MIX, args.lambda_init);
#endif
#endif
    } SEAM(11);
    if (IN(12)) for (int rep_ = 0; rep_ < ((MK_REPEAT_PHASE == 12) ? MK_REPEAT_COUNT : 1); ++rep_) { if (rep_ > 0) __syncthreads();  pg8::SchedPlain S; S.init(MIX, ws + WS_WOUT1, MTOK, DM, DM, G, cid); pg8::EpiResid<true> E{XB, (pg8::bf16_t*)XB, mod1 + 2048, 6144, SEQ, DM, 0};
                  pg8::gphase<pg8::EpiResid<true>, pg8::SchedPlain, false>(F.lds, DM, S, E, F.wave, F.lane); } SEAM(12);
    if (IN(13)) for (int rep_ = 0; rep_ < ((MK_REPEAT_PHASE == 13) ? MK_REPEAT_COUNT : 1); ++rep_) { if (rep_ > 0) __syncthreads();  p_router(F, XB, H, inp(F, 6) + DM, mod1, 3072, 4096); } SEAM(13);
    int ntiles = 0;
    LAS int* mtab = (LAS int*)(F.lds + MISC_OFF + 256);
    if (hi > 14 && lo < 18) {
        int acc_t = 0;
#pragma unroll
        for (int e = 0; e < NEXP; ++e) { const int c = (int)__builtin_amdgcn_readfirstlane(__hip_atomic_load(F.ctl + CW_CNT + 64 * e, RLX_AGENT));
            if (F.tid == 0) { mtab[e] = acc_t; mtab[16 + e] = c; } acc_t += (c + 255) >> 8; }
        if (F.tid == 0) mtab[8] = acc_t;
        ntiles = acc_t;
        __syncthreads();
    }
    const int nA = ntiles < MOE_CHUNK_TILES ? ntiles : MOE_CHUNK_TILES, nAB = ntiles < 2 * MOE_CHUNK_TILES ? ntiles : 2 * MOE_CHUNK_TILES, nB = nAB - nA, nO = ntiles - nAB;
    const bool fancy = (G == 256) && nO > 0 && nB == MOE_CHUNK_TILES;
    const int nd = fancy ? 4 * nO : 0;
    const int* list = (const int*)(ws + WS_LIST);
#define MOE_SCHED(S, Aptr, Wptr, Kk, gat, t0_, nM_, nN_, ovfat_, mode_) pg8::SchedMoe S; S.A = (const char*)(Aptr); S.W = (const char*)(Wptr); S.wstride = WMOE_STRIDE; S.list = list; S.cap = LIST_CAP; S.tab = mtab; \
        S.t0 = (t0_); S.K = (Kk); S.gather = (gat); S.ovf_at = (ovfat_); S.ovf_tile0 = 2 * MOE_CHUNK_TILES; S.mode = (mode_); S.nd = nd; S.rounds = ((nM_) * (nN_) + G - 1) / G; S.so.init((nM_) * 256, (nN_) * 256, G, cid)
    if (IN(14)) for (int rep_ = 0; rep_ < ((MK_REPEAT_PHASE == 14) ? MK_REPEAT_COUNT : 1); ++rep_) { if (rep_ > 0) __syncthreads();  MOE_SCHED(S, H, ws + WS_WMOE, DM, 1, 0, nA + (fancy ? nO : 0), 2 * FFE / 256, nA, 0);
                  pg8::EpiSwiglu E{(pg8::bf16_t*)ACT, FFE, 0};
                  pg8::gphase<pg8::EpiSwiglu, pg8::SchedMoe, true>(F.lds, DM, S, E, F.wave, F.lane); } SEAM(14);
    if (IN(15)) for (int rep_ = 0; rep_ < ((MK_REPEAT_PHASE == 15) ? MK_REPEAT_COUNT : 1); ++rep_) { if (rep_ > 0) __syncthreads();  MOE_SCHED(S, ACT, ws + WS_WMOE + WMOE_D_OFF, FFE, 0, 0, nA, DM / 256, 1 << 30, 0);
                  pg8::EpiMoeDown E{(pg8::bf16_t*)xo, list, LIST_CAP};
                  pg8::gphase<pg8::EpiMoeDown, pg8::SchedMoe, false>(F.lds, FFE, S, E, F.wave, F.lane); } SEAM(15);
    if (IN(16)) for (int rep_ = 0; rep_ < ((MK_REPEAT_PHASE == 16) ? MK_REPEAT_COUNT : 1); ++rep_) { if (rep_ > 0) __syncthreads();  if (fancy) { MOE_SCHED(S, ACT, ws + WS_WMOE + WMOE_D_OFF, FFE, 0, 0, nO, DM / 256, MOE_CHUNK_TILES, 2);
                      pg8::EpiMoeDown E{(pg8::bf16_t*)xo, list, LIST_CAP};
                      pg8::gphase<pg8::EpiMoeDown, pg8::SchedMoe, false>(F.lds, FFE, S, E, F.wave, F.lane); }
                  { MOE_SCHED(S, H, ws + WS_WMOE, DM, 1, nA, nB + (fancy ? 0 : nO), 2 * FFE / 256, 1 << 30, fancy ? 1 : 0);
                    pg8::EpiSwiglu E{(pg8::bf16_t*)ACT, FFE, 0};
                    pg8::gphase<pg8::EpiSwiglu, pg8::SchedMoe, true>(F.lds, DM, S, E, F.wave, F.lane); } } SEAM(16);
    if (IN(17)) for (int rep_ = 0; rep_ < ((MK_REPEAT_PHASE == 17) ? MK_REPEAT_COUNT : 1); ++rep_) { if (rep_ > 0) __syncthreads();  MOE_SCHED(S, ACT, ws + WS_WMOE + WMOE_D_OFF, FFE, 0, nA, nB + (fancy ? 0 : nO), DM / 256, 1 << 30, 0);
                  pg8::EpiMoeDown E{(pg8::bf16_t*)xo, list, LIST_CAP};
                  pg8::gphase<pg8::EpiMoeDown, pg8::SchedMoe, false>(F.lds, FFE, S, E, F.wave, F.lane); } SEAM(17);
#undef MOE_SCHED
    if (IN(18)) for (int rep_ = 0; rep_ < ((MK_REPEAT_PHASE == 18) ? MK_REPEAT_COUNT : 1); ++rep_) { if (rep_ > 0) __syncthreads();  p_final(F, XB, mod1 + 5120, inp(F, 7)); }
#undef IN
#undef SEAM
}

#ifndef MK_ONE_LAUNCH
#define MK_ONE_LAUNCH 1
#endif
extern "C" void kernel_launch(void* const* d_in, const int* in_sizes, int n_in, void* d_out, int out_size, void* d_ws, size_t ws_size, hipStream_t stream) {
    static int grid = 0;
    if (grid == 0) {
        int dev = 0, cus = 0;
        if (hipGetDevice(&dev) != hipSuccess || hipDeviceGetAttribute(&cus, hipDeviceAttributeMultiprocessorCount, dev) != hipSuccess) { grid = -1; return; }
        if (n_in != 32 || ws_size < WS_END) { fprintf(stderr, "kernel_launch: unexpected n_in %d / ws %zu\n", n_in, ws_size); grid = -1; return; }
        if (hipFuncSetAttribute((const void*)mk_fwd, hipFuncAttributeMaxDynamicSharedMemorySize, LDS_BYTES) != hipSuccess) { grid = -1; return; }
        grid = cus;
    }
    if (grid < 0) return;
    (void)hipMemsetAsync((char*)d_ws + WS_CTL, 0, CTL_ZERO_BYTES, stream);
    Args a{};
    for (int i = 0; i < 32; ++i) a.in[i] = (const float*)d_in[i];
    a.out = (float*)d_out; a.ws = (unsigned char*)d_ws; a.lambda_init = (float)(0.8 - 0.6 * exp(-0.3 * 1.0)); a.pad = 0;
#if MK_ONE_LAUNCH
    a.ph_lo = 0; a.ph_hi = NPHASE;
    hipLaunchKernelGGL(mk_fwd, dim3(grid), dim3(NWAVES * 64), LDS_BYTES, stream, a);
#else
    for (int p = 0; p < NPHASE; ++p) { a.ph_lo = p; a.ph_hi = p + 1; hipLaunchKernelGGL(mk_fwd, dim3(grid), dim3(NWAVES * 64), LDS_BYTES, stream, a); }
#endif
}
```

```cpp
#include <hip/hip_runtime.h>
#include <cstdio>
#include <cstdint>
#include <cmath>
namespace pg8 {
#define PG8_LAS __attribute__((address_space(3)))
typedef unsigned short bf16_t;
typedef short bf16x8 __attribute__((ext_vector_type(8)));
typedef float f32x4 __attribute__((ext_vector_type(4)));
typedef unsigned u32x4 __attribute__((ext_vector_type(4)));
constexpr int BM = 256, BK = 64, HALF = 128, HTB = HALF * BK * 2  , STAGE_BYTES = 8 * HTB, NXCD = 8, WGM = 8;

__host__ __device__ __forceinline__ int lds_byte(int r, int c) { const int st = (r >> 4) * 2 + (c >> 5), rr = r & 15, cc = c & 31, ob = rr * 64 + cc * 2; return st * 1024 + (ob ^ (((ob >> 9) & 1) << 5)); }
__host__ __device__ __forceinline__ void stage_rc(int b, int& R, int& C) { const int st = b / 1024, sb = b % 1024, swz = sb ^ (((sb >> 9) & 1) << 5); R = (st >> 1) * 16 + swz / 64; C = (st & 1) * 32 + (swz % 64) / 2; }
__host__ __device__ __forceinline__ int perm32(int rho) { const int n = rho >> 4, i = rho & 15; return 8 * (i >> 2) + 4 * n + (i & 3); }

struct Unit { int pm, pn; };
struct Gemm { const bf16_t* A; const bf16_t* Bt; int M, N, K, pad; };

struct StaticOrder {
    int nM, nN, nwg, G, c;
    __host__ __device__ void init(int M, int N, int G_, int c_) { nM = M / BM; nN = N / BM; nwg = nM * nN; G = G_; c = c_; }
    __host__ __device__ bool next(int i, Unit& u) const {
        const long L = (long)i * G + c; if (L >= nwg) return false;
        int wgid = (int)L; { const int q = nwg / NXCD, r = nwg % NXCD, xcd = wgid % NXCD, off = wgid / NXCD; wgid = (xcd < r ? xcd * (q + 1) : r * (q + 1) + (xcd - r) * q) + off; }
        const int nig = WGM * nN, gid = wgid / nig, fm = gid * WGM, gsz = (nM - fm) < WGM ? (nM - fm) : WGM;
        u.pm = fm + ((wgid % nig) % gsz); u.pn = (wgid % nig) / gsz; return true;
    }
    __device__ __forceinline__ void a_ready(const Unit&) const {}
    __device__ __forceinline__ void done(const Unit&) const {}
};

__device__ __forceinline__ unsigned cvt_pk_bf16(float lo, float hi) { typedef float f2_ __attribute__((ext_vector_type(2))); typedef __bf16 b2_ __attribute__((ext_vector_type(2))); const f2_ v = {lo, hi}; const b2_ b = __builtin_convertvector(v, b2_); return __builtin_bit_cast(unsigned, b); }
typedef float f32x2 __attribute__((ext_vector_type(2)));
__device__ __forceinline__ f32x2 gelu_pk(f32x2 v) {
    const f32x2 av = __builtin_elementwise_abs(v), d = av * 0.2316418882f + 1.0f;
    f32x2 t; t.x = __builtin_amdgcn_rcpf(d.x); t.y = __builtin_amdgcn_rcpf(d.y);
    f32x2 q = t * 0.5307027145f + (-0.7265760135f); q = q * t + 0.7107068705f; q = q * t + (-0.142248368f); q = q * t + 0.127414796f; q = q * t;
    const f32x2 s = (v * v) * (-0.72134752044f);
    f32x2 e; e.x = __builtin_amdgcn_exp2f(s.x); e.y = __builtin_amdgcn_exp2f(s.y);
    const f32x2 m = v * (q * e), r = v - m;
    f32x2 o; o.x = v.x < 0.f ? m.x : r.x; o.y = v.y < 0.f ? m.y : r.y; return o;
}

template <int ACT  > struct EpiBf16 {
    static constexpr bool PERM = true, AFTER_DRAIN = false; static_assert(ACT == 0 || ACT == 1, "EpiBf16: ACT is 0 (none) or 1 (gelu_pk)");
    bf16_t* O; int ldc; const float* bias; int split_cols; size_t split_stride; float scale0;
    __device__ __forceinline__ void operator()(const f32x4 (&acc)[2][2][4][2], const Unit& u, int wr, int wc, int fr, int fq) const {
        const int row0 = u.pm * BM + wr * 64 + fr; int colt = u.pn * BM; bf16_t* base = O;
        float sc = 1.f; if (split_cols) { const int t = colt / split_cols; base += (size_t)t * split_stride; colt -= t * split_cols; if (t == 0) sc = scale0; }
        const int col0 = colt + wc * 32 + 8 * fq, bcol0 = u.pn * BM + wc * 32 + 8 * fq;
        f32x4 bv[2][2];
#pragma unroll
        for (int bj = 0; bj < 2; ++bj)
#pragma unroll
            for (int n = 0; n < 2; ++n) bv[bj][n] = bias ? *(const f32x4*)(bias + bcol0 + bj * HALF + 4 * n) : (f32x4){0.f, 0.f, 0.f, 0.f};
#pragma unroll
        for (int ai = 0; ai < 2; ++ai)
#pragma unroll
            for (int m = 0; m < 4; ++m) { bf16_t* rowp = base + (size_t)(row0 + ai * HALF + m * 16) * ldc + col0;
#pragma unroll
                for (int bj = 0; bj < 2; ++bj) { f32x4 v0 = acc[ai][bj][m][0] + bv[bj][0], v1 = acc[ai][bj][m][1] + bv[bj][1];
                    if (ACT == 1) { f32x2 a = gelu_pk((f32x2){v0[0], v0[1]}), b = gelu_pk((f32x2){v0[2], v0[3]}), c = gelu_pk((f32x2){v1[0], v1[1]}), d = gelu_pk((f32x2){v1[2], v1[3]});
                        v0 = (f32x4){a.x, a.y, b.x, b.y}; v1 = (f32x4){c.x, c.y, d.x, d.y}; }
                    v0 = v0 * sc; v1 = v1 * sc; u32x4 w; w.x = cvt_pk_bf16(v0[0], v0[1]); w.y = cvt_pk_bf16(v0[2], v0[3]); w.z = cvt_pk_bf16(v1[0], v1[1]); w.w = cvt_pk_bf16(v1[2], v1[3]);
                    *(u32x4*)(rowp + bj * HALF) = w; } }
    }
};
struct UnitX { int pm, pn; const char* A; const char* B; int e, nvalid, r0, pad; };
__device__ __forceinline__ float silu_f(float x) { return x * __builtin_amdgcn_rcpf(1.0f + __expf(-x)); }
__device__ __forceinline__ float swiglu_pre(float g, float u) { return (g * u) * __builtin_amdgcn_rcpf(1.0f + __builtin_amdgcn_exp2f(g)); }
template <bool XIN_BF16> struct EpiResid {
    static constexpr bool PERM = true, AFTER_DRAIN = false;
    const void* xin; bf16_t* xout; const float* gate; int gate_ld; int rows_per_batch; int ldc; int pad;
    __device__ __forceinline__ void operator()(const f32x4 (&acc)[2][2][4][2], const UnitX& u, int wr, int wc, int fr, int fq) const {
        const int row0 = u.pm * BM + wr * 64 + fr, col0 = u.pn * BM + wc * 32 + 8 * fq;
        const int b = (u.pm * BM) / rows_per_batch;
        f32x4 gv[2][2];
#pragma unroll
        for (int bj = 0; bj < 2; ++bj)
#pragma unroll
            for (int n = 0; n < 2; ++n) gv[bj][n] = *(const f32x4*)(gate + (size_t)b * gate_ld + col0 + bj * HALF + 4 * n);
#pragma unroll
        for (int ai = 0; ai < 2; ++ai)
#pragma unroll
            for (int m = 0; m < 4; ++m) { const int row = row0 + ai * HALF + m * 16; const size_t off = (size_t)row * ldc + col0;
#pragma unroll
                for (int bj = 0; bj < 2; ++bj) {
                    f32x4 x0, x1;
                    if constexpr (XIN_BF16) { const u32x4 xw = *(const u32x4*)((const bf16_t*)xin + off + bj * HALF);
                        x0 = (f32x4){__uint_as_float(xw.x << 16), __uint_as_float(xw.x & 0xffff0000u), __uint_as_float(xw.y << 16), __uint_as_float(xw.y & 0xffff0000u)};
                        x1 = (f32x4){__uint_as_float(xw.z << 16), __uint_as_float(xw.z & 0xffff0000u), __uint_as_float(xw.w << 16), __uint_as_float(xw.w & 0xffff0000u)}; }
                    else { x0 = *(const f32x4*)((const float*)xin + off + bj * HALF); x1 = *(const f32x4*)((const float*)xin + off + bj * HALF + 4); }
                    const f32x4 y0 = x0 + gv[bj][0] * acc[ai][bj][m][0], y1 = x1 + gv[bj][1] * acc[ai][bj][m][1];
                    u32x4 w; w.x = cvt_pk_bf16(y0[0], y0[1]); w.y = cvt_pk_bf16(y0[2], y0[3]); w.z = cvt_pk_bf16(y1[0], y1[1]); w.w = cvt_pk_bf16(y1[2], y1[3]);
                    *(u32x4*)(xout + off + bj * HALF) = w; } }
    }
};
struct EpiSwiglu {
    static constexpr bool PERM = true, AFTER_DRAIN = false;
    bf16_t* O; int ldc; int pad;
    __device__ __forceinline__ void operator()(const f32x4 (&acc)[2][2][4][2], const UnitX& u, int wr, int wc, int fr, int fq) const {
        const int row0 = u.pm * BM + wr * 64 + fr, col0 = u.pn * HALF + wc * 32 + 8 * fq;
#pragma unroll
        for (int ai = 0; ai < 2; ++ai)
#pragma unroll
            for (int m = 0; m < 4; ++m) { bf16_t* rowp = O + (size_t)(row0 + ai * HALF + m * 16) * ldc + col0;
                const f32x4 g0 = acc[ai][0][m][0], g1 = acc[ai][0][m][1], u0 = acc[ai][1][m][0], u1 = acc[ai][1][m][1];
                u32x4 w;
                w.x = cvt_pk_bf16(swiglu_pre(g0[0], u0[0]), swiglu_pre(g0[1], u0[1])); w.y = cvt_pk_bf16(swiglu_pre(g0[2], u0[2]), swiglu_pre(g0[3], u0[3]));
                w.z = cvt_pk_bf16(swiglu_pre(g1[0], u1[0]), swiglu_pre(g1[1], u1[1])); w.w = cvt_pk_bf16(swiglu_pre(g1[2], u1[2]), swiglu_pre(g1[3], u1[3]));
                *(u32x4*)rowp = w; }
    }
};
struct EpiStore {
    static constexpr bool PERM = true, AFTER_DRAIN = false;
    bf16_t* O; long ldc; int scale_cols; float scale;
    __device__ __forceinline__ void operator()(const f32x4 (&acc)[2][2][4][2], const UnitX& u, int wr, int wc, int fr, int fq) const {
        const int row0 = u.pm * BM + wr * 64 + fr, col0 = u.pn * BM + wc * 32 + 8 * fq;
        const float sc = (u.pn * BM < scale_cols) ? scale : 1.0f;
#pragma unroll
        for (int ai = 0; ai < 2; ++ai)
#pragma unroll
            for (int m = 0; m < 4; ++m) { bf16_t* rowp = O + (size_t)(row0 + ai * HALF + m * 16) * ldc + col0;
#pragma unroll
                for (int bj = 0; bj < 2; ++bj) { const f32x4 v0 = acc[ai][bj][m][0] * sc, v1 = acc[ai][bj][m][1] * sc; u32x4 w;
                    w.x = cvt_pk_bf16(v0[0], v0[1]); w.y = cvt_pk_bf16(v0[2], v0[3]); w.z = cvt_pk_bf16(v1[0], v1[1]); w.w = cvt_pk_bf16(v1[2], v1[3]);
                    *(u32x4*)(rowp + bj * HALF) = w; } }
    }
};
struct EpiMoeDown {
    static constexpr bool PERM = true, AFTER_DRAIN = false;
    bf16_t* Y; const int* list; long cap;
    __device__ __forceinline__ void operator()(const f32x4 (&acc)[2][2][4][2], const UnitX& u, int wr, int wc, int fr, int fq) const {
        const int col0 = u.pn * BM + wc * 32 + 8 * fq;
        const int* lp = list + (size_t)u.e * cap + u.r0;
#pragma unroll
        for (int ai = 0; ai < 2; ++ai)
#pragma unroll
            for (int m = 0; m < 4; ++m) { const int r = ai * HALF + wr * 64 + m * 16 + fr;
                if (r < u.nvalid) { const int entry = lp[r]; bf16_t* rowp = Y + (size_t)entry * 1024 + col0;
#pragma unroll
                    for (int bj = 0; bj < 2; ++bj) { const f32x4 v0 = acc[ai][bj][m][0], v1 = acc[ai][bj][m][1]; u32x4 w;
                        w.x = cvt_pk_bf16(v0[0], v0[1]); w.y = cvt_pk_bf16(v0[2], v0[3]); w.z = cvt_pk_bf16(v1[0], v1[1]); w.w = cvt_pk_bf16(v1[2], v1[3]);
                        *(u32x4*)(rowp + bj * HALF) = w; } } }
    }
};
struct SchedPlain {
    const char* A; const char* Bt; int K; StaticOrder so;
    __device__ __forceinline__ void init(const void* A_, const void* Bt_, int M, int N, int K_, int G, int c) { A = (const char*)A_; Bt = (const char*)Bt_; K = K_; so.init(M, N, G, c); }
    __device__ __forceinline__ bool next(int i, UnitX& u) const { Unit t; if (!so.next(i, t)) return false; u.pm = t.pm; u.pn = t.pn; u.A = A + (size_t)t.pm * BM * K * 2; u.B = Bt + (size_t)t.pn * BM * K * 2; u.e = 0; u.nvalid = BM; u.r0 = 0; u.pad = 0; return true; }
};
struct SchedMoe {
    const char* A; const char* W; size_t wstride; const int* list; long cap; const PG8_LAS int* tab; int t0, K, gather, ovf_at, ovf_tile0, mode, nd, rounds; StaticOrder so;
    static constexpr int ND_DROP = 3;
    __device__ __forceinline__ bool deal(int i, Unit& t) const {
        if (mode == 0) return so.next(i, t);
        if (mode == 2) { if (i != 0 || so.c >= nd) return false; t.pm = ovf_at + (so.c >> 2); t.pn = so.c & 3; return true; }
        if (so.c < nd) return i < rounds - ND_DROP ? so.next(i, t) : false;
        if (i < rounds) return so.next(i, t);
        const int j = so.c - nd; if (i != rounds || j >= ND_DROP * nd) return false;
        StaticOrder o2 = so; o2.c = j % nd; return o2.next(rounds - ND_DROP + j / nd, t);
    }
    __device__ __forceinline__ bool next(int i, UnitX& u) const {
        Unit t; if (!deal(i, t)) return false;
        const int tile = t.pm < ovf_at ? t0 + t.pm : ovf_tile0 + (t.pm - ovf_at); int e = 0;
#pragma unroll
        for (int j = 1; j < 8; ++j) e += (tile >= tab[j]) ? 1 : 0;
        const int tse = tab[e], ce = tab[16 + e];
        u.pm = t.pm; u.pn = t.pn; u.e = e; u.r0 = (tile - tse) * BM; u.nvalid = ce - u.r0 < BM ? ce - u.r0 : BM; u.pad = 0;
        u.A = gather ? A : A + (size_t)t.pm * BM * K * 2; u.B = W + (size_t)e * wstride + (size_t)t.pn * BM * K * 2; return true;
    }
    __device__ __forceinline__ void a_tok_async(const UnitX& u, const int (&R)[2], int (&tok)[2][2]) const {
        const int* lp = list + (size_t)u.e * cap + u.r0;
#pragma unroll
        for (int h = 0; h < 2; ++h)
#pragma unroll
            for (int i = 0; i < 2; ++i) { const int r = h * HALF + R[i]; const int* ap = lp + (r < u.nvalid ? r : u.nvalid - 1);
                asm volatile("global_load_dword %0, %1, off" : "=v"(tok[h][i]) : "v"(ap) : "memory"); }
    }
    __device__ __forceinline__ void a_off(const UnitX& u, const int (&R)[2], const int (&C2)[2], unsigned (&go)[2][2]) const {
        const int* lp = list + (size_t)u.e * cap + u.r0; int tok[2][2];
#pragma unroll
        for (int h = 0; h < 2; ++h)
#pragma unroll
            for (int i = 0; i < 2; ++i) { const int r = h * HALF + R[i]; tok[h][i] = lp[r < u.nvalid ? r : u.nvalid - 1] >> 1; }
#pragma unroll
        for (int h = 0; h < 2; ++h)
#pragma unroll
            for (int i = 0; i < 2; ++i) go[h][i] = (unsigned)tok[h][i] * (unsigned)(K * 2) + (unsigned)C2[i];
    }
};
template <class Epi, class Sched, bool GATHER, bool ALIGN_EPI = true>
__device__ __forceinline__ void gphase(PG8_LAS unsigned char* lds, const int K, const Sched& S, const Epi& E, const int wid, const int lane) {
    const int tid = wid * 64 + lane, wr = wid >> 2, wc = wid & 3, fr = lane & 15, fq = lane >> 4;
    const int nt = K / BK;
    unsigned voffB[2]; int RA[2], CA2[2];
#pragma unroll
    for (int i = 0; i < 2; ++i) { int R, C; stage_rc(tid * 16 + i * 8192, R, C); const int Rb = Epi::PERM ? ((R & ~31) + perm32(R & 31)) : R;
        RA[i] = R; CA2[i] = C * 2; voffB[i] = (unsigned)(Rb * K + C) * 2u; }
    const size_t kstep = (size_t)(BK * 2);
    const size_t hstep = (size_t)HALF * K * 2;
    const unsigned ldsw = (unsigned)wid * 1024u;
    const int aoff = lds_byte(wr * 64 + fr, fq * 8), boff = lds_byte(wc * 32 + fr, fq * 8);
#define PG8_SA(b, h) (((b) * 2 + (h)) * HTB)
#define PG8_SB(b, h) ((4 + (b) * 2 + (h)) * HTB)
#define PG8_STAGE(bufoff, gbase, voff) do { _Pragma("unroll") for (int _i = 0; _i < 2; ++_i) \
        __builtin_amdgcn_global_load_lds((const unsigned*)((const char*)(gbase) + (voff)[_i]), (PG8_LAS unsigned*)(lds + (bufoff) + ldsw + _i * 8192), 16, 0, 0); } while (0)
#define PG8_LDA(dst, b, h) do { _Pragma("unroll") for (int m = 0; m < 4; ++m) _Pragma("unroll") for (int k = 0; k < 2; ++k) dst[m][k] = *(const PG8_LAS bf16x8*)(lds + PG8_SA(b, h) + aoff + m * 2048 + k * 1024); } while (0)
#define PG8_LDB(dst, b, h) do { _Pragma("unroll") for (int n = 0; n < 2; ++n) _Pragma("unroll") for (int k = 0; k < 2; ++k) dst[n][k] = *(const PG8_LAS bf16x8*)(lds + PG8_SB(b, h) + boff + n * 2048 + k * 1024); } while (0)
#define PG8_MMA(ai, bj, At, Bt) do { __builtin_amdgcn_s_setprio(1); _Pragma("unroll") for (int m = 0; m < 4; ++m) _Pragma("unroll") for (int n = 0; n < 2; ++n) _Pragma("unroll") for (int k = 0; k < 2; ++k) \
        acc[ai][bj][m][n] = __builtin_amdgcn_mfma_f32_16x16x32_bf16(Bt[n][k], At[m][k], acc[ai][bj][m][n], 0, 0, 0); __builtin_amdgcn_s_setprio(0); } while (0)
#define PG8_WAIT_V(n) asm volatile("s_waitcnt vmcnt(" #n ")" ::: "memory")
#define PG8_WAIT_L(n) asm volatile("s_waitcnt lgkmcnt(" #n ")" ::: "memory")
#define PG8_BAR __builtin_amdgcn_s_barrier()
#define PG8_SCHED __builtin_amdgcn_sched_barrier(0)
    UnitX cur, nxt; int ui = 0;
    if (!S.next(0, cur)) return;
    unsigned goC[2][2], goN[2][2];
    if constexpr (GATHER) { S.a_off(cur, RA, CA2, goC); }
    else {
#pragma unroll
        for (int h = 0; h < 2; ++h)
#pragma unroll
            for (int i = 0; i < 2; ++i) goC[h][i] = (unsigned)(RA[i] * K * 2 + CA2[i]) + (unsigned)h * (unsigned)hstep; }
#pragma unroll
    for (int h = 0; h < 2; ++h)
#pragma unroll
        for (int i = 0; i < 2; ++i) goN[h][i] = goC[h][i];
    f32x4 acc[2][2][4][2];
#pragma unroll
    for (int a = 0; a < 2; ++a)
#pragma unroll
        for (int b = 0; b < 2; ++b)
#pragma unroll
            for (int m = 0; m < 4; ++m)
#pragma unroll
                for (int n = 0; n < 2; ++n) acc[a][b][m][n] = (f32x4){0.f, 0.f, 0.f, 0.f};
    bf16x8 At[4][2], B0[2][2], B1[2][2];
    const char* cA = cur.A; const char* cB = cur.B;
    PG8_STAGE(PG8_SB(0, 0), cB, voffB); PG8_STAGE(PG8_SB(0, 1), cB + hstep, voffB); PG8_STAGE(PG8_SA(0, 0), cA, goC[0]); PG8_STAGE(PG8_SA(0, 1), cA, goC[1]);
    if (wr == 1) PG8_BAR;
    PG8_WAIT_V(2); PG8_BAR;
    PG8_STAGE(PG8_SB(1, 0), cB + kstep, voffB); PG8_STAGE(PG8_SA(1, 0), cA + kstep, goC[0]); PG8_STAGE(PG8_SB(1, 1), cB + hstep + kstep, voffB);
    PG8_WAIT_V(6); PG8_BAR;
    for (;;) {
        const bool has_next = S.next(ui + 1, nxt);
        int tokN[2][2] = {{0, 0}, {0, 0}};
        if constexpr (GATHER) { if (has_next) S.a_tok_async(nxt, RA, tokN); }
        const char* nA = has_next ? nxt.A : cA; const char* nB = has_next ? nxt.B : cB;
        for (int t = 0; t < nt; t += 2) {
            const bool last = (t == nt - 2);
            const char* a1 = cA + (size_t)(t + 1) * kstep;
            const char* a2 = last ? nA : cA + (size_t)(t + 2) * kstep; const char* b2 = last ? nB : cB + (size_t)(t + 2) * kstep;
            const char* a3 = a2 + kstep; const char* b3 = b2 + kstep;
            unsigned g2[2][2];
#pragma unroll
            for (int h = 0; h < 2; ++h)
#pragma unroll
                for (int i = 0; i < 2; ++i) { if constexpr (GATHER) { asm volatile("" : "+v"(tokN[h][i])); goN[h][i] = (unsigned)(tokN[h][i] >> 1) * (unsigned)(K * 2) + (unsigned)CA2[i]; }
                    g2[h][i] = (GATHER && last && has_next) ? goN[h][i] : goC[h][i]; }
            PG8_LDB(B0, 0, 0); PG8_LDB(B1, 0, 1); PG8_SCHED; PG8_LDA(At, 0, 0); PG8_STAGE(PG8_SA(1, 1), a1, goC[1]);
            PG8_WAIT_V(8); PG8_WAIT_L(0); PG8_BAR; PG8_MMA(0, 0, At, B0); PG8_MMA(0, 1, At, B1); PG8_BAR; PG8_SCHED;
            PG8_LDA(At, 0, 1); PG8_STAGE(PG8_SB(0, 0), b2, voffB); PG8_STAGE(PG8_SB(0, 1), b2 + hstep, voffB); PG8_STAGE(PG8_SA(0, 0), a2, g2[0]);
            PG8_WAIT_V(8); PG8_WAIT_L(0); PG8_BAR; PG8_MMA(1, 0, At, B0); PG8_MMA(1, 1, At, B1); PG8_BAR; PG8_SCHED;
            PG8_LDB(B0, 1, 0); PG8_LDB(B1, 1, 1); PG8_SCHED; PG8_LDA(At, 1, 0); PG8_STAGE(PG8_SA(0, 1), a2, g2[1]);
            PG8_WAIT_V(8); PG8_WAIT_L(0); PG8_BAR; PG8_MMA(0, 0, At, B0); PG8_MMA(0, 1, At, B1); PG8_BAR; PG8_SCHED;
            PG8_LDA(At, 1, 1); PG8_STAGE(PG8_SB(1, 0), b3, voffB); PG8_STAGE(PG8_SB(1, 1), b3 + hstep, voffB); PG8_STAGE(PG8_SA(1, 0), a3, g2[0]);
            PG8_WAIT_V(8); PG8_WAIT_L(0); PG8_BAR; PG8_MMA(1, 0, At, B0); PG8_MMA(1, 1, At, B1); PG8_BAR; PG8_SCHED;
        }
        if constexpr (ALIGN_EPI) { if (wr == 0) PG8_BAR; }
        E(acc, cur, wr, wc, fr, fq);
        if (!has_next) break;
#pragma unroll
        for (int a = 0; a < 2; ++a)
#pragma unroll
            for (int b = 0; b < 2; ++b)
#pragma unroll
                for (int m = 0; m < 4; ++m)
#pragma unroll
                    for (int n = 0; n < 2; ++n) acc[a][b][m][n] = (f32x4){0.f, 0.f, 0.f, 0.f};
        cur = nxt; cA = nA; cB = nB; ++ui;
#pragma unroll
        for (int h = 0; h < 2; ++h)
#pragma unroll
            for (int i = 0; i < 2; ++i) goC[h][i] = goN[h][i];
        if constexpr (ALIGN_EPI) { if (wr == 1) PG8_BAR; }
    }
    PG8_WAIT_V(0);
    if constexpr (!ALIGN_EPI) { if (wr == 0) PG8_BAR; }
    PG8_BAR;
#undef PG8_SA
#undef PG8_SB
#undef PG8_STAGE
#undef PG8_LDA
#undef PG8_LDB
#undef PG8_MMA
#undef PG8_WAIT_V
#undef PG8_WAIT_L
#undef PG8_BAR
#undef PG8_SCHED
}
}
#define GAS __attribute__((address_space(1)))
#define LAS __attribute__((address_space(3)))
typedef unsigned short bf16;
typedef unsigned v4u __attribute__((ext_vector_type(4)));
typedef float f32x4 __attribute__((ext_vector_type(4)));
typedef short bf16x8 __attribute__((ext_vector_type(8)));
typedef GAS unsigned gu32;
typedef GAS unsigned long long gu64;
#define RLX_AGENT __ATOMIC_RELAXED, __HIP_MEMORY_SCOPE_AGENT
#define LDS_WAIT() asm volatile("s_waitcnt lgkmcnt(0)" ::: "memory")
#define VM_WAIT() asm volatile("s_waitcnt vmcnt(0)" ::: "memory")
__device__ __forceinline__ unsigned long long rt() { return __builtin_amdgcn_s_memrealtime(); }
__device__ __forceinline__ unsigned f2bf(float f) { unsigned u = __builtin_bit_cast(unsigned, f); return (u + 0x7fffu + ((u >> 16) & 1u)) >> 16; }
__device__ __forceinline__ unsigned pk2(float lo, float hi) { typedef float f2v_ __attribute__((ext_vector_type(2))); typedef __bf16 b2v_ __attribute__((ext_vector_type(2))); f2v_ v = {lo, hi}; b2v_ b = __builtin_convertvector(v, b2v_); return __builtin_bit_cast(unsigned, b); }

#define XB_TMO      128
#define XB_XCNT(j)  (256  + 64 * (j))
#define XB_XSUB(j)  (1280 + 64 * (j))
#define XB_XGEN(j)  (2304 + 64 * (j))
#define XB_TOP      3328
#define XB_TOPGEN   3392
#define XCD_BAR_WORDS 3456
#define XB_SPIN_CAP (1u << 18)

__device__ __forceinline__ unsigned xb_ld(unsigned* p)              { return __hip_atomic_load(p, __ATOMIC_RELAXED, __HIP_MEMORY_SCOPE_AGENT); }
__device__ __forceinline__ unsigned xb_add(unsigned* p, unsigned v) { return __hip_atomic_fetch_add(p, v, __ATOMIC_RELAXED, __HIP_MEMORY_SCOPE_AGENT); }
__device__ __forceinline__ unsigned xb_xcc_id() { return (unsigned)__builtin_amdgcn_s_getreg((3 << 11) | 20) & 0xFu; }
#define XB_SPIN(cond, bar) do { unsigned _sp = 0; while (cond) { __builtin_amdgcn_s_sleep(1); \
    if ((++_sp & 255u) == 0u) { if (xb_ld(&(bar)[XB_TMO])) break; if (_sp > XB_SPIN_CAP) { atomicAdd(&(bar)[XB_TMO], 1u); break; } } } } while (0)

__device__ __forceinline__ int mk_lane() { int l; asm volatile("v_mbcnt_lo_u32_b32 %0, -1, 0\n\tv_mbcnt_hi_u32_b32 %0, -1, %0" : "=v"(l)); return l; }
struct XcdBarrier {
    unsigned* bar; unsigned x; int wave;
    volatile LAS unsigned* st;
};

__device__ __forceinline__ XcdBarrier xcd_barrier_post(unsigned* bar, volatile LAS unsigned* st, int wave) {
    XcdBarrier b; b.bar = bar; b.x = xb_xcc_id(); b.st = st; b.wave = wave;
    if (wave == 0 && mk_lane() == 0) (void)xb_add(&bar[XB_XCNT(b.x)], 1u);
    return b;
}
__device__ __forceinline__ void xcd_barrier_complete(unsigned* bar, unsigned x, unsigned& nloc, unsigned& nx) {
    const unsigned G = gridDim.x * gridDim.y * gridDim.z;
    unsigned sum, cnt, mine, sp = 0u;
    for (;;) {
        sum = 0u; cnt = 0u; mine = 0u;
#pragma unroll
        for (unsigned j = 0; j < 16; ++j) { const unsigned c = xb_ld(&bar[XB_XCNT(j)]); sum += c; cnt += (c > 0u) ? 1u : 0u; mine = (j == x) ? c : mine; }
        if (sum == G) break;
        __builtin_amdgcn_s_sleep(1);
        if ((++sp & 255u) == 0u) { if (xb_ld(&bar[XB_TMO])) break; if (sp > XB_SPIN_CAP) { atomicAdd(&bar[XB_TMO], 1u); break; } }
    }
    nloc = mine > 0u ? mine : 1u; nx = cnt > 0u ? cnt : 1u;
}

__device__ __forceinline__ void xcd_barrier(const XcdBarrier& b) {
    asm volatile("s_waitcnt vmcnt(0)" ::: "memory");
    __syncthreads();
    if (b.wave == 0 && mk_lane() == 0) {
        unsigned* bar = b.bar;
        __builtin_amdgcn_s_waitcnt(0);
        unsigned nloc = b.st[0], nx = b.st[1];
        if (nloc == 0u) { xcd_barrier_complete(bar, b.x, nloc, nx); b.st[0] = nloc; b.st[1] = nx; }
        const unsigned old = xb_add(&bar[XB_XSUB(b.x)], 1u);
        const unsigned gen = old / nloc;
        if (old + 1u == (gen + 1u) * nloc) {
            __builtin_amdgcn_fence(__ATOMIC_RELEASE, "agent");
            asm volatile("s_waitcnt vmcnt(0)" ::: "memory");
            const unsigned og = xb_add(&bar[XB_TOP], 1u);
            const unsigned tg = og / nx;
            if (og + 1u == (tg + 1u) * nx) xb_add(&bar[XB_TOPGEN], 1u);
            else XB_SPIN(xb_ld(&bar[XB_TOPGEN]) == tg, bar);
            __builtin_amdgcn_fence(__ATOMIC_ACQUIRE, "agent");
            xb_add(&bar[XB_XGEN(b.x)], 1u);
            asm volatile("s_waitcnt vmcnt(0)" ::: "memory");
        } else {
            XB_SPIN(xb_ld(&bar[XB_XGEN(b.x)]) == gen, bar);
            __builtin_amdgcn_fence(__ATOMIC_ACQUIRE, "agent");
            asm volatile("s_waitcnt vmcnt(0)" ::: "memory");
        }
    }
    __syncthreads();
}
#ifndef MK_DIAG_SEL
#define MK_DIAG_SEL -1
#endif
#ifndef MK_DIAG_SCALE
#define MK_DIAG_SCALE 1e-5f
#endif
constexpr int NB = 8, SEQ = 4096, DM = 1024, MTOK = NB * SEQ;
constexpr int EVEN_IN = 2560, ODD_IN = 3072, FFD = 2816, FFE = 3584, NEXP = 8;
constexpr float EPS = 1e-6f;
constexpr size_t MiB = 1u << 20;
constexpr int NWAVES = 8;
constexpr size_t WS_CTL = 0, CTL_ZERO_BYTES = 1 * MiB;
constexpr size_t WS_MOD = 1 * MiB;
constexpr size_t WS_TOPW = 2 * MiB;
constexpr size_t WS_LIST = 3 * MiB;
constexpr size_t WS_WIN0 = 4 * MiB, WS_WOUT0 = 9 * MiB, WS_WGU0 = 11 * MiB, WS_WD0 = 22 * MiB, WS_WIN1 = 28 * MiB, WS_WOUT1 = 34 * MiB;
constexpr size_t WS_WMOE = 40 * MiB, WMOE_STRIDE = 21 * MiB, WMOE_D_OFF = 14 * MiB;
constexpr size_t WS_H = 208 * MiB;
constexpr size_t WS_PROJ = 272 * MiB;
constexpr size_t WS_MIX = 464 * MiB;
constexpr size_t WS_ACT = 272 * MiB;
constexpr size_t WS_XB = 510 * MiB;
constexpr size_t WS_END = 574 * MiB;
constexpr long LIST_CAP = 32768;
constexpr int MOE_CHUNK_TILES = 128;
constexpr int CW_BAR = 4096;
constexpr int CW_CNT = 8192;
constexpr int RING_BYTES = 131072, MISC_OFF = RING_BYTES, LDS_BYTES = 135168;

__device__ __forceinline__ float bf2f(bf16 v) { return __builtin_bit_cast(float, (unsigned)v << 16); }
__device__ __forceinline__ float wave_sum(float v) {
#pragma unroll
    for (int o = 1; o < 64; o <<= 1) v += __shfl_xor(v, o);
    return v;
}
__device__ __forceinline__ float logsig_f(float z) { return fminf(z, 0.f) - log1pf(expf(-fabsf(z))); }
__device__ __forceinline__ float sigmoid_f(float z) { return 1.0f / (1.0f + expf(-z)); }
__device__ __forceinline__ float gelu_tanh_f(float x) { const float t = tanhf(0.7978845608028654f * (x + 0.044715f * x * x * x)); return 0.5f * x * (1.0f + t); }

struct Frame {
    LAS unsigned char* lds; volatile LAS unsigned* MISC; gu32* ctl;
    int tid, lane, wave, G, gw, NGW;
    float* out; unsigned char* ws;
};
__device__ __forceinline__ const float* inp(const Frame& F, int i) {
    const unsigned long long v = ((const LAS unsigned long long*)(F.lds + MISC_OFF + 512))[i];
    const unsigned lo = __builtin_amdgcn_readfirstlane((unsigned)v), hi = __builtin_amdgcn_readfirstlane((unsigned)(v >> 32));
    return (const float*)(((unsigned long long)hi << 32) | lo);
}

typedef short v4i16p __attribute__((ext_vector_type(4)));
constexpr int TR_ROW = 288;
template <bool SCALED = false> __device__ __forceinline__ void transpose_item(const float* W, int N, int k0, int n0, bf16* dst, int ldk, LAS unsigned char* scr, int lane, float sc = 1.0f) {
    const int l32 = lane & 31, rh = lane >> 5;
    const GAS f32x4* src = (const GAS f32x4*)(W + (size_t)(k0 + rh) * N + n0) + l32;
    const size_t rs2 = (size_t)(N >> 1);
    {
        f32x4 v[16];
#pragma unroll
        for (int i = 0; i < 16; ++i) v[i] = src[(size_t)i * rs2];
#pragma unroll
        for (int i = 0; i < 16; ++i) { if constexpr (SCALED) v[i] = v[i] * sc; *(LAS unsigned long long*)(scr + (2 * i + rh) * TR_ROW + 8 * l32) = (unsigned long long)pk2(v[i].x, v[i].y) | ((unsigned long long)pk2(v[i].z, v[i].w) << 32); }
    }
    LDS_WAIT(); asm volatile("" ::: "memory");
    const int kc = lane >> 4, li = lane & 15, q = li >> 2, p = li & 3;
    LAS unsigned char* rb = scr + (8 * kc + q) * TR_ROW + 8 * p;
#pragma unroll
    for (int j = 0; j < 8; ++j) {
        const v4i16p lo = __builtin_amdgcn_ds_read_tr16_b64_v4i16((LAS v4i16p*)(rb + 32 * j)), hi = __builtin_amdgcn_ds_read_tr16_b64_v4i16((LAS v4i16p*)(rb + 4 * TR_ROW + 32 * j));
        v4u o; o.x = (unsigned)(unsigned short)lo[0] | ((unsigned)(unsigned short)lo[1] << 16); o.y = (unsigned)(unsigned short)lo[2] | ((unsigned)(unsigned short)lo[3] << 16);
        o.z = (unsigned)(unsigned short)hi[0] | ((unsigned)(unsigned short)hi[1] << 16); o.w = (unsigned)(unsigned short)hi[2] | ((unsigned)(unsigned short)hi[3] << 16);
        *(GAS v4u*)(dst + (size_t)(16 * j + li) * ldk + k0 + 8 * kc) = o; }
    LDS_WAIT(); asm volatile("" ::: "memory");
}
__device__ __forceinline__ bool tr_plain(int& r, const float* W, int K, int N, bf16* Wt, LAS unsigned char* scr, int lane) {
    const int nblk = N / 128, items = (K / 32) * nblk;
    if (r >= items) { r -= items; return false; }
    const int kb = r / nblk, nb = r % nblk;
    transpose_item(W, N, 32 * kb, 128 * nb, Wt + (size_t)(128 * nb) * K, K, scr, lane); return true;
}
__device__ __forceinline__ bool tr_gu(int& r, const float* Wg, const float* Wu, int K, int F, bf16* Wt, LAS unsigned char* scr, int lane) {
    const int nblk = F / 128, items = (K / 32) * nblk;
    if (r >= 2 * items) { r -= 2 * items; return false; }
    const int up = r >= items ? 1 : 0; const int q = r - up * items; const int kb = q / nblk, nb = q % nblk;
    transpose_item<true>(up ? Wu : Wg, F, 32 * kb, 128 * nb, Wt + (size_t)(256 * nb + 128 * up) * K, K, scr, lane, up ? -0.6931471805599453f : -1.4426950408889634f); return true;
}
__device__ __forceinline__ void p_prologue(Frame& F) {
    LAS float* cond = (LAS float*)F.lds;
    const float* cin = inp(F, 1);
    for (int i = F.tid; i < NB * DM; i += 512) { const float c = cin[i]; cond[i] = c / (1.0f + expf(-c)); }
    __syncthreads();
    float* mod = (float*)(F.ws + WS_MOD);
    const float* ada_w = inp(F, 3); const float* ada_b = inp(F, 4);
    for (int it = F.gw; it < 768; it += F.NGW) {
        const int layer = it / 384, j0 = (it % 384) * 16, cj = F.lane & 15, kp = F.lane >> 4;
        float acc[NB];
#pragma unroll
        for (int b = 0; b < NB; ++b) acc[b] = 0.f;
        const float* wp = ada_w + (size_t)layer * DM * 6144 + j0 + cj;
#pragma unroll 16
        for (int k = kp; k < DM; k += 4) { const float w = wp[(size_t)k * 6144];
#pragma unroll
            for (int b = 0; b < NB; ++b) acc[b] += cond[b * DM + k] * w; }
#pragma unroll
        for (int b = 0; b < NB; ++b) { acc[b] += __shfl_xor(acc[b], 16); acc[b] += __shfl_xor(acc[b], 32); }
        if (kp == 0) {
            const float bias = ada_b[layer * 6144 + j0 + cj];
#pragma unroll
            for (int b = 0; b < NB; ++b) mod[(size_t)(layer * NB + b) * 6144 + j0 + cj] = acc[b] + bias; }
    }
    __syncthreads();
    LAS unsigned char* scr = F.lds + F.wave * 16384;
    constexpr int ITEMS_MOE_E = 3 * (DM / 32) * (FFE / 128);
    constexpr int ITEMS_FIX = (DM / 32) * (EVEN_IN / 128) + (DM / 32) * (DM / 128) + 2 * (DM / 32) * (FFD / 128) + (FFD / 32) * (DM / 128) + (DM / 32) * (ODD_IN / 128) + (DM / 32) * (DM / 128);
    constexpr int NITEMS = ITEMS_FIX + NEXP * ITEMS_MOE_E;
    unsigned char* ws = F.ws;
    for (int it = F.gw; it < NITEMS; it += F.NGW) {
        int r = it;
        if (tr_plain(r, inp(F, 8), DM, EVEN_IN, (bf16*)(ws + WS_WIN0), scr, F.lane)) continue;
        if (tr_plain(r, inp(F, 9), DM, DM, (bf16*)(ws + WS_WOUT0), scr, F.lane)) continue;
        if (tr_gu(r, inp(F, 17), inp(F, 18), DM, FFD, (bf16*)(ws + WS_WGU0), scr, F.lane)) continue;
        if (tr_plain(r, inp(F, 19), FFD, DM, (bf16*)(ws + WS_WD0), scr, F.lane)) continue;
        if (tr_plain(r, inp(F, 20), DM, ODD_IN, (bf16*)(ws + WS_WIN1), scr, F.lane)) continue;
        if (tr_plain(r, inp(F, 21), DM, DM, (bf16*)(ws + WS_WOUT1), scr, F.lane)) continue;
        const int e = r / ITEMS_MOE_E; r -= e * ITEMS_MOE_E;
        unsigned char* we = ws + WS_WMOE + (size_t)e * WMOE_STRIDE;
        if (tr_gu(r, inp(F, 29) + (size_t)e * DM * FFE, inp(F, 30) + (size_t)e * DM * FFE, DM, FFE, (bf16*)we, scr, F.lane)) continue;
        tr_plain(r, inp(F, 31) + (size_t)e * FFE * DM, FFE, DM, (bf16*)(we + WMOE_D_OFF), scr, F.lane);
    }
}

__device__ __forceinline__ f32x4 bf4_to_f32(unsigned long long w) { return (f32x4){__uint_as_float((unsigned)w << 16), __uint_as_float((unsigned)w & 0xffff0000u), __uint_as_float((unsigned)(w >> 32) << 16), __uint_as_float((unsigned)(w >> 32) & 0xffff0000u)}; }
template <bool X_BF16> __device__ __forceinline__ void p_norm_mod(Frame& F, const void* X, bf16* H, const float* ln, const float* modl, int sh_off, int sc_off) {
    for (int m = F.gw; m < MTOK; m += F.NGW) {
        const int b = m / SEQ;
        const GAS f32x4* xr = (const GAS f32x4*)((const float*)X + (size_t)m * DM) + F.lane;
        const GAS unsigned long long* xb8 = (const GAS unsigned long long*)((const bf16*)X + (size_t)m * DM) + F.lane;
        f32x4 v[4]; float ss = 0.f;
#pragma unroll
        for (int j = 0; j < 4; ++j) { if constexpr (X_BF16) v[j] = bf4_to_f32(xb8[64 * j]); else v[j] = xr[64 * j]; ss += (v[j].x * v[j].x + v[j].y * v[j].y) + (v[j].z * v[j].z + v[j].w * v[j].w); }
        const float rstd = 1.0f / sqrtf(wave_sum(ss) * (1.f / DM) + EPS);
        GAS unsigned long long* o8 = (GAS unsigned long long*)(H + (size_t)m * DM) + F.lane;
#pragma unroll
        for (int j = 0; j < 4; ++j) { const int col = 4 * F.lane + 256 * j;
            const f32x4 g = *(const GAS f32x4*)(ln + col), sc = *(const GAS f32x4*)(modl + (size_t)b * 6144 + sc_off + col), sh = *(const GAS f32x4*)(modl + (size_t)b * 6144 + sh_off + col);
            const f32x4 h = v[j] * rstd * g * (sc + 1.0f) + sh;
            o8[64 * j] = (unsigned long long)pk2(h.x, h.y) | ((unsigned long long)pk2(h.z, h.w) << 32); }
    }
}
__device__ __forceinline__ void p_router(Frame& F, const bf16* X, bf16* H, const float* ln, const float* modl, int sh_off, int sc_off) {
    LAS float* rws = (LAS float*)F.lds;
    LAS int* sel = (LAS int*)(F.lds + 32768);
    const float* rw = inp(F, 27); const float* rb = inp(F, 28);
    float* topw = (float*)(F.ws + WS_TOPW); int* list = (int*)(F.ws + WS_LIST);
    for (int i = F.tid; i < DM * NEXP; i += 512) rws[i] = rw[i];
    __syncthreads();
    for (int chunk = blockIdx.x; chunk < MTOK / 128; chunk += F.G) {
        for (int i = 0; i < 16; ++i) {
            const int lt = F.wave * 16 + i, m = chunk * 128 + lt, b = m / SEQ;
            const GAS unsigned long long* xb8 = (const GAS unsigned long long*)(X + (size_t)m * DM) + F.lane;
            f32x4 v[4]; float ss = 0.f;
#pragma unroll
            for (int j = 0; j < 4; ++j) { v[j] = bf4_to_f32(xb8[64 * j]); ss += (v[j].x * v[j].x + v[j].y * v[j].y) + (v[j].z * v[j].z + v[j].w * v[j].w); }
            const float rstd = 1.0f / sqrtf(wave_sum(ss) * (1.f / DM) + EPS);
            GAS unsigned long long* o8 = (GAS unsigned long long*)(H + (size_t)m * DM) + F.lane;
            float lg[NEXP];
#pragma unroll
            for (int e = 0; e < NEXP; ++e) lg[e] = 0.f;
#pragma unroll
            for (int j = 0; j < 4; ++j) { const int col = 4 * F.lane + 256 * j;
                const f32x4 g = *(const GAS f32x4*)(ln + col), sc = *(const GAS f32x4*)(modl + (size_t)b * 6144 + sc_off + col), sh = *(const GAS f32x4*)(modl + (size_t)b * 6144 + sh_off + col);
                const f32x4 h = v[j] * rstd * g * (sc + 1.0f) + sh;
                o8[64 * j] = (unsigned long long)pk2(h.x, h.y) | ((unsigned long long)pk2(h.z, h.w) << 32);
#pragma unroll
                for (int q = 0; q < 4; ++q) { const f32x4 w0 = *(const LAS f32x4*)(rws + (col + q) * 8), w1 = *(const LAS f32x4*)(rws + (col + q) * 8 + 4); const float hv = h[q];
                    lg[0] += hv * w0.x; lg[1] += hv * w0.y; lg[2] += hv * w0.z; lg[3] += hv * w0.w; lg[4] += hv * w1.x; lg[5] += hv * w1.y; lg[6] += hv * w1.z; lg[7] += hv * w1.w; } }
#pragma unroll
            for (int e = 0; e < NEXP; ++e) lg[e] = wave_sum(lg[e]) + rb[e];
            int i0 = 0; float v0 = lg[0];
#pragma unroll
            for (int e = 1; e < NEXP; ++e) if (lg[e] > v0) { v0 = lg[e]; i0 = e; }
            int i1 = (i0 == 0) ? 1 : 0; float v1 = (i0 == 0) ? lg[1] : lg[0];
#pragma unroll
            for (int e = 1; e < NEXP; ++e) if (e != i0 && lg[e] > v1) { v1 = lg[e]; i1 = e; }
            const float w0 = 1.0f / (1.0f + expf(v1 - v0)), w1 = 1.0f - w0;
            if (F.lane == 0) { sel[2 * lt] = i0; sel[2 * lt + 1] = i1; topw[(size_t)m * 2] = w0; topw[(size_t)m * 2 + 1] = w1; }
        }
        __syncthreads();
        {
            const int e = F.wave; bool mt[4]; int rk[4]; int total = 0;
#pragma unroll
            for (int r = 0; r < 4; ++r) { mt[r] = (sel[r * 64 + F.lane] == e); const unsigned long long mask = __ballot(mt[r]);
                rk[r] = total + __popcll(mask & ((1ull << F.lane) - 1ull)); total += __popcll(mask); }
            int base = 0;
            if (F.lane == 0 && total > 0) base = (int)__hip_atomic_fetch_add((unsigned*)(F.ctl + CW_CNT + 64 * e), (unsigned)total, RLX_AGENT);
            base = __builtin_amdgcn_readfirstlane(base);
#pragma unroll
            for (int r = 0; r < 4; ++r) if (mt[r]) list[(size_t)e * LIST_CAP + base + rk[r]] = (chunk * 128) * 2 + r * 64 + F.lane;
        }
        __syncthreads();
    }
}
__device__ __forceinline__ void p_final(Frame& F, const bf16* XB, const float* gate, const float* ln) {
    const float* topw = (const float*)(F.ws + WS_TOPW);
    for (int m = F.gw; m < MTOK; m += F.NGW) {
        const int b = m / SEQ;
        const GAS unsigned long long* x8 = (const GAS unsigned long long*)(XB + (size_t)m * DM) + F.lane;
        const GAS unsigned long long* y0 = (const GAS unsigned long long*)((const bf16*)F.out + (size_t)(2 * m) * DM) + F.lane;
        const GAS unsigned long long* y1 = (const GAS unsigned long long*)((const bf16*)F.out + (size_t)(2 * m + 1) * DM) + F.lane;
        const float w0 = topw[(size_t)m * 2], w1 = topw[(size_t)m * 2 + 1];
        f32x4 v[4]; float ss = 0.f;
#pragma unroll
        for (int j = 0; j < 4; ++j) { const unsigned long long xa = x8[64 * j], ya = y0[64 * j], yb = y1[64 * j];
            const f32x4 g = *(const GAS f32x4*)(gate + (size_t)b * 6144 + 4 * F.lane + 256 * j);
            f32x4 xv, y0v, y1v;
            xv.x = bf2f((bf16)(xa & 0xffff)); xv.y = bf2f((bf16)((xa >> 16) & 0xffff)); xv.z = bf2f((bf16)((xa >> 32) & 0xffff)); xv.w = bf2f((bf16)(xa >> 48));
            y0v.x = bf2f((bf16)(ya & 0xffff)); y0v.y = bf2f((bf16)((ya >> 16) & 0xffff)); y0v.z = bf2f((bf16)((ya >> 32) & 0xffff)); y0v.w = bf2f((bf16)(ya >> 48));
            y1v.x = bf2f((bf16)(yb & 0xffff)); y1v.y = bf2f((bf16)((yb >> 16) & 0xffff)); y1v.z = bf2f((bf16)((yb >> 32) & 0xffff)); y1v.w = bf2f((bf16)(yb >> 48));
            v[j] = xv + g * (y0v * w0 + y1v * w1);
            ss += (v[j].x * v[j].x + v[j].y * v[j].y) + (v[j].z * v[j].z + v[j].w * v[j].w); }
        float rstd = 1.0f / sqrtf(wave_sum(ss) * (1.f / DM) + EPS);
#if MK_DIAG_SEL >= 0
        rstd *= 1.0f + ((const float*)(F.ws + WS_CTL + 65536))[MK_DIAG_SEL] * MK_DIAG_SCALE;
#endif
        asm volatile("" ::: "memory");
        GAS f32x4* orow = (GAS f32x4*)(F.out + (size_t)m * DM) + F.lane;
#pragma unroll
        for (int j = 0; j < 4; ++j) { const f32x4 g = *(const GAS f32x4*)(ln + 4 * F.lane + 256 * j); orow[64 * j] = v[j] * rstd * g; }
    }
}

__device__ __forceinline__ void p_sb_naive(Frame& F, const bf16* proj, bf16* mix) {
    for (int w = blockIdx.x * 7 + (F.wave - 1); w < NB * 8 * SEQ; w += F.G * 7) {
        const int t = w % SEQ, bh = w / SEQ, h = bh % 8, b = bh / 8;
        const size_t row = (size_t)b * SEQ + t;
        const float q = bf2f(proj[row * EVEN_IN + h * 64 + F.lane]);
        float acc = 0.f, later = 0.f;
        for (int s = t - 1; s >= 0; --s) {
            const size_t kr = ((size_t)b * SEQ + s) * EVEN_IN;
            const float kk = bf2f(proj[kr + 512 + h * 64 + F.lane]), vv = bf2f(proj[kr + 1024 + h * 64 + F.lane]);
            const float z = wave_sum(q * kk) * 0.125f;
            const float lp = logsig_f(z), ln_ = lp - z;
            acc += expf(lp + later) * vv; later += ln_;
            if (later < -110.f) break;
        }
        mix[row * DM + h * 64 + F.lane] = (bf16)f2bf(acc);
    }
}
__device__ __forceinline__ void p_lru_naive_wave(Frame& F, int unit, const bf16* proj, bf16* mix) {
    LAS float* wa = (LAS float*)F.lds; LAS float* wx = wa + 4096; LAS float* xcs = wx + 4096;
    const float* conv_w = inp(F, 10); const float* conv_b = inp(F, 11); const float* ga_w = inp(F, 12); const float* ga_b = inp(F, 13); const float* gx_w = inp(F, 14); const float* gx_b = inp(F, 15); const float* lam = inp(F, 16);
    const int b = unit / 8, g = unit % 8, j = F.lane, c = g * 64 + j;
    for (int i = j; i < 4096; i += 64) { wa[i] = ga_w[g * 4096 + i]; wx[i] = gx_w[g * 4096 + i]; }
    const float cw0 = conv_w[c], cw1 = conv_w[512 + c], cw2 = conv_w[1024 + c], cw3 = conv_w[1536 + c], cb = conv_b[c], ba = ga_b[c], bx = gx_b[c], lsl = logsig_f(lam[c]);
    float x1 = 0.f, x2 = 0.f, x3 = 0.f, hs = 0.f;
    LDS_WAIT();
    for (int t = 0; t < SEQ; ++t) {
        const size_t row = (size_t)b * SEQ + t;
        const float xb = bf2f(proj[row * EVEN_IN + 1536 + c]), gb = bf2f(proj[row * EVEN_IN + 2048 + c]);
        const float xc = cw0 * x3 + cw1 * x2 + cw2 * x1 + cw3 * xb + cb; x3 = x2; x2 = x1; x1 = xb;
        xcs[j] = xc; LDS_WAIT(); asm volatile("" ::: "memory");
        float ra = ba, rx = bx;
#pragma unroll 8
        for (int i = 0; i < 64; ++i) { const float xi = xcs[i]; ra += xi * wa[i * 64 + j]; rx += xi * wx[i * 64 + j]; }
        LDS_WAIT(); asm volatile("" ::: "memory");
        const float r = sigmoid_f(ra), ig = sigmoid_f(rx), log_a = 8.0f * r * lsl, aa = expf(log_a), u = sqrtf(-expm1f(2.0f * log_a)) * (ig * xc);
        hs = aa * hs + u;
        mix[row * DM + 512 + c] = (bf16)f2bf(hs * gelu_tanh_f(gb));
    }
}
__device__ __forceinline__ void p_diff_naive(Frame& F, const bf16* proj, bf16* o, float lambda_init) {
    LAS float* lut = (LAS float*)F.lds; LAS float* lam_s = lut + 132;
    const float* rel_bias = inp(F, 2); const float* lq1 = inp(F, 22); const float* lk1 = inp(F, 23); const float* lq2 = inp(F, 24); const float* lk2 = inp(F, 25); const float* subln = inp(F, 26);
    int k = 0;
    for (int u = blockIdx.x; u < NB * 8 * 32; u += F.G, ++k) {
        const int bh = u / 32, h = bh % 8, b = bh / 8; int tile = u % 32; if (k & 1) tile = 31 - tile;
        const int qi = F.tid >> 2, part = F.tid & 3, t = tile * 128 + qi;
        __syncthreads();
        if (F.tid < 129) { const int n = F.tid; int bk;
            if (n < 16) bk = n; else bk = 16 + (n >= 19) + (n >= 21) + (n >= 24) + (n >= 27) + (n >= 31) + (n >= 35) + (n >= 40) + (n >= 46) + (n >= 52) + (n >= 59) + (n >= 67) + (n >= 77) + (n >= 87) + (n >= 99) + (n >= 113);
            lut[n] = rel_bias[bk * 8 + h]; }
        if (F.tid == 0) { float s1 = 0.f, s2 = 0.f; for (int i = 0; i < 64; ++i) { s1 += lq1[i] * lk1[i]; s2 += lq2[i] * lk2[i]; } lam_s[0] = expf(s1) - expf(s2) + lambda_init; }
        __syncthreads();
        const float lam = lam_s[0];
        const size_t row = (size_t)b * SEQ + t;
        float q1[16], q2[16], a1[32], a2[32];
#pragma unroll
        for (int i = 0; i < 16; ++i) { q1[i] = bf2f(proj[row * ODD_IN + (2 * h) * 64 + part * 16 + i]); q2[i] = bf2f(proj[row * ODD_IN + (2 * h + 1) * 64 + part * 16 + i]); }
#pragma unroll
        for (int i = 0; i < 32; ++i) { a1[i] = 0.f; a2[i] = 0.f; }
        float m1 = -INFINITY, m2 = -INFINITY, l1 = 0.f, l2 = 0.f;
        const int tmax = tile * 128 + 127;
        for (int s = 0; s <= tmax; ++s) {
            const bf16* kr = proj + ((size_t)b * SEQ + s) * ODD_IN;
            const bf16x8 ka = *(const bf16x8*)(kr + 1024 + (2 * h) * 64 + part * 16), kb = *(const bf16x8*)(kr + 1024 + (2 * h) * 64 + part * 16 + 8);
            const bf16x8 kc = *(const bf16x8*)(kr + 1024 + (2 * h + 1) * 64 + part * 16), kd = *(const bf16x8*)(kr + 1024 + (2 * h + 1) * 64 + part * 16 + 8);
            float d1 = 0.f, d2 = 0.f;
#pragma unroll
            for (int i = 0; i < 8; ++i) { d1 += q1[i] * bf2f((bf16)ka[i]) + q1[8 + i] * bf2f((bf16)kb[i]); d2 += q2[i] * bf2f((bf16)kc[i]) + q2[8 + i] * bf2f((bf16)kd[i]); }
            d1 += __shfl_xor(d1, 1); d1 += __shfl_xor(d1, 2); d2 += __shfl_xor(d2, 1); d2 += __shfl_xor(d2, 2);
            if (s <= t) {
                const int rel = t - s; const float bias = lut[rel > 128 ? 128 : rel];
                const float z1 = d1 * 0.125f + bias, z2 = d2 * 0.125f + bias;
                const float n1 = fmaxf(m1, z1), n2 = fmaxf(m2, z2);
                const float s1 = expf(m1 - n1), s2 = expf(m2 - n2), p1 = expf(z1 - n1), p2 = expf(z2 - n2);
                l1 = l1 * s1 + p1; l2 = l2 * s2 + p2; m1 = n1; m2 = n2;
                const bf16* vr = kr + 2048 + h * 128 + part * 32;
#pragma unroll
                for (int c8 = 0; c8 < 4; ++c8) { const bf16x8 vv = *(const bf16x8*)(vr + 8 * c8);
#pragma unroll
                    for (int i = 0; i < 8; ++i) { const float vf = bf2f((bf16)vv[i]); a1[8 * c8 + i] = a1[8 * c8 + i] * s1 + p1 * vf; a2[8 * c8 + i] = a2[8 * c8 + i] * s2 + p2 * vf; } }
            }
        }
        const float r1 = 1.0f / l1, r2 = lam / l2; float ss = 0.f;
#pragma unroll
        for (int i = 0; i < 32; ++i) { a1[i] = a1[i] * r1 - a2[i] * r2; ss += a1[i] * a1[i]; }
        ss += __shfl_xor(ss, 1); ss += __shfl_xor(ss, 2);
        const float rstd = 1.0f / sqrtf(ss * (1.0f / 128.0f) + EPS) * (1.0f - lambda_init);
        bf16* op = o + row * DM + h * 128 + part * 32;
#pragma unroll
        for (int i = 0; i < 32; i += 2) *(unsigned*)(op + i) = pk2(a1[i] * rstd * subln[part * 32 + i], a1[i + 1] * rstd * subln[part * 32 + i + 1]);
    }
}

typedef float f32x16 __attribute__((ext_vector_type(16)));
typedef short v4i16_t __attribute__((ext_vector_type(4)));
constexpr float LOG2E = 1.4426950408889634f;
constexpr float QK_PRESCALE = 0.125f * LOG2E;
constexpr int ATTN_QSCALE_COLS = 1024; constexpr float ATTN_QSCALE = QK_PRESCALE;
__device__ __forceinline__ float max3f(float a, float b, float c) { float r; asm("v_max3_f32 %0, %1, %2, %3" : "=v"(r) : "v"(a), "v"(b), "v"(c)); return r; }
__device__ __forceinline__ float mov_s(float a) { float r; asm("v_mov_b32_e32 %0, %1" : "=v"(r) : "v"(a)); return r; }
__device__ __forceinline__ float fadd_s(float a, float b) { float r; asm("v_add_f32_e32 %0, %1, %2" : "=v"(r) : "v"(a), "v"(b)); return r; }
__device__ __forceinline__ int crow(int r, int hi) { return (r & 3) + 8 * (r >> 2) + 4 * hi; }
__device__ __forceinline__ float half_max(float v) { auto rr = __builtin_amdgcn_permlane32_swap(__float_as_uint(v), __float_as_uint(v), false, false); return fmaxf(__uint_as_float(rr[0]), __uint_as_float(rr[1])); }
__device__ __forceinline__ float half_sum(float v) { auto rr = __builtin_amdgcn_permlane32_swap(__float_as_uint(v), __float_as_uint(v), false, false); return __uint_as_float(rr[0]) + __uint_as_float(rr[1]); }
__device__ __forceinline__ unsigned cvtpk(float lo, float hi) { typedef float f2 __attribute__((ext_vector_type(2))); typedef __bf16 b2 __attribute__((ext_vector_type(2))); f2 v = {lo, hi}; b2 b = __builtin_convertvector(v, b2); return __builtin_bit_cast(unsigned, b); }
__device__ __forceinline__ bf16x8 vfrag(LAS const unsigned char* p0, LAS const unsigned char* p1) {
    const v4i16_t lo = __builtin_amdgcn_ds_read_tr16_b64_v4i16((LAS v4i16_t*)p0), hi = __builtin_amdgcn_ds_read_tr16_b64_v4i16((LAS v4i16_t*)p1);
    return (bf16x8){lo[0], lo[1], lo[2], lo[3], hi[0], hi[1], hi[2], hi[3]};
}
constexpr int DA_KRING = 0, DA_KSLOT = 16384, DA_VRING = 49152, DA_VSLOT = 16384, DA_LUT = 131072 + 1024, DA_SLN = 131072 + 2560, DA_QF = 98304, DA_OST = 65536, DA_OROW = 264;
constexpr float DA_THR = 8.0f;

#ifndef MK_DIAG_SEL
#define MK_DIAG_SEL -1
#endif
#if MK_DIAG_SEL >= 0
#define DIAG_T(v) do { v = __builtin_amdgcn_s_memtime(); } while (0)
#define DIAG_ACC(k, t1, t0) do { dg[k] += (t1) - (t0); } while (0)
#else
#define DIAG_T(v) do { } while (0)
#define DIAG_ACC(k, t1, t0) do { } while (0)
#endif
__device__ __forceinline__ float da_maxall(const f32x16& a, const f32x16& b) {
    float mxa = max3f(a[0], a[1], b[0]), mxb = max3f(a[2], a[3], b[1]); mxa = max3f(mxa, b[2], b[3]);
#pragma unroll
    for (int r = 4; r < 16; r += 4) { mxa = max3f(mxa, a[r], a[r + 1]); mxb = max3f(mxb, a[r + 2], a[r + 3]); mxa = max3f(mxa, b[r], b[r + 1]); mxb = max3f(mxb, b[r + 2], b[r + 3]); }
    return max3f(mxa, mxb, mxb);
}
#define DA_MAXALL(a, b) da_maxall(a, b)
__device__ __forceinline__ void p_diff_attn(Frame& F, const bf16* proj, bf16* o, float lambda_init) {
    unsigned long long dg[6] = {0, 0, 0, 0, 0, 0}; unsigned long long ta = 0, tb = 0, tc = 0, td = 0; (void)ta; (void)tb; (void)tc; (void)td; (void)dg;
    const float* rel_bias = inp(F, 2); const float* lq1 = inp(F, 22); const float* lk1 = inp(F, 23); const float* lq2 = inp(F, 24); const float* lk2 = inp(F, 25); const float* subln = inp(F, 26);
    const int lane0 = F.lane, wave = F.wave, w4 = wave & 3, map = wave >> 2;
    LAS unsigned char* L = F.lds;
    LAS float* lut = (LAS float*)(L + DA_LUT) + 128;
    float lam;
    { float s1 = lq1[lane0] * lk1[lane0], s2 = lq2[lane0] * lk2[lane0]; s1 = wave_sum(s1); s2 = wave_sum(s2); lam = expf(s1) - expf(s2) + lambda_init; }
    const int G = F.G; const int bx = blockIdx.x; const int vcu0 = (G % 8 == 0) ? (bx % 8) * (G / 8) + bx / 8 : bx;
#define DA_WAITBAR(n) do { asm volatile("s_waitcnt vmcnt(" #n ") lgkmcnt(0)" ::: "memory"); __builtin_amdgcn_s_barrier(); asm volatile("" ::: "memory"); } while (0)
#define DA_WAITBAR_N(cnt) do { if ((cnt) >= 6) DA_WAITBAR(6); else if ((cnt) == 4) DA_WAITBAR(4); else if ((cnt) == 2) DA_WAITBAR(2); else DA_WAITBAR(0); } while (0)
    LAS float* sln = (LAS float*)(L + DA_SLN);
    __syncthreads();
    if (F.tid < 128) sln[F.tid] = subln[F.tid];
    for (int vcu = vcu0; vcu < 256; vcu += G) {
        const int xg = vcu >> 5, jl = vcu & 31;
        for (int k = 0; k < 8; ++k) {
            const int bh = xg * 8 + k, h = bh & 7, b = bh >> 3, qb = (k & 1) ? 31 - jl : jl;
            int lane_u = lane0; asm volatile("" : "+v"(lane_u));
            const int lane = lane_u, r32 = lane & 31, hi = lane >> 5;
            const int q4 = (lane & 15) >> 2, p4 = lane & 3, blk = (lane >> 4) & 1;
            const int vb0 = 64 * (4 * hi + q4) + 16 * ((2 * blk + (p4 >> 1)) ^ hi) + 8 * (p4 & 1);
            const int vb1 = 2048 + 64 * (4 * hi + q4) + 16 * ((2 * blk + (p4 >> 1)) ^ (2 + hi)) + 8 * (p4 & 1);
            const int vkey = 8 * wave + ((lane >> 2) & 7);
            const int vch0 = 4 * (lane >> 5) + ((lane & 3) ^ (2 * (wave & 1) + ((lane >> 4) & 1)));
            const int q0w = qb * 128 + 32 * w4, head = 2 * h + map;
            const int nkt = 2 * qb + 2, my_last = 2 * qb + (w4 >= 2 ? 1 : 0);
            __syncthreads();
            if (F.tid < 384) { int n = F.tid - 128; asm volatile("" : "+v"(n)); int bk;
                if (n < 16) bk = max(n, 0); else bk = 16 + (n >= 19) + (n >= 21) + (n >= 24) + (n >= 27) + (n >= 31) + (n >= 35) + (n >= 40) + (n >= 46) + (n >= 52) + (n >= 59) + (n >= 67) + (n >= 77) + (n >= 87) + (n >= 99) + (n >= 113);
                const float bv = rel_bias[bk * 8 + h] * LOG2E; lut[n] = n < 0 ? -INFINITY : bv; }
            const bf16* kvbase = proj + (size_t)b * SEQ * ODD_IN;
            bf16x8 qf[4];
            { const bf16* qp = kvbase + (size_t)(q0w + r32) * ODD_IN + head * 64 + 8 * hi;
#pragma unroll
              for (int d0 = 0; d0 < 4; ++d0) qf[d0] = *(const bf16x8*)(qp + 16 * d0); }
            const int krow = 8 * wave + (lane >> 3), kch = (lane & 7) ^ ((krow >> 1) & 7);
            const unsigned ko0 = (unsigned)(krow * ODD_IN + 1024 + (2 * h) * 64 + 8 * kch) * 2u, ko1 = ko0 + 128u;
            const unsigned vo0 = (unsigned)(vkey * ODD_IN + 2048 + h * 128 + 8 * vch0) * 2u, vo1 = vo0 + 128u;
#define DA_ISSUE_K(kt) do { const char* gb_ = (const char*)kvbase + (size_t)(kt) * 64 * ODD_IN * 2; LAS unsigned char* sb_ = L + DA_KRING + ((kt) % 3) * DA_KSLOT; \
            __builtin_amdgcn_global_load_lds((const unsigned*)(gb_ + ko0), (LAS unsigned*)(sb_ + wave * 1024), 16, 0, 0); \
            __builtin_amdgcn_global_load_lds((const unsigned*)(gb_ + ko1), (LAS unsigned*)(sb_ + 8192 + wave * 1024), 16, 0, 0); } while (0)
#define DA_ISSUE_V(kt) do { const char* gb_ = (const char*)kvbase + (size_t)(kt) * 64 * ODD_IN * 2; LAS unsigned char* sb_ = L + DA_VRING + ((kt) % 3) * DA_VSLOT; \
            __builtin_amdgcn_global_load_lds((const unsigned*)(gb_ + vo0), (LAS unsigned*)(sb_ + wave * 2048), 16, 0, 0); \
            __builtin_amdgcn_global_load_lds((const unsigned*)(gb_ + vo1), (LAS unsigned*)(sb_ + wave * 2048 + 1024), 16, 0, 0); } while (0)
            DA_ISSUE_K(0); DA_ISSUE_V(0); DA_ISSUE_K(1); DA_ISSUE_V(1); if (2 < nkt) DA_ISSUE_K(2);
            f32x16 oacc[4];
#pragma unroll
            for (int c = 0; c < 4; ++c)
#pragma unroll
                for (int r = 0; r < 16; ++r) oacc[c][r] = 0.f;
            float mref = 0.f, lrun = 0.f; bool first = true;
            f32x16 s0, s1;
#define DA_SB() __builtin_amdgcn_sched_barrier(0)
#define DA_LDKQ(t) do { LAS const unsigned char* kb_ = L + DA_KRING + ((t) % 3) * DA_KSLOT + map * 8192 + r32 * 128; const int sw_ = (r32 >> 1) & 7; \
                _Pragma("unroll") for (int d0 = 0; d0 < 4; ++d0) { const int co_ = ((2 * d0 + hi) ^ sw_) << 4; kf[2 * d0] = *(LAS const bf16x8*)(kb_ + co_); kf[2 * d0 + 1] = *(LAS const bf16x8*)(kb_ + co_ + 4096); } } while (0)
#define DA_QKM(t, S0, S1) do { const bool farq_ = (q0w - (64 * (t) + 63) >= 128); const float ci_ = (farq_ ? lut[128] : 0.f) - mref; \
                _Pragma("unroll") for (int r = 0; r < 16; ++r) { S0[r] = ci_; S1[r] = ci_; } \
                _Pragma("unroll") for (int d0 = 0; d0 < 4; ++d0) { \
                    S0 = __builtin_amdgcn_mfma_f32_32x32x16_bf16(kf[2 * d0], qf[d0], S0, 0, 0, 0); \
                    S1 = __builtin_amdgcn_mfma_f32_32x32x16_bf16(kf[2 * d0 + 1], qf[d0], S1, 0, 0, 0); } } while (0)
#define DA_LDV(c, dst) do { _Pragma("unroll") for (int s = 0; s < 4; ++s) { \
                asm volatile("ds_read_b64_tr_b16 %0, %1 offset:%c2" : "=&v"(dst##l[s]) : "v"(vp0u), "i"(4096 * s + 512 * (c)) : "memory"); \
                asm volatile("ds_read_b64_tr_b16 %0, %1 offset:%c2" : "=&v"(dst##h[s]) : "v"(vp1u), "i"(4096 * s + 512 * (c)) : "memory"); } } while (0)
#define DA_VF(dst, s) (bf16x8){dst##l[s][0], dst##l[s][1], dst##l[s][2], dst##l[s][3], dst##h[s][0], dst##h[s][1], dst##h[s][2], dst##h[s][3]}
#define DA_LWAIT(n) do { asm volatile("s_waitcnt lgkmcnt(" #n ")" ::: "memory"); DA_SB(); } while (0)
            bf16x8 kf[8];
            DA_WAITBAR(0);
            DA_LDKQ(0); DA_SB(); DA_QKM(0, s0, s1); DA_SB();
            asm volatile("s_nop 15\n\ts_nop 7" : "+v"(s0), "+v"(s1));
            float mx_pre = DA_MAXALL(s0, s1);
#pragma unroll 1
            for (int t = 0; t < nkt; ++t) {
                if (t > 0) { const int fly = 2 * ((t + 2 < nkt ? 1 : 0) + (t + 1 < nkt ? 1 : 0)); DA_WAITBAR_N(fly); }
                if (t + 3 < nkt) DA_ISSUE_K(t + 3);
                if (t + 2 < nkt) DA_ISSUE_V(t + 2);
                DA_LDKQ(t + 1);
                DA_SB();
                const int k0_ = 64 * t;
                float mx;
                if (!(q0w - (k0_ + 63) >= 128)) { int lq_ = lane; asm volatile("" : "+v"(lq_));
                    const int relb = q0w + (lq_ & 31) - k0_ - 4 * (lq_ >> 5);
                    LAS const float* bp = lut + (relb - 59); { unsigned bpu = (unsigned)(size_t)bp; asm volatile("" : "+v"(bpu)); bp = (LAS const float*)bpu; }
#pragma unroll
                    for (int r = 0; r < 16; ++r) { const int c = (r & 3) + 8 * (r >> 2); s0[r] += bp[59 - c]; s1[r] += bp[27 - c]; }
                    mx = DA_MAXALL(s0, s1); }
                else mx = mx_pre;
                mx = half_max(mx);
                if (first || __any(mx > DA_THR)) {
                    const float dl = first ? mx : fmaxf(mx, 0.f); const float al = __builtin_amdgcn_exp2f(-dl);
                    mref += dl; lrun *= al;
#pragma unroll
                    for (int c = 0; c < 4; ++c)
#pragma unroll
                        for (int r = 0; r < 16; ++r) oacc[c][r] *= al;
#pragma unroll
                    for (int r = 0; r < 16; ++r) { s0[r] -= dl; s1[r] -= dl; }
                    first = false; }
                DA_SB();
                f32x16 n0, n1;
                DA_QKM(t + 1, n0, n1);
#pragma unroll
                for (int r = 0; r < 16; ++r) { s0[r] = __builtin_amdgcn_exp2f(s0[r]); s1[r] = __builtin_amdgcn_exp2f(s1[r]); }
#pragma unroll
                for (int i = 0; i < 8; ++i) { __builtin_amdgcn_sched_group_barrier(0x008, 1, 0); __builtin_amdgcn_sched_group_barrier(0x400, 4, 0); }
                DA_SB();
                asm volatile("s_nop 1" : "+v"(s0), "+v"(s1));
                unsigned vp0u = (unsigned)(size_t)(L + DA_VRING + (t % 3) * DA_VSLOT) + (unsigned)vb0, vp1u = vp0u - (unsigned)vb0 + (unsigned)vb1;
                asm volatile("" : "+v"(vp0u), "+v"(vp1u));
                v4i16_t val[4], vah[4], vnl[4], vnh[4], vml[4], vmh[4];
                DA_LDV(0, va); DA_LDV(1, vn);
                DA_SB();
                bf16x8 pw[4];
                { v4u w;
                  w.x = cvtpk(s0[0], s0[1]); w.y = cvtpk(s0[2], s0[3]); w.z = cvtpk(s0[4], s0[5]); w.w = cvtpk(s0[6], s0[7]); pw[0] = __builtin_bit_cast(bf16x8, w);
                  w.x = cvtpk(s0[8], s0[9]); w.y = cvtpk(s0[10], s0[11]); w.z = cvtpk(s0[12], s0[13]); w.w = cvtpk(s0[14], s0[15]); pw[1] = __builtin_bit_cast(bf16x8, w); }
                DA_SB();
                float lsa = 0.f, lsb = 0.f, mxa, mxb;
#define DA_PVA(acc, vf, s, r, EXTRA) do { acc = __builtin_amdgcn_mfma_f32_32x32x16_bf16(DA_VF(vf, s), pw[s], acc, 0, 0, 0); lsa = fadd_s(lsa, s0[r]); lsb = fadd_s(lsb, s1[r]); EXTRA; if ((r) > 0) { s0[(r) - 1] = mov_s(n0[(r) - 1]); s1[(r) - 1] = mov_s(n1[(r) - 1]); } DA_SB(); } while (0)
                DA_LDV(2, vm); DA_LWAIT(15);
                DA_PVA(oacc[0], va, 0, 0, { v4u w; w.x = cvtpk(s1[0], s1[1]); w.y = cvtpk(s1[2], s1[3]); w.z = cvtpk(s1[4], s1[5]); w.w = cvtpk(s1[6], s1[7]); pw[2] = __builtin_bit_cast(bf16x8, w); });
                DA_PVA(oacc[0], va, 1, 1, { v4u w; w.x = cvtpk(s1[8], s1[9]); w.y = cvtpk(s1[10], s1[11]); w.z = cvtpk(s1[12], s1[13]); w.w = cvtpk(s1[14], s1[15]); pw[3] = __builtin_bit_cast(bf16x8, w); });
                DA_PVA(oacc[0], va, 2, 2, );
                DA_PVA(oacc[0], va, 3, 3, { mxa = max3f(n0[0], n0[1], n1[0]); mxb = max3f(n0[2], n0[3], n1[1]); });
                DA_LDV(3, va); DA_LWAIT(15);
                DA_PVA(oacc[1], vn, 0, 4, { mxa = max3f(mxa, n1[2], n1[3]); mxb = max3f(mxb, n0[6], n0[7]); });
                DA_PVA(oacc[1], vn, 1, 5, { mxa = max3f(mxa, n0[4], n0[5]); mxb = max3f(mxb, n1[6], n1[7]); });
                DA_PVA(oacc[1], vn, 2, 6, { mxa = max3f(mxa, n1[4], n1[5]); });
                DA_PVA(oacc[1], vn, 3, 7, { mxb = max3f(mxb, n0[10], n0[11]); });
                DA_LWAIT(8);
                DA_PVA(oacc[2], vm, 0, 8, { mxa = max3f(mxa, n0[8], n0[9]); });
                DA_PVA(oacc[2], vm, 1, 9, { mxb = max3f(mxb, n1[10], n1[11]); });
                DA_PVA(oacc[2], vm, 2, 10, { mxa = max3f(mxa, n1[8], n1[9]); });
                DA_PVA(oacc[2], vm, 3, 11, { mxb = max3f(mxb, n0[14], n0[15]); });
                DA_LWAIT(0);
                DA_PVA(oacc[3], va, 0, 12, { mxa = max3f(mxa, n0[12], n0[13]); });
                DA_PVA(oacc[3], va, 1, 13, { mxb = max3f(mxb, n1[14], n1[15]); });
                DA_PVA(oacc[3], va, 2, 14, { mxa = max3f(mxa, n1[12], n1[13]); });
                DA_PVA(oacc[3], va, 3, 15, { mx_pre = max3f(mxa, mxb, mxb); });
#undef DA_PVA
                lrun = fadd_s(lrun, fadd_s(lsa, lsb));
                s0[15] = mov_s(n0[15]); s1[15] = mov_s(n1[15]);
            }
#undef DA_SB
#undef DA_LDKQ
#undef DA_QKM
#undef DA_LDV
#undef DA_VF
#undef DA_LWAIT
#undef DA_ISSUE_K
#undef DA_ISSUE_V
            {
            int lane_e = lane; asm volatile("" : "+v"(lane_e));
            const int r32 = lane_e & 31, hi = lane_e >> 5, lane = lane_e;
            const float ltot = half_sum(lrun);
            const float rl = (map == 0 ? 1.0f : lam) / ltot;
#pragma unroll
            for (int c = 0; c < 4; ++c)
#pragma unroll
                for (int r = 0; r < 16; ++r) oacc[c][r] *= rl;
            __syncthreads();
            LAS f32x4* cb = (LAS f32x4*)(L + w4 * 16384) + lane;
            if (map == 1) {
#pragma unroll
                for (int c = 0; c < 4; ++c)
#pragma unroll
                    for (int g = 0; g < 4; ++g) cb[(c * 4 + g) * 64] = (f32x4){oacc[c][4 * g], oacc[c][4 * g + 1], oacc[c][4 * g + 2], oacc[c][4 * g + 3]};
            }
            __syncthreads();
            if (map == 0) {
                float ss = 0.f;
#pragma unroll
                for (int c = 0; c < 4; ++c)
#pragma unroll
                    for (int g = 0; g < 4; ++g) { const f32x4 tq = cb[(c * 4 + g) * 64];
                        oacc[c][4 * g] -= tq.x; oacc[c][4 * g + 1] -= tq.y; oacc[c][4 * g + 2] -= tq.z; oacc[c][4 * g + 3] -= tq.w;
                        ss += (oacc[c][4 * g] * oacc[c][4 * g] + oacc[c][4 * g + 1] * oacc[c][4 * g + 1]) + (oacc[c][4 * g + 2] * oacc[c][4 * g + 2] + oacc[c][4 * g + 3] * oacc[c][4 * g + 3]); }
                ss = half_sum(ss);
                const float rstd = (1.0f - lambda_init) / sqrtf(ss * (1.0f / 128.0f) + EPS);
                LAS unsigned char* st = L + DA_OST + w4 * (32 * DA_OROW);
#pragma unroll
                for (int c = 0; c < 4; ++c)
#pragma unroll
                    for (int g = 0; g < 4; ++g) { const int d = 32 * c + 8 * g + 4 * hi; const f32x4 sg = *(const LAS f32x4*)(sln + d);
                        const unsigned lo = cvtpk(oacc[c][4 * g] * rstd * sg.x, oacc[c][4 * g + 1] * rstd * sg.y), hi2 = cvtpk(oacc[c][4 * g + 2] * rstd * sg.z, oacc[c][4 * g + 3] * rstd * sg.w);
                        *(LAS unsigned long long*)(st + r32 * DA_OROW + d * 2) = (unsigned long long)lo | ((unsigned long long)hi2 << 32); }
                LDS_WAIT(); asm volatile("" ::: "memory");
                bf16* orow = o + ((size_t)b * SEQ + q0w) * DM + h * 128;
#pragma unroll
                for (int i = 0; i < 8; ++i) { const int idx = i * 64 + lane, row = idx >> 4, ch = idx & 15;
                    const unsigned long long a = *(LAS const unsigned long long*)(st + row * DA_OROW + ch * 16), bq = *(LAS const unsigned long long*)(st + row * DA_OROW + ch * 16 + 8);
                    v4u w; w.x = (unsigned)a; w.y = (unsigned)(a >> 32); w.z = (unsigned)bq; w.w = (unsigned)(bq >> 32);
                    *(GAS v4u*)(orow + (size_t)row * DM + ch * 8) = w; }
            }
            }
        }
    }
#undef DA_WAITBAR
#undef DA_WAITBAR_N
#if MK_DIAG_SEL >= 0
    if (blockIdx.x == 0 && F.wave == 0 && lane0 == 0) { float* dgo = (float*)(F.ws + WS_CTL + 65536); const float n = (float)dg[4];
        dgo[0] = (float)dg[0] / n; dgo[1] = (float)dg[1] / n; dgo[2] = (float)dg[2] / n; dgo[3] = (float)dg[3] / n; dgo[4] = n; }
#endif
}

constexpr size_t WS_HL = WS_H, WS_AC = WS_H + 32 * MiB;
constexpr size_t WS_SUMM = 3 * MiB;
constexpr int LRU_W = 512, NSEG = 32;
__device__ __forceinline__ float expm1_fast(float x) { const float p = x * (1.0f + x * (0.5f + x * (0.16666667f + x * (0.041666668f + x * 0.0083333338f)))); return x > -0.1f ? p : __expf(x) - 1.0f; }
__device__ __forceinline__ float fast_sigmoid(float z) { return __builtin_amdgcn_rcpf(1.0f + __expf(-z)); }
__device__ __forceinline__ void p_lru_local(Frame& F, const bf16* proj) {
    const float* conv_w = inp(F, 10); const float* conv_b = inp(F, 11); const float* ga_w = inp(F, 12); const float* ga_b = inp(F, 13); const float* gx_w = inp(F, 14); const float* gx_b = inp(F, 15); const float* lamp = inp(F, 16);
    const int lane = F.lane, r32 = lane & 31, hi = lane >> 5;
    const int g = blockIdx.x & 7;
    LAS unsigned char* WAl = F.lds;
    LAS float* Lc = (LAS float*)(F.lds + 16384);
    LAS float* cw = Lc; LAS float* cb = Lc + 256; LAS float* gab = Lc + 320; LAS float* gxb = Lc + 384; LAS float* lsl = Lc + 448;
    LAS float* hcs = (LAS float*)(F.lds + 20480 + F.wave * 512); LAS float* Acs = hcs + 64;
    __syncthreads();
    if (F.wave == 0) { const int c = g * 64 + lane;
      cw[lane] = conv_w[c]; cw[64 + lane] = conv_w[512 + c]; cw[128 + lane] = conv_w[1024 + c]; cw[192 + lane] = conv_w[1536 + c];
      cb[lane] = conv_b[c]; gab[lane] = ga_b[c]; gxb[lane] = gx_b[c]; lsl[lane] = logsig_f(lamp[c]); }
#pragma unroll
    for (int f2 = 0; f2 < 2; ++f2) { const int fi = 2 * F.wave + f2, rt = fi >> 2, ks = fi & 3;
        const float* wp = (rt < 2 ? ga_w : gx_w) + (size_t)g * 4096 + 32 * (rt & 1) + r32 + (16 * ks + 8 * hi) * 64; v4u w;
        w.x = cvtpk(wp[0], wp[64]); w.y = cvtpk(wp[128], wp[192]); w.z = cvtpk(wp[256], wp[320]); w.w = cvtpk(wp[384], wp[448]);
        *(LAS v4u*)(WAl + (fi * 64 + lane) * 16) = w; }
    __syncthreads();
    bf16x8 idf[2];
#pragma unroll
    for (int kk = 0; kk < 2; ++kk)
#pragma unroll
        for (int jj = 0; jj < 8; ++jj) idf[kk][jj] = (r32 == (16 * kk + 8 * hi + jj)) ? (short)0x3F80 : (short)0;
#define LRU_WA(rt, ks) (*(const LAS bf16x8*)(WAl + (((rt) * 4 + (ks)) * 64 + lane) * 16))
    bf16* HL = (bf16*)(F.ws + WS_HL); bf16* AC = (bf16*)(F.ws + WS_AC); float* SUMM = (float*)(F.ws + WS_SUMM);
    for (int item = (blockIdx.x >> 3) * 8 + F.wave; item < NB * NSEG; item += (F.G >> 3) * 8) {
        const int b = item / NSEG, seg = item % NSEG;
        hcs[lane] = 0.f; Acs[lane] = 1.f;
        LDS_WAIT(); asm volatile("" ::: "memory");
#pragma unroll 1
        for (int tile = 0; tile < 4; ++tile) {
            const int t = seg * 128 + tile * 32 + r32; const size_t row = (size_t)b * SEQ + t;
            bf16x8 Bf[4];
#pragma unroll
            for (int ks = 0; ks < 4; ++ks) { const int i0 = 16 * ks + 8 * hi; const bf16* xp = proj + row * EVEN_IN + 1536 + g * 64 + i0;
                float xc[8];
                { const f32x4 c0 = *(const LAS f32x4*)(cb + i0), c1 = *(const LAS f32x4*)(cb + i0 + 4); xc[0] = c0.x; xc[1] = c0.y; xc[2] = c0.z; xc[3] = c0.w; xc[4] = c1.x; xc[5] = c1.y; xc[6] = c1.z; xc[7] = c1.w; }
#pragma unroll
                for (int w = 0; w < 4; ++w) { const int back = 3 - w;
                    const bool inb = (t - back >= 0);
                    bf16x8 xv = *(const bf16x8*)(xp - (size_t)(inb ? back : 0) * EVEN_IN);
                    if (!inb) xv = (bf16x8){0, 0, 0, 0, 0, 0, 0, 0};
                    const f32x4 w0 = *(const LAS f32x4*)(cw + 64 * w + i0), w1 = *(const LAS f32x4*)(cw + 64 * w + i0 + 4);
                    xc[0] += w0.x * bf2f((bf16)xv[0]); xc[1] += w0.y * bf2f((bf16)xv[1]); xc[2] += w0.z * bf2f((bf16)xv[2]); xc[3] += w0.w * bf2f((bf16)xv[3]);
                    xc[4] += w1.x * bf2f((bf16)xv[4]); xc[5] += w1.y * bf2f((bf16)xv[5]); xc[6] += w1.z * bf2f((bf16)xv[6]); xc[7] += w1.w * bf2f((bf16)xv[7]); }
                v4u pk; pk.x = cvtpk(xc[0], xc[1]); pk.y = cvtpk(xc[2], xc[3]); pk.z = cvtpk(xc[4], xc[5]); pk.w = cvtpk(xc[6], xc[7]); Bf[ks] = __builtin_bit_cast(bf16x8, pk);
                __builtin_amdgcn_sched_barrier(0); }
#pragma unroll 1
            for (int rt2 = 0; rt2 < 2; ++rt2) {
                f32x16 Dr, Di, Dx;
#pragma unroll
                for (int r = 0; r < 16; ++r) { Dr[r] = 0.f; Di[r] = 0.f; Dx[r] = 0.f; }
#pragma unroll
                for (int ks = 0; ks < 4; ++ks) {
                    Dr = __builtin_amdgcn_mfma_f32_32x32x16_bf16(LRU_WA(rt2, ks), Bf[ks], Dr, 0, 0, 0);
                    Di = __builtin_amdgcn_mfma_f32_32x32x16_bf16(LRU_WA(2 + rt2, ks), Bf[ks], Di, 0, 0, 0);
                    if ((ks >> 1) == rt2) Dx = __builtin_amdgcn_mfma_f32_32x32x16_bf16(idf[ks & 1], Bf[ks], Dx, 0, 0, 0); }
                float av[16], hv[16];
#pragma unroll
                for (int a4 = 0; a4 < 4; ++a4) { const int ch = 32 * rt2 + 8 * a4 + 4 * hi;
                    const f32x4 ba = *(const LAS f32x4*)(gab + ch), bx = *(const LAS f32x4*)(gxb + ch), ls = *(const LAS f32x4*)(lsl + ch);
#pragma unroll
                    for (int q = 0; q < 4; ++q) { const int r = 4 * a4 + q;
                        const float rg = fast_sigmoid(Dr[r] + ba[q]), ig = fast_sigmoid(Di[r] + bx[q]);
                        const float log_a = 8.0f * rg * ls[q];
                        av[r] = __expf(log_a); hv[r] = __builtin_amdgcn_sqrtf(-expm1_fast(2.0f * log_a)) * (ig * Dx[r]); }
                    __builtin_amdgcn_sched_barrier(0); }
#define LRU_DPP(oldv, v, ctrl, rmask) __builtin_bit_cast(float, __builtin_amdgcn_update_dpp(__builtin_bit_cast(int, (float)(oldv)), __builtin_bit_cast(int, (float)(v)), (ctrl), (rmask), 0xf, false))
#define LRU_STEP(ctrl, rmask) do { _Pragma("unroll") for (int r = 0; r < 16; ++r) { const float ap = LRU_DPP(1.0f, av[r], ctrl, rmask), hp = LRU_DPP(0.0f, hv[r], ctrl, rmask); \
                        hv[r] = av[r] * hp + hv[r]; av[r] = av[r] * ap; } } while (0)
                LRU_STEP(0x111, 0xf); LRU_STEP(0x112, 0xf); LRU_STEP(0x114, 0xf); LRU_STEP(0x118, 0xf); LRU_STEP(0x142, 0xa);
#undef LRU_STEP
#undef LRU_DPP
                unsigned hp[4][2], ap[4][2];
#pragma unroll
                for (int a4 = 0; a4 < 4; ++a4) { const int ch = 32 * rt2 + 8 * a4 + 4 * hi;
                    const f32x4 hc = *(const LAS f32x4*)(hcs + ch), Ac = *(const LAS f32x4*)(Acs + ch);
                    f32x4 ho, ao;
#pragma unroll
                    for (int q = 0; q < 4; ++q) { const int r = 4 * a4 + q; ho[q] = hv[r] + av[r] * hc[q]; ao[q] = av[r] * Ac[q]; }
                    asm volatile("" ::: "memory");
                    if (r32 == 31) { *(LAS f32x4*)(hcs + ch) = ho; *(LAS f32x4*)(Acs + ch) = ao; }
                    hp[a4][0] = cvtpk(ho[0], ho[1]); hp[a4][1] = cvtpk(ho[2], ho[3]); ap[a4][0] = cvtpk(ao[0], ao[1]); ap[a4][1] = cvtpk(ao[2], ao[3]); }
#pragma unroll
                for (int k = 0; k < 2; ++k) {
#pragma unroll
                    for (int j = 0; j < 2; ++j) {
                        { auto r = __builtin_amdgcn_permlane32_swap(hp[2 * k][j], hp[2 * k + 1][j], false, false); hp[2 * k][j] = r[0]; hp[2 * k + 1][j] = r[1]; }
                        { auto r = __builtin_amdgcn_permlane32_swap(ap[2 * k][j], ap[2 * k + 1][j], false, false); ap[2 * k][j] = r[0]; ap[2 * k + 1][j] = r[1]; } }
                    const size_t o = row * LRU_W + g * 64 + 32 * rt2 + 16 * k + 8 * hi;
                    v4u wh, wa; wh.x = hp[2 * k][0]; wh.y = hp[2 * k][1]; wh.z = hp[2 * k + 1][0]; wh.w = hp[2 * k + 1][1];
                    wa.x = ap[2 * k][0]; wa.y = ap[2 * k][1]; wa.z = ap[2 * k + 1][0]; wa.w = ap[2 * k + 1][1];
                    *(GAS v4u*)(HL + o) = wh; *(GAS v4u*)(AC + o) = wa; }
                LDS_WAIT(); asm volatile("" ::: "memory");
            }
        }
        { float* sp = SUMM + ((size_t)(b * NSEG + seg) * 2) * LRU_W + g * 64; sp[lane] = Acs[lane]; sp[LRU_W + lane] = hcs[lane]; }
    }
#undef LRU_WA
}
__device__ __forceinline__ void p_lru_fix(Frame& F, const bf16* proj, bf16* mix) {
    const bf16* HL = (const bf16*)(F.ws + WS_HL); const bf16* AC = (const bf16*)(F.ws + WS_AC); const float* SUMM = (const float*)(F.ws + WS_SUMM);
    const int lane = F.lane;
    for (int u = F.gw; u < NB * NSEG * 8; u += F.NGW) {
        const int qt = u & 7, bs = u >> 3, b = bs / NSEG, seg = bs % NSEG;
        float c[8];
#pragma unroll
        for (int j = 0; j < 8; ++j) c[j] = 0.f;
        const float* sp0 = SUMM + ((size_t)(b * NSEG) * 2) * LRU_W + 8 * lane;
        int s = 0;
        for (; s + 4 <= seg; s += 4) {
            f32x4 a0[4], a1[4], h0[4], h1[4];
#pragma unroll
            for (int k = 0; k < 4; ++k) { const float* sp = sp0 + (size_t)(s + k) * 2 * LRU_W; a0[k] = *(const GAS f32x4*)sp; a1[k] = *(const GAS f32x4*)(sp + 4); h0[k] = *(const GAS f32x4*)(sp + LRU_W); h1[k] = *(const GAS f32x4*)(sp + LRU_W + 4); }
#pragma unroll
            for (int k = 0; k < 4; ++k) {
                c[0] = a0[k].x * c[0] + h0[k].x; c[1] = a0[k].y * c[1] + h0[k].y; c[2] = a0[k].z * c[2] + h0[k].z; c[3] = a0[k].w * c[3] + h0[k].w;
                c[4] = a1[k].x * c[4] + h1[k].x; c[5] = a1[k].y * c[5] + h1[k].y; c[6] = a1[k].z * c[6] + h1[k].z; c[7] = a1[k].w * c[7] + h1[k].w; } }
        for (; s < seg; ++s) { const float* sp = sp0 + (size_t)s * 2 * LRU_W;
            const f32x4 a0 = *(const GAS f32x4*)sp, a1 = *(const GAS f32x4*)(sp + 4), h0 = *(const GAS f32x4*)(sp + LRU_W), h1 = *(const GAS f32x4*)(sp + LRU_W + 4);
            c[0] = a0.x * c[0] + h0.x; c[1] = a0.y * c[1] + h0.y; c[2] = a0.z * c[2] + h0.z; c[3] = a0.w * c[3] + h0.w;
            c[4] = a1.x * c[4] + h1.x; c[5] = a1.y * c[5] + h1.y; c[6] = a1.z * c[6] + h1.z; c[7] = a1.w * c[7] + h1.w; }
#pragma unroll 4
        for (int i = 0; i < 16; ++i) {
            const size_t row = (size_t)b * SEQ + seg * 128 + qt * 16 + i;
            const bf16x8 hl = *(const bf16x8*)(HL + row * LRU_W + 8 * lane), ac = *(const bf16x8*)(AC + row * LRU_W + 8 * lane), gb = *(const bf16x8*)(proj + row * EVEN_IN + 2048 + 8 * lane);
            float y[8];
#pragma unroll
            for (int j = 0; j < 8; ++j) { const float g = bf2f((bf16)gb[j]); const float u2 = 1.5957691216057308f * (g + 0.044715f * g * g * g);
                y[j] = (bf2f((bf16)hl[j]) + bf2f((bf16)ac[j]) * c[j]) * (g * __builtin_amdgcn_rcpf(1.0f + __expf(-u2))); }
            v4u w; w.x = cvtpk(y[0], y[1]); w.y = cvtpk(y[2], y[3]); w.z = cvtpk(y[4], y[5]); w.w = cvtpk(y[6], y[7]);
            *(GAS v4u*)(mix + row * DM + 512 + 8 * lane) = w;
        }
    }
}

constexpr int SB_LDS0 = 32768;
constexpr float LN2 = 0.6931471805599453f;
#define SB_QSCALE_COLS 512
#define SB_QSCALE (0.125f * LOG2E)
constexpr float SB_STOP = -40.0f * LOG2E;
__device__ __forceinline__ void p_sb_attn(Frame& F, const bf16* proj, bf16* mix) {
    const int lane = F.lane, wave = F.wave, r32 = lane & 31, hi = lane >> 5;
    LAS unsigned char* Vw = F.lds + SB_LDS0 + wave * 8192;
    const int q4 = (lane & 15) >> 2, p4 = lane & 3, blk = (lane >> 4) & 1;
    const int vb0 = 64 * (4 * hi + q4) + 16 * ((2 * blk + (p4 >> 1)) ^ hi) + 8 * (p4 & 1);
    const int vb1 = 1024 + 64 * (4 * hi + q4) + 16 * ((2 * blk + (p4 >> 1)) ^ (2 + hi)) + 8 * (p4 & 1);
    const int vkl = (lane >> 2) & 7, vchE = 4 * (lane >> 5) + ((lane & 3) ^ ((lane >> 4) & 1)), vchO = 4 * (lane >> 5) + ((lane & 3) ^ (2 + ((lane >> 4) & 1)));
    const unsigned voE = (unsigned)(vkl * EVEN_IN + 8 * vchE) * 2u, voO = (unsigned)(vkl * EVEN_IN + 8 * vchO) * 2u;
    bf16x8 Tp[2], ONES;
#pragma unroll
    for (int ks = 0; ks < 2; ++ks)
#pragma unroll
        for (int jj = 0; jj < 8; ++jj) Tp[ks][jj] = ((16 * ks + 8 * (jj >> 2) + 4 * hi + (jj & 3)) > r32) ? (short)0x3F80 : (short)0;
#pragma unroll
    for (int jj = 0; jj < 8; ++jj) ONES[jj] = (short)0x3F80;
    for (int u = F.gw; u < NB * 8 * (SEQ / 32); u += F.NGW) {
        const int qt = u % (SEQ / 32), h = (u / (SEQ / 32)) % 8, b = u / (8 * (SEQ / 32)), qw = qt * 32;
        const bf16* base = proj + (size_t)b * SEQ * EVEN_IN;
        bf16x8 qf[4];
        { const bf16* qp = base + (size_t)(qw + r32) * EVEN_IN + h * 64 + 8 * hi;
#pragma unroll
          for (int d0 = 0; d0 < 4; ++d0) qf[d0] = *(const bf16x8*)(qp + 16 * d0); }
        f32x16 oacc[2];
#pragma unroll
        for (int c = 0; c < 2; ++c)
#pragma unroll
            for (int r = 0; r < 16; ++r) oacc[c][r] = 0.f;
        float R = 0.f;
        const int qpos = qw + r32;
#pragma unroll 1
        for (int k0 = ((qw + 30) >> 6) << 6; k0 >= 0; k0 -= 64) {
            LDS_WAIT();
            { const char* vg = (const char*)(base + (size_t)k0 * EVEN_IN + 1024 + h * 64);
#pragma unroll
              for (int p = 0; p < 8; ++p)
                  __builtin_amdgcn_global_load_lds((const unsigned*)(vg + (size_t)(8 * p) * EVEN_IN * 2 + ((p & 1) ? voO : voE)), (LAS unsigned*)(Vw + p * 1024), 16, 0, 0); }
            f32x16 p0, p1;
#pragma unroll
            for (int r = 0; r < 16; ++r) { p0[r] = 0.f; p1[r] = 0.f; }
            { const bf16* kp = base + (size_t)(k0 + r32) * EVEN_IN + 512 + h * 64 + 8 * hi;
#pragma unroll
              for (int d0 = 0; d0 < 4; ++d0) { const bf16x8 a0 = *(const bf16x8*)(kp + 16 * d0), a1 = *(const bf16x8*)(kp + (size_t)32 * EVEN_IN + 16 * d0);
                  p0 = __builtin_amdgcn_mfma_f32_32x32x16_bf16(a0, qf[d0], p0, 0, 0, 0);
                  p1 = __builtin_amdgcn_mfma_f32_32x32x16_bf16(a1, qf[d0], p1, 0, 0, 0); } }
            float Lsum = 0.f; bf16x8 Lh[4], Ll[4];
#define SB_SOFT(MASKED) \
            _Pragma("unroll") for (int half = 0; half < 2; ++half) { \
                float Lv[16]; \
                _Pragma("unroll") for (int r = 0; r < 16; ++r) { const float z = half ? p1[r] : p0[r]; \
                    const float sp = __builtin_amdgcn_logf(1.0f + __builtin_amdgcn_exp2f(-fabsf(z))); \
                    float lp = fminf(z, 0.f) - sp, lv = -fmaxf(z, 0.f) - sp; \
                    if (MASKED) { const bool valid = (k0 + 32 * half + crow(r, hi)) < qpos; lv = valid ? lv : 0.f; lp = valid ? lp : -INFINITY; } \
                    Lv[r] = lv; Lsum += lv; if (half) p1[r] = lp; else p0[r] = lp; } \
                _Pragma("unroll") for (int s = 0; s < 2; ++s) { v4u wh, wl; unsigned hv[4], lv[4]; \
                    _Pragma("unroll") for (int i = 0; i < 4; ++i) { const float x0 = Lv[8 * s + 2 * i], x1 = Lv[8 * s + 2 * i + 1]; hv[i] = cvtpk(x0, x1); \
                        const float r0 = x0 - __uint_as_float(hv[i] << 16), r1 = x1 - __uint_as_float(hv[i] & 0xffff0000u); lv[i] = cvtpk(r0, r1); } \
                    wh.x = hv[0]; wh.y = hv[1]; wh.z = hv[2]; wh.w = hv[3]; wl.x = lv[0]; wl.y = lv[1]; wl.z = lv[2]; wl.w = lv[3]; \
                    Lh[2 * half + s] = __builtin_bit_cast(bf16x8, wh); Ll[2 * half + s] = __builtin_bit_cast(bf16x8, wl); } }
            if (k0 + 63 >= qw) { SB_SOFT(1) } else { SB_SOFT(0) }
#undef SB_SOFT
            __builtin_amdgcn_sched_barrier(0);
            f32x16 l0, l1;
#pragma unroll
            for (int r = 0; r < 16; ++r) { l0[r] = R + p0[r]; l1[r] = R + p1[r]; }
#pragma unroll
            for (int ks = 0; ks < 2; ++ks) {
                l0 = __builtin_amdgcn_mfma_f32_32x32x16_bf16(Tp[ks], Lh[ks], l0, 0, 0, 0); l0 = __builtin_amdgcn_mfma_f32_32x32x16_bf16(Tp[ks], Ll[ks], l0, 0, 0, 0);
                l0 = __builtin_amdgcn_mfma_f32_32x32x16_bf16(ONES, Lh[2 + ks], l0, 0, 0, 0); l0 = __builtin_amdgcn_mfma_f32_32x32x16_bf16(ONES, Ll[2 + ks], l0, 0, 0, 0);
                l1 = __builtin_amdgcn_mfma_f32_32x32x16_bf16(Tp[ks], Lh[2 + ks], l1, 0, 0, 0); l1 = __builtin_amdgcn_mfma_f32_32x32x16_bf16(Tp[ks], Ll[2 + ks], l1, 0, 0, 0); }
            R += half_sum(Lsum);
            bf16x8 pw[4];
            { v4u w;
#define SBW(P, Lx, r) __builtin_amdgcn_exp2f(Lx[r])
              w.x = cvtpk(SBW(p0, l0, 0), SBW(p0, l0, 1)); w.y = cvtpk(SBW(p0, l0, 2), SBW(p0, l0, 3)); w.z = cvtpk(SBW(p0, l0, 4), SBW(p0, l0, 5)); w.w = cvtpk(SBW(p0, l0, 6), SBW(p0, l0, 7)); pw[0] = __builtin_bit_cast(bf16x8, w);
              w.x = cvtpk(SBW(p0, l0, 8), SBW(p0, l0, 9)); w.y = cvtpk(SBW(p0, l0, 10), SBW(p0, l0, 11)); w.z = cvtpk(SBW(p0, l0, 12), SBW(p0, l0, 13)); w.w = cvtpk(SBW(p0, l0, 14), SBW(p0, l0, 15)); pw[1] = __builtin_bit_cast(bf16x8, w);
              w.x = cvtpk(SBW(p1, l1, 0), SBW(p1, l1, 1)); w.y = cvtpk(SBW(p1, l1, 2), SBW(p1, l1, 3)); w.z = cvtpk(SBW(p1, l1, 4), SBW(p1, l1, 5)); w.w = cvtpk(SBW(p1, l1, 6), SBW(p1, l1, 7)); pw[2] = __builtin_bit_cast(bf16x8, w);
              w.x = cvtpk(SBW(p1, l1, 8), SBW(p1, l1, 9)); w.y = cvtpk(SBW(p1, l1, 10), SBW(p1, l1, 11)); w.z = cvtpk(SBW(p1, l1, 12), SBW(p1, l1, 13)); w.w = cvtpk(SBW(p1, l1, 14), SBW(p1, l1, 15)); pw[3] = __builtin_bit_cast(bf16x8, w);
#undef SBW
            }
            asm volatile("s_waitcnt vmcnt(0)" ::: "memory");
#pragma unroll
            for (int c = 0; c < 2; ++c) {
                bf16x8 va[4];
#pragma unroll
                for (int s = 0; s < 4; ++s) va[s] = vfrag(Vw + vb0 + 2048 * s + 512 * c, Vw + vb1 + 2048 * s + 512 * c);
#pragma unroll
                for (int s = 0; s < 4; ++s) oacc[c] = __builtin_amdgcn_mfma_f32_32x32x16_bf16(va[s], pw[s], oacc[c], 0, 0, 0);
            }
            if (__all(R < SB_STOP)) break;
        }
        bf16* op = mix + ((size_t)b * SEQ + qpos) * DM + h * 64 + 8 * hi;
#pragma unroll
        for (int c = 0; c < 2; ++c)
#pragma unroll
            for (int k = 0; k < 2; ++k) {
                unsigned ax = cvtpk(oacc[c][8 * k], oacc[c][8 * k + 1]), ay = cvtpk(oacc[c][8 * k + 2], oacc[c][8 * k + 3]);
                unsigned bx = cvtpk(oacc[c][8 * k + 4], oacc[c][8 * k + 5]), by = cvtpk(oacc[c][8 * k + 6], oacc[c][8 * k + 7]);
                { auto r = __builtin_amdgcn_permlane32_swap(ax, bx, false, false); ax = r[0]; bx = r[1]; }
                { auto r = __builtin_amdgcn_permlane32_swap(ay, by, false, false); ay = r[0]; by = r[1]; }
                v4u w; w.x = ax; w.y = ay; w.z = bx; w.w = by;
                *(GAS v4u*)(op + 32 * c + 16 * k) = w; }
    }
}

#ifndef MK_NAIVE_DIFF
#define MK_NAIVE_DIFF 0
#endif
constexpr int NPHASE = 19;
#ifndef MK_REP3_SUB
#define MK_REP3_SUB 0
#endif
#ifndef MK_REPEAT_PHASE
#define MK_REPEAT_PHASE -1
#endif
#ifndef MK_REPEAT_COUNT
#define MK_REPEAT_COUNT 2
#endif
#ifndef MK_NAIVE_MIX0
#define MK_NAIVE_MIX0 0
#endif
struct Args { const float* in[32]; float* out; unsigned char* ws; int ph_lo, ph_hi; float lambda_init; int pad; };
__global__ void __launch_bounds__(NWAVES * 64, 2) mk_fwd(Args args) {
    extern __shared__ __attribute__((aligned(16))) unsigned char lds[];
    Frame F;
    F.lds = (LAS unsigned char*)lds; F.MISC = (volatile LAS unsigned*)(F.lds + MISC_OFF);
    F.wave = __builtin_amdgcn_readfirstlane(threadIdx.x >> 6); F.lane = mk_lane(); F.tid = F.wave * 64 + F.lane;
    F.G = gridDim.x; F.gw = blockIdx.x * NWAVES + F.wave; F.NGW = F.G * NWAVES;
    F.out = args.out; F.ws = args.ws; F.ctl = (gu32*)(args.ws + WS_CTL);
    for (int u = F.tid; u < (LDS_BYTES - MISC_OFF) / 4; u += NWAVES * 64) ((LAS unsigned*)(F.lds + MISC_OFF))[u] = 0u;
    __syncthreads();
    if (F.tid < 32) ((LAS unsigned long long*)(F.lds + MISC_OFF + 512))[F.tid] = (unsigned long long)args.in[F.tid];
    __syncthreads();
    const int lo = args.ph_lo, hi = args.ph_hi;
    const bool one = (hi - lo) > 1;
    XcdBarrier bar; bar.bar = (unsigned*)(F.ctl + CW_BAR); bar.x = 0; bar.st = nullptr; bar.wave = F.wave;
    if (one) bar = xcd_barrier_post((unsigned*)(F.ctl + CW_BAR), F.MISC + 8, F.wave);
#define IN(k) (lo <= (k) && (k) < hi && ((F.lane = mk_lane()), (F.tid = F.wave * 64 + F.lane), true))
#define SEAM(k) do { if (IN(k) && IN((k) + 1)) xcd_barrier(bar); } while (0)
    unsigned char* ws = args.ws;
    float* xo = args.out;
    const float* mod0 = (const float*)(ws + WS_MOD); const float* mod1 = mod0 + (size_t)NB * 6144;
    bf16* H = (bf16*)(ws + WS_H); bf16* PROJ = (bf16*)(ws + WS_PROJ); bf16* MIX = (bf16*)args.out;                   bf16* ACT = (bf16*)(ws + WS_ACT); bf16* XB = (bf16*)(ws + WS_XB);
    const int G = F.G, cid = (int)blockIdx.x;

    if (IN(0)) for (int rep_ = 0; rep_ < ((MK_REPEAT_PHASE == 0) ? MK_REPEAT_COUNT : 1); ++rep_) { if (rep_ > 0) __syncthreads();  p_prologue(F); } SEAM(0);
    if (IN(1)) for (int rep_ = 0; rep_ < ((MK_REPEAT_PHASE == 1) ? MK_REPEAT_COUNT : 1); ++rep_) { if (rep_ > 0) __syncthreads();  p_norm_mod<false>(F, inp(F, 0), H, inp(F, 5), mod0, 0, 1024); } SEAM(1);
    if (IN(2)) for (int rep_ = 0; rep_ < ((MK_REPEAT_PHASE == 2) ? MK_REPEAT_COUNT : 1); ++rep_) { if (rep_ > 0) __syncthreads();  pg8::SchedPlain S; S.init(H, ws + WS_WIN0, MTOK, EVEN_IN, DM, G, cid); pg8::EpiStore E{(pg8::bf16_t*)PROJ, EVEN_IN, SB_QSCALE_COLS, SB_QSCALE};
                 pg8::gphase<pg8::EpiStore, pg8::SchedPlain, false>(F.lds, DM, S, E, F.wave, F.lane); } SEAM(2);
    if (IN(3)) for (int rep_ = 0; rep_ < ((MK_REPEAT_PHASE == 3) ? MK_REPEAT_COUNT : 1); ++rep_) { if (rep_ > 0) __syncthreads();
#if MK_NAIVE_MIX0
        if (F.wave == 0) { if (cid < NB * 8) p_lru_naive_wave(F, cid, PROJ, MIX); } else p_sb_naive(F, PROJ, MIX);
#else
        if (rep_ == 0 || MK_REP3_SUB != 2) p_lru_local(F, PROJ);
        if (rep_ == 0 || MK_REP3_SUB != 1) p_sb_attn(F, PROJ, MIX);
#endif
    } SEAM(3);
    if (IN(4)) for (int rep_ = 0; rep_ < ((MK_REPEAT_PHASE == 4) ? MK_REPEAT_COUNT : 1); ++rep_) { if (rep_ > 0) __syncthreads();
#if !MK_NAIVE_MIX0
        p_lru_fix(F, PROJ, MIX);
#endif
    } SEAM(4);

    if (IN(5)) for (int rep_ = 0; rep_ < ((MK_REPEAT_PHASE == 5) ? MK_REPEAT_COUNT : 1); ++rep_) { if (rep_ > 0) __syncthreads();  pg8::SchedPlain S; S.init(MIX, ws + WS_WOUT0, MTOK, DM, DM, G, cid); pg8::EpiResid<false> E{inp(F, 0), (pg8::bf16_t*)XB, mod0 + 2048, 6144, SEQ, DM, 0};
                 pg8::gphase<pg8::EpiResid<false>, pg8::SchedPlain, false>(F.lds, DM, S, E, F.wave, F.lane); } SEAM(5);
    if (IN(6)) for (int rep_ = 0; rep_ < ((MK_REPEAT_PHASE == 6) ? MK_REPEAT_COUNT : 1); ++rep_) { if (rep_ > 0) __syncthreads();  p_norm_mod<true>(F, XB, H, inp(F, 6), mod0, 3072, 4096); } SEAM(6);
    if (IN(7)) for (int rep_ = 0; rep_ < ((MK_REPEAT_PHASE == 7) ? MK_REPEAT_COUNT : 1); ++rep_) { if (rep_ > 0) __syncthreads();  pg8::SchedPlain S; S.init(H, ws + WS_WGU0, MTOK, 2 * FFD, DM, G, cid); pg8::EpiSwiglu E{(pg8::bf16_t*)ACT, FFD, 0};
                 pg8::gphase<pg8::EpiSwiglu, pg8::SchedPlain, false>(F.lds, DM, S, E, F.wave, F.lane); } SEAM(7);
    if (IN(8)) for (int rep_ = 0; rep_ < ((MK_REPEAT_PHASE == 8) ? MK_REPEAT_COUNT : 1); ++rep_) { if (rep_ > 0) __syncthreads();  pg8::SchedPlain S; S.init(ACT, ws + WS_WD0, MTOK, DM, FFD, G, cid); pg8::EpiResid<true> E{XB, (pg8::bf16_t*)XB, mod0 + 5120, 6144, SEQ, DM, 0};
                 pg8::gphase<pg8::EpiResid<true>, pg8::SchedPlain, false>(F.lds, FFD, S, E, F.wave, F.lane); } SEAM(8);
    if (IN(9)) for (int rep_ = 0; rep_ < ((MK_REPEAT_PHASE == 9) ? MK_REPEAT_COUNT : 1); ++rep_) { if (rep_ > 0) __syncthreads();  p_norm_mod<true>(F, XB, H, inp(F, 5) + DM, mod1, 0, 1024); } SEAM(9);
    if (IN(10)) for (int rep_ = 0; rep_ < ((MK_REPEAT_PHASE == 10) ? MK_REPEAT_COUNT : 1); ++rep_) { if (rep_ > 0) __syncthreads();  pg8::SchedPlain S; S.init(H, ws + WS_WIN1, MTOK, ODD_IN, DM, G, cid); pg8::EpiStore E{(pg8::bf16_t*)PROJ, ODD_IN, ATTN_QSCALE_COLS, ATTN_QSCALE};
                 pg8::gphase<pg8::EpiStore, pg8::SchedPlain, false>(F.lds, DM, S, E, F.wave, F.lane); } SEAM(10);
    if (IN(11)) for (int rep_ = 0; rep_ < ((MK_REPEAT_PHASE == 11) ? MK_REPEAT_COUNT : 1); ++rep_) { if (rep_ > 0) __syncthreads();
#if MK_NAIVE_DIFF
        p_diff_naive(F, PROJ, MIX, args.lambda_init);
#else
#ifdef MK_ATTN_VAR
        if (rep_ == 0) p_diff_attn(F, PROJ, MIX, args.lambda_init); else p_diff_attn_t<MK_ATTN_VAR>(F, PROJ, H, args.lambda_init);
#else
        p_diff_attn(F, PROJ, MIX, args.lambda_init);
#endif
#endif
    } SEAM(11);
    if (IN(12)) for (int rep_ = 0; rep_ < ((MK_REPEAT_PHASE == 12) ? MK_REPEAT_COUNT : 1); ++rep_) { if (rep_ > 0) __syncthreads();  pg8::SchedPlain S; S.init(MIX, ws + WS_WOUT1, MTOK, DM, DM, G, cid); pg8::EpiResid<true> E{XB, (pg8::bf16_t*)XB, mod1 + 2048, 6144, SEQ, DM, 0};
                  pg8::gphase<pg8::EpiResid<true>, pg8::SchedPlain, false>(F.lds, DM, S, E, F.wave, F.lane); } SEAM(12);
    if (IN(13)) for (int rep_ = 0; rep_ < ((MK_REPEAT_PHASE == 13) ? MK_REPEAT_COUNT : 1); ++rep_) { if (rep_ > 0) __syncthreads();  p_router(F, XB, H, inp(F, 6) + DM, mod1, 3072, 4096); } SEAM(13);
    int ntiles = 0;
    LAS int* mtab = (LAS int*)(F.lds + MISC_OFF + 256);
    if (hi > 14 && lo < 18) {
        int acc_t = 0;
#pragma unroll
        for (int e = 0; e < NEXP; ++e) { const int c = (int)__builtin_amdgcn_readfirstlane(__hip_atomic_load(F.ctl + CW_CNT + 64 * e, RLX_AGENT));
            if (F.tid == 0) { mtab[e] = acc_t; mtab[16 + e] = c; } acc_t += (c + 255) >> 8; }
        if (F.tid == 0) mtab[8] = acc_t;
        ntiles = acc_t;
        __syncthreads();
    }
    const int nA = ntiles < MOE_CHUNK_TILES ? ntiles : MOE_CHUNK_TILES, nAB = ntiles < 2 * MOE_CHUNK_TILES ? ntiles : 2 * MOE_CHUNK_TILES, nB = nAB - nA, nO = ntiles - nAB;
    const bool fancy = (G == 256) && nO > 0 && nB == MOE_CHUNK_TILES;
    const int nd = fancy ? 4 * nO : 0;
    const int* list = (const int*)(ws + WS_LIST);
#define MOE_SCHED(S, Aptr, Wptr, Kk, gat, t0_, nM_, nN_, ovfat_, mode_) pg8::SchedMoe S; S.A = (const char*)(Aptr); S.W = (const char*)(Wptr); S.wstride = WMOE_STRIDE; S.list = list; S.cap = LIST_CAP; S.tab = mtab; \
        S.t0 = (t0_); S.K = (Kk); S.gather = (gat); S.ovf_at = (ovfat_); S.ovf_tile0 = 2 * MOE_CHUNK_TILES; S.mode = (mode_); S.nd = nd; S.rounds = ((nM_) * (nN_) + G - 1) / G; S.so.init((nM_) * 256, (nN_) * 256, G, cid)
    if (IN(14)) for (int rep_ = 0; rep_ < ((MK_REPEAT_PHASE == 14) ? MK_REPEAT_COUNT : 1); ++rep_) { if (rep_ > 0) __syncthreads();  MOE_SCHED(S, H, ws + WS_WMOE, DM, 1, 0, nA + (fancy ? nO : 0), 2 * FFE / 256, nA, 0);
                  pg8::EpiSwiglu E{(pg8::bf16_t*)ACT, FFE, 0};
                  pg8::gphase<pg8::EpiSwiglu, pg8::SchedMoe, true>(F.lds, DM, S, E, F.wave, F.lane); } SEAM(14);
    if (IN(15)) for (int rep_ = 0; rep_ < ((MK_REPEAT_PHASE == 15) ? MK_REPEAT_COUNT : 1); ++rep_) { if (rep_ > 0) __syncthreads();  MOE_SCHED(S, ACT, ws + WS_WMOE + WMOE_D_OFF, FFE, 0, 0, nA, DM / 256, 1 << 30, 0);
                  pg8::EpiMoeDown E{(pg8::bf16_t*)xo, list, LIST_CAP};
                  pg8::gphase<pg8::EpiMoeDown, pg8::SchedMoe, false>(F.lds, FFE, S, E, F.wave, F.lane); } SEAM(15);
    if (IN(16)) for (int rep_ = 0; rep_ < ((MK_REPEAT_PHASE == 16) ? MK_REPEAT_COUNT : 1); ++rep_) { if (rep_ > 0) __syncthreads();  if (fancy) { MOE_SCHED(S, ACT, ws + WS_WMOE + WMOE_D_OFF, FFE, 0, 0, nO, DM / 256, MOE_CHUNK_TILES, 2);
                      pg8::EpiMoeDown E{(pg8::bf16_t*)xo, list, LIST_CAP};
                      pg8::gphase<pg8::EpiMoeDown, pg8::SchedMoe, false>(F.lds, FFE, S, E, F.wave, F.lane); }
                  { MOE_SCHED(S, H, ws + WS_WMOE, DM, 1, nA, nB + (fancy ? 0 : nO), 2 * FFE / 256, 1 << 30, fancy ? 1 : 0);
                    pg8::EpiSwiglu E{(pg8::bf16_t*)ACT, FFE, 0};
                    pg8::gphase<pg8::EpiSwiglu, pg8::SchedMoe, true>(F.lds, DM, S, E, F.wave, F.lane); } } SEAM(16);
    if (IN(17)) for (int rep_ = 0; rep_ < ((MK_REPEAT_PHASE == 17) ? MK_REPEAT_COUNT : 1); ++rep_) { if (rep_ > 0) __syncthreads();  MOE_SCHED(S, ACT, ws + WS_WMOE + WMOE_D_OFF, FFE, 0, nA, nB + (fancy ? 0 : nO), DM / 256, 1 << 30, 0);
                  pg8::EpiMoeDown E{(pg8::bf16_t*)xo, list, LIST_CAP};
                  pg8::gphase<pg8::EpiMoeDown, pg8::SchedMoe, false>(F.lds, FFE, S, E, F.wave, F.lane); } SEAM(17);
#undef MOE_SCHED
    if (IN(18)) for (int rep_ = 0; rep_ < ((MK_REPEAT_PHASE == 18) ? MK_REPEAT_COUNT : 1); ++rep_) { if (rep_ > 0) __syncthreads();  p_final(F, XB, mod1 + 5120, inp(F, 7)); }
#undef IN
#undef SEAM
}

#ifndef MK_ONE_LAUNCH
#define MK_ONE_LAUNCH 1
#endif
extern "C" void kernel_launch(void* const* d_in, const int* in_sizes, int n_in, void* d_out, int out_size, void* d_ws, size_t ws_size, hipStream_t stream) {
    static int grid = 0;
    if (grid == 0) {
        int dev = 0, cus = 0;
        if (hipGetDevice(&dev) != hipSuccess || hipDeviceGetAttribute(&cus, hipDeviceAttributeMultiprocessorCount, dev) != hipSuccess) { grid = -1; return; }
        if (n_in != 32 || ws_size < WS_END) { fprintf(stderr, "kernel_launch: unexpected n_in %d / ws %zu\n", n_in, ws_size); grid = -1; return; }
        if (hipFuncSetAttribute((const void*)mk_fwd, hipFuncAttributeMaxDynamicSharedMemorySize, LDS_BYTES) != hipSuccess) { grid = -1; return; }
        grid = cus;
    }
    if (grid < 0) return;
    (void)hipMemsetAsync((char*)d_ws + WS_CTL, 0, CTL_ZERO_BYTES, stream);
    Args a{};
    for (int i = 0; i < 32; ++i) a.in[i] = (const float*)d_in[i];
    a.out = (float*)d_out; a.ws = (unsigned char*)d_ws; a.lambda_init = (float)(0.8 - 0.6 * exp(-0.3 * 1.0)); a.pad = 0;
#if MK_ONE_LAUNCH
    a.ph_lo = 0; a.ph_hi = NPHASE;
    hipLaunchKernelGGL(mk_fwd, dim3(grid), dim3(NWAVES * 64), LDS_BYTES, stream, a);
#else
    for (int p = 0; p < NPHASE; ++p) { a.ph_lo = p; a.ph_hi = p + 1; hipLaunchKernelGGL(mk_fwd, dim3(grid), dim3(NWAVES * 64), LDS_BYTES, stream, a); }
#endif
}
```

```cpp
#include <hip/hip_runtime.h>
#include <cstdio>
#include <cstdint>
#include <cmath>
namespace pg8 {
#define PG8_LAS __attribute__((address_space(3)))
typedef unsigned short bf16_t;
typedef short bf16x8 __attribute__((ext_vector_type(8)));
typedef float f32x4 __attribute__((ext_vector_type(4)));
typedef unsigned u32x4 __attribute__((ext_vector_type(4)));
constexpr int BM = 256, BK = 64, HALF = 128, HTB = HALF * BK * 2  , STAGE_BYTES = 8 * HTB, NXCD = 8, WGM = 8;

__host__ __device__ __forceinline__ int lds_byte(int r, int c) { const int st = (r >> 4) * 2 + (c >> 5), rr = r & 15, cc = c & 31, ob = rr * 64 + cc * 2; return st * 1024 + (ob ^ (((ob >> 9) & 1) << 5)); }
__host__ __device__ __forceinline__ void stage_rc(int b, int& R, int& C) { const int st = b / 1024, sb = b % 1024, swz = sb ^ (((sb >> 9) & 1) << 5); R = (st >> 1) * 16 + swz / 64; C = (st & 1) * 32 + (swz % 64) / 2; }
__host__ __device__ __forceinline__ int perm32(int rho) { const int n = rho >> 4, i = rho & 15; return 8 * (i >> 2) + 4 * n + (i & 3); }

struct Unit { int pm, pn; };
struct Gemm { const bf16_t* A; const bf16_t* Bt; int M, N, K, pad; };

struct StaticOrder {
    int nM, nN, nwg, G, c;
    __host__ __device__ void init(int M, int N, int G_, int c_) { nM = M / BM; nN = N / BM; nwg = nM * nN; G = G_; c = c_; }
    __host__ __device__ bool next(int i, Unit& u) const {
        const long L = (long)i * G + c; if (L >= nwg) return false;
        int wgid = (int)L; { const int q = nwg / NXCD, r = nwg % NXCD, xcd = wgid % NXCD, off = wgid / NXCD; wgid = (xcd < r ? xcd * (q + 1) : r * (q + 1) + (xcd - r) * q) + off; }
        const int nig = WGM * nN, gid = wgid / nig, fm = gid * WGM, gsz = (nM - fm) < WGM ? (nM - fm) : WGM;
        u.pm = fm + ((wgid % nig) % gsz); u.pn = (wgid % nig) / gsz; return true;
    }
    __device__ __forceinline__ void a_ready(const Unit&) const {}
    __device__ __forceinline__ void done(const Unit&) const {}
};

__device__ __forceinline__ unsigned cvt_pk_bf16(float lo, float hi) { typedef float f2_ __attribute__((ext_vector_type(2))); typedef __bf16 b2_ __attribute__((ext_vector_type(2))); const f2_ v = {lo, hi}; const b2_ b = __builtin_convertvector(v, b2_); return __builtin_bit_cast(unsigned, b); }
typedef float f32x2 __attribute__((ext_vector_type(2)));
__device__ __forceinline__ f32x2 gelu_pk(f32x2 v) {
    const f32x2 av = __builtin_elementwise_abs(v), d = av * 0.2316418882f + 1.0f;
    f32x2 t; t.x = __builtin_amdgcn_rcpf(d.x); t.y = __builtin_amdgcn_rcpf(d.y);
    f32x2 q = t * 0.5307027145f + (-0.7265760135f); q = q * t + 0.7107068705f; q = q * t + (-0.142248368f); q = q * t + 0.127414796f; q = q * t;
    const f32x2 s = (v * v) * (-0.72134752044f);
    f32x2 e; e.x = __builtin_amdgcn_exp2f(s.x); e.y = __builtin_amdgcn_exp2f(s.y);
    const f32x2 m = v * (q * e), r = v - m;
    f32x2 o; o.x = v.x < 0.f ? m.x : r.x; o.y = v.y < 0.f ? m.y : r.y; return o;
}

template <int ACT  > struct EpiBf16 {
    static constexpr bool PERM = true, AFTER_DRAIN = false; static_assert(ACT == 0 || ACT == 1, "EpiBf16: ACT is 0 (none) or 1 (gelu_pk)");
    bf16_t* O; int ldc; const float* bias; int split_cols; size_t split_stride; float scale0;
    __device__ __forceinline__ void operator()(const f32x4 (&acc)[2][2][4][2], const Unit& u, int wr, int wc, int fr, int fq) const {
        const int row0 = u.pm * BM + wr * 64 + fr; int colt = u.pn * BM; bf16_t* base = O;
        float sc = 1.f; if (split_cols) { const int t = colt / split_cols; base += (size_t)t * split_stride; colt -= t * split_cols; if (t == 0) sc = scale0; }
        const int col0 = colt + wc * 32 + 8 * fq, bcol0 = u.pn * BM + wc * 32 + 8 * fq;
        f32x4 bv[2][2];
#pragma unroll
        for (int bj = 0; bj < 2; ++bj)
#pragma unroll
            for (int n = 0; n < 2; ++n) bv[bj][n] = bias ? *(const f32x4*)(bias + bcol0 + bj * HALF + 4 * n) : (f32x4){0.f, 0.f, 0.f, 0.f};
#pragma unroll
        for (int ai = 0; ai < 2; ++ai)
#pragma unroll
            for (int m = 0; m < 4; ++m) { bf16_t* rowp = base + (size_t)(row0 + ai * HALF + m * 16) * ldc + col0;
#pragma unroll
                for (int bj = 0; bj < 2; ++bj) { f32x4 v0 = acc[ai][bj][m][0] + bv[bj][0], v1 = acc[ai][bj][m][1] + bv[bj][1];
                    if (ACT == 1) { f32x2 a = gelu_pk((f32x2){v0[0], v0[1]}), b = gelu_pk((f32x2){v0[2], v0[3]}), c = gelu_pk((f32x2){v1[0], v1[1]}), d = gelu_pk((f32x2){v1[2], v1[3]});
                        v0 = (f32x4){a.x, a.y, b.x, b.y}; v1 = (f32x4){c.x, c.y, d.x, d.y}; }
                    v0 = v0 * sc; v1 = v1 * sc; u32x4 w; w.x = cvt_pk_bf16(v0[0], v0[1]); w.y = cvt_pk_bf16(v0[2], v0[3]); w.z = cvt_pk_bf16(v1[0], v1[1]); w.w = cvt_pk_bf16(v1[2], v1[3]);
                    *(u32x4*)(rowp + bj * HALF) = w; } }
    }
};
struct UnitX { int pm, pn; const char* A; const char* B; int e, nvalid, r0, pad; };
__device__ __forceinline__ float silu_f(float x) { return x * __builtin_amdgcn_rcpf(1.0f + __expf(-x)); }
__device__ __forceinline__ float swiglu_pre(float g, float u) { return (g * u) * __builtin_amdgcn_rcpf(1.0f + __builtin_amdgcn_exp2f(g)); }
template <bool XIN_BF16> struct EpiResid {
    static constexpr bool PERM = true, AFTER_DRAIN = false;
    const void* xin; bf16_t* xout; const float* gate; int gate_ld; int rows_per_batch; int ldc; int pad;
    __device__ __forceinline__ void operator()(const f32x4 (&acc)[2][2][4][2], const UnitX& u, int wr, int wc, int fr, int fq) const {
        const int row0 = u.pm * BM + wr * 64 + fr, col0 = u.pn * BM + wc * 32 + 8 * fq;
        const int b = (u.pm * BM) / rows_per_batch;
        f32x4 gv[2][2];
#pragma unroll
        for (int bj = 0; bj < 2; ++bj)
#pragma unroll
            for (int n = 0; n < 2; ++n) gv[bj][n] = *(const f32x4*)(gate + (size_t)b * gate_ld + col0 + bj * HALF + 4 * n);
#pragma unroll
        for (int ai = 0; ai < 2; ++ai)
#pragma unroll
            for (int m = 0; m < 4; ++m) { const int row = row0 + ai * HALF + m * 16; const size_t off = (size_t)row * ldc + col0;
#pragma unroll
                for (int bj = 0; bj < 2; ++bj) {
                    f32x4 x0, x1;
                    if constexpr (XIN_BF16) { const u32x4 xw = *(const u32x4*)((const bf16_t*)xin + off + bj * HALF);
                        x0 = (f32x4){__uint_as_float(xw.x << 16), __uint_as_float(xw.x & 0xffff0000u), __uint_as_float(xw.y << 16), __uint_as_float(xw.y & 0xffff0000u)};
                        x1 = (f32x4){__uint_as_float(xw.z << 16), __uint_as_float(xw.z & 0xffff0000u), __uint_as_float(xw.w << 16), __uint_as_float(xw.w & 0xffff0000u)}; }
                    else { x0 = *(const f32x4*)((const float*)xin + off + bj * HALF); x1 = *(const f32x4*)((const float*)xin + off + bj * HALF + 4); }
                    const f32x4 y0 = x0 + gv[bj][0] * acc[ai][bj][m][0], y1 = x1 + gv[bj][1] * acc[ai][bj][m][1];
                    u32x4 w; w.x = cvt_pk_bf16(y0[0], y0[1]); w.y = cvt_pk_bf16(y0[2], y0[3]); w.z = cvt_pk_bf16(y1[0], y1[1]); w.w = cvt_pk_bf16(y1[2], y1[3]);
                    *(u32x4*)(xout + off + bj * HALF) = w; } }
    }
};
struct EpiSwiglu {
    static constexpr bool PERM = true, AFTER_DRAIN = false;
    bf16_t* O; int ldc; int pad;
    __device__ __forceinline__ void operator()(const f32x4 (&acc)[2][2][4][2], const UnitX& u, int wr, int wc, int fr, int fq) const {
        const int row0 = u.pm * BM + wr * 64 + fr, col0 = u.pn * HALF + wc * 32 + 8 * fq;
#pragma unroll
        for (int ai = 0; ai < 2; ++ai)
#pragma unroll
            for (int m = 0; m < 4; ++m) { bf16_t* rowp = O + (size_t)(row0 + ai * HALF + m * 16) * ldc + col0;
                const f32x4 g0 = acc[ai][0][m][0], g1 = acc[ai][0][m][1], u0 = acc[ai][1][m][0], u1 = acc[ai][1][m][1];
                u32x4 w;
                w.x = cvt_pk_bf16(swiglu_pre(g0[0], u0[0]), swiglu_pre(g0[1], u0[1])); w.y = cvt_pk_bf16(swiglu_pre(g0[2], u0[2]), swiglu_pre(g0[3], u0[3]));
                w.z = cvt_pk_bf16(swiglu_pre(g1[0], u1[0]), swiglu_pre(g1[1], u1[1])); w.w = cvt_pk_bf16(swiglu_pre(g1[2], u1[2]), swiglu_pre(g1[3], u1[3]));
                *(u32x4*)rowp = w; }
    }
};
struct EpiStore {
    static constexpr bool PERM = true, AFTER_DRAIN = false;
    bf16_t* O; long ldc; int scale_cols; float scale;
    __device__ __forceinline__ void operator()(const f32x4 (&acc)[2][2][4][2], const UnitX& u, int wr, int wc, int fr, int fq) const {
        const int row0 = u.pm * BM + wr * 64 + fr, col0 = u.pn * BM + wc * 32 + 8 * fq;
        const bool scaled = (u.pn * BM < scale_cols); const float sc = scale;
#pragma unroll
        for (int ai = 0; ai < 2; ++ai)
#pragma unroll
            for (int m = 0; m < 4; ++m) { bf16_t* rowp = O + (size_t)(row0 + ai * HALF + m * 16) * ldc + col0;
#pragma unroll
                for (int bj = 0; bj < 2; ++bj) { f32x4 v0 = acc[ai][bj][m][0], v1 = acc[ai][bj][m][1]; if (scaled) { v0 = v0 * sc; v1 = v1 * sc; } u32x4 w;
                    w.x = cvt_pk_bf16(v0[0], v0[1]); w.y = cvt_pk_bf16(v0[2], v0[3]); w.z = cvt_pk_bf16(v1[0], v1[1]); w.w = cvt_pk_bf16(v1[2], v1[3]);
                    *(u32x4*)(rowp + bj * HALF) = w; } }
    }
};
struct EpiMoeDown {
    static constexpr bool PERM = true, AFTER_DRAIN = false;
    bf16_t* Y; const int* list; long cap;
    __device__ __forceinline__ void operator()(const f32x4 (&acc)[2][2][4][2], const UnitX& u, int wr, int wc, int fr, int fq) const {
        const int col0 = u.pn * BM + wc * 32 + 8 * fq;
        const int* lp = list + (size_t)u.e * cap + u.r0;
#pragma unroll
        for (int ai = 0; ai < 2; ++ai)
#pragma unroll
            for (int m = 0; m < 4; ++m) { const int r = ai * HALF + wr * 64 + m * 16 + fr;
                if (r < u.nvalid) { const int entry = lp[r]; bf16_t* rowp = Y + (size_t)entry * 1024 + col0;
#pragma unroll
                    for (int bj = 0; bj < 2; ++bj) { const f32x4 v0 = acc[ai][bj][m][0], v1 = acc[ai][bj][m][1]; u32x4 w;
                        w.x = cvt_pk_bf16(v0[0], v0[1]); w.y = cvt_pk_bf16(v0[2], v0[3]); w.z = cvt_pk_bf16(v1[0], v1[1]); w.w = cvt_pk_bf16(v1[2], v1[3]);
                        *(u32x4*)(rowp + bj * HALF) = w; } } }
    }
};
struct SchedPlain {
    const char* A; const char* Bt; int K; StaticOrder so;
    __device__ __forceinline__ void init(const void* A_, const void* Bt_, int M, int N, int K_, int G, int c) { A = (const char*)A_; Bt = (const char*)Bt_; K = K_; so.init(M, N, G, c); }
    __device__ __forceinline__ bool next(int i, UnitX& u) const { Unit t; if (!so.next(i, t)) return false; u.pm = t.pm; u.pn = t.pn; u.A = A + (size_t)t.pm * BM * K * 2; u.B = Bt + (size_t)t.pn * BM * K * 2; u.e = 0; u.nvalid = BM; u.r0 = 0; u.pad = 0; return true; }
};
struct SchedMoe {
    const char* A; const char* W; size_t wstride; const int* list; long cap; const PG8_LAS int* tab; int t0, K, gather, ovf_at, ovf_tile0, mode, nd, rounds; StaticOrder so;
    static constexpr int ND_DROP = 3;
    __device__ __forceinline__ bool deal(int i, Unit& t) const {
        if (mode == 0) return so.next(i, t);
        if (mode == 2) { if (i != 0 || so.c >= nd) return false; t.pm = ovf_at + (so.c >> 2); t.pn = so.c & 3; return true; }
        if (so.c < nd) return i < rounds - ND_DROP ? so.next(i, t) : false;
        if (i < rounds) return so.next(i, t);
        const int j = so.c - nd; if (i != rounds || j >= ND_DROP * nd) return false;
        StaticOrder o2 = so; o2.c = j % nd; return o2.next(rounds - ND_DROP + j / nd, t);
    }
    __device__ __forceinline__ bool next(int i, UnitX& u) const {
        Unit t; if (!deal(i, t)) return false;
        const int tile = t.pm < ovf_at ? t0 + t.pm : ovf_tile0 + (t.pm - ovf_at); int e = 0;
#pragma unroll
        for (int j = 1; j < 8; ++j) e += (tile >= tab[j]) ? 1 : 0;
        const int tse = tab[e], ce = tab[16 + e];
        u.pm = t.pm; u.pn = t.pn; u.e = e; u.r0 = (tile - tse) * BM; u.nvalid = ce - u.r0 < BM ? ce - u.r0 : BM; u.pad = 0;
        u.A = gather ? A : A + (size_t)t.pm * BM * K * 2; u.B = W + (size_t)e * wstride + (size_t)t.pn * BM * K * 2; return true;
    }
    __device__ __forceinline__ void a_tok_async(const UnitX& u, const int (&R)[2], int (&tok)[2][2]) const {
        const int* lp = list + (size_t)u.e * cap + u.r0;
#pragma unroll
        for (int h = 0; h < 2; ++h)
#pragma unroll
            for (int i = 0; i < 2; ++i) { const int r = h * HALF + R[i]; const int* ap = lp + (r < u.nvalid ? r : u.nvalid - 1);
                asm volatile("global_load_dword %0, %1, off" : "=v"(tok[h][i]) : "v"(ap) : "memory"); }
    }
    __device__ __forceinline__ void a_off(const UnitX& u, const int (&R)[2], const int (&C2)[2], unsigned (&go)[2][2]) const {
        const int* lp = list + (size_t)u.e * cap + u.r0; int tok[2][2];
#pragma unroll
        for (int h = 0; h < 2; ++h)
#pragma unroll
            for (int i = 0; i < 2; ++i) { const int r = h * HALF + R[i]; tok[h][i] = lp[r < u.nvalid ? r : u.nvalid - 1] >> 1; }
#pragma unroll
        for (int h = 0; h < 2; ++h)
#pragma unroll
            for (int i = 0; i < 2; ++i) go[h][i] = (unsigned)tok[h][i] * (unsigned)(K * 2) + (unsigned)C2[i];
    }
};
template <class Epi, class Sched, bool GATHER, bool ALIGN_EPI = true>
__device__ __forceinline__ void gphase(PG8_LAS unsigned char* lds, const int K, const Sched& S, const Epi& E, const int wid, const int lane) {
    const int tid = wid * 64 + lane, wr = wid >> 2, wc = wid & 3, fr = lane & 15, fq = lane >> 4;
    const int nt = K / BK;
    unsigned voffB[2]; int RA[2], CA2[2];
#pragma unroll
    for (int i = 0; i < 2; ++i) { int R, C; stage_rc(tid * 16 + i * 8192, R, C); const int Rb = Epi::PERM ? ((R & ~31) + perm32(R & 31)) : R;
        RA[i] = R; CA2[i] = C * 2; voffB[i] = (unsigned)(Rb * K + C) * 2u; }
    const size_t kstep = (size_t)(BK * 2);
    const size_t hstep = (size_t)HALF * K * 2;
    const unsigned ldsw = (unsigned)wid * 1024u;
    const int aoff = lds_byte(wr * 64 + fr, fq * 8), boff = lds_byte(wc * 32 + fr, fq * 8);
#define PG8_SA(b, h) (((b) * 2 + (h)) * HTB)
#define PG8_SB(b, h) ((4 + (b) * 2 + (h)) * HTB)
#define PG8_STAGE(bufoff, gbase, voff) do { _Pragma("unroll") for (int _i = 0; _i < 2; ++_i) \
        __builtin_amdgcn_global_load_lds((const unsigned*)((const char*)(gbase) + (voff)[_i]), (PG8_LAS unsigned*)(lds + (bufoff) + ldsw + _i * 8192), 16, 0, 0); } while (0)
#define PG8_LDA(dst, b, h) do { _Pragma("unroll") for (int m = 0; m < 4; ++m) _Pragma("unroll") for (int k = 0; k < 2; ++k) dst[m][k] = *(const PG8_LAS bf16x8*)(lds + PG8_SA(b, h) + aoff + m * 2048 + k * 1024); } while (0)
#define PG8_LDB(dst, b, h) do { _Pragma("unroll") for (int n = 0; n < 2; ++n) _Pragma("unroll") for (int k = 0; k < 2; ++k) dst[n][k] = *(const PG8_LAS bf16x8*)(lds + PG8_SB(b, h) + boff + n * 2048 + k * 1024); } while (0)
#define PG8_MMA(ai, bj, At, Bt) do { __builtin_amdgcn_s_setprio(1); _Pragma("unroll") for (int m = 0; m < 4; ++m) _Pragma("unroll") for (int n = 0; n < 2; ++n) _Pragma("unroll") for (int k = 0; k < 2; ++k) \
        acc[ai][bj][m][n] = __builtin_amdgcn_mfma_f32_16x16x32_bf16(Bt[n][k], At[m][k], acc[ai][bj][m][n], 0, 0, 0); __builtin_amdgcn_s_setprio(0); } while (0)
#define PG8_WAIT_V(n) asm volatile("s_waitcnt vmcnt(" #n ")" ::: "memory")
#define PG8_WAIT_L(n) asm volatile("s_waitcnt lgkmcnt(" #n ")" ::: "memory")
#define PG8_BAR __builtin_amdgcn_s_barrier()
#define PG8_SCHED __builtin_amdgcn_sched_barrier(0)
    UnitX cur, nxt; int ui = 0;
    if (!S.next(0, cur)) return;
    unsigned goC[2][2], goN[2][2];
    if constexpr (GATHER) { S.a_off(cur, RA, CA2, goC); }
    else {
#pragma unroll
        for (int h = 0; h < 2; ++h)
#pragma unroll
            for (int i = 0; i < 2; ++i) goC[h][i] = (unsigned)(RA[i] * K * 2 + CA2[i]) + (unsigned)h * (unsigned)hstep; }
#pragma unroll
    for (int h = 0; h < 2; ++h)
#pragma unroll
        for (int i = 0; i < 2; ++i) goN[h][i] = goC[h][i];
    f32x4 acc[2][2][4][2];
#pragma unroll
    for (int a = 0; a < 2; ++a)
#pragma unroll
        for (int b = 0; b < 2; ++b)
#pragma unroll
            for (int m = 0; m < 4; ++m)
#pragma unroll
                for (int n = 0; n < 2; ++n) acc[a][b][m][n] = (f32x4){0.f, 0.f, 0.f, 0.f};
    bf16x8 At[4][2], B0[2][2], B1[2][2];
    const char* cA = cur.A; const char* cB = cur.B;
    PG8_STAGE(PG8_SB(0, 0), cB, voffB); PG8_STAGE(PG8_SB(0, 1), cB + hstep, voffB); PG8_STAGE(PG8_SA(0, 0), cA, goC[0]); PG8_STAGE(PG8_SA(0, 1), cA, goC[1]);
    if (wr == 1) PG8_BAR;
    PG8_WAIT_V(2); PG8_BAR;
    PG8_STAGE(PG8_SB(1, 0), cB + kstep, voffB); PG8_STAGE(PG8_SA(1, 0), cA + kstep, goC[0]); PG8_STAGE(PG8_SB(1, 1), cB + hstep + kstep, voffB);
    PG8_WAIT_V(6); PG8_BAR;
    for (;;) {
        const bool has_next = S.next(ui + 1, nxt);
        int tokN[2][2] = {{0, 0}, {0, 0}};
        if constexpr (GATHER) { if (has_next) S.a_tok_async(nxt, RA, tokN); }
        const char* nA = has_next ? nxt.A : cA; const char* nB = has_next ? nxt.B : cB;
        for (int t = 0; t < nt; t += 2) {
            const bool last = (t == nt - 2);
            const char* a1 = cA + (size_t)(t + 1) * kstep;
            const char* a2 = last ? nA : cA + (size_t)(t + 2) * kstep; const char* b2 = last ? nB : cB + (size_t)(t + 2) * kstep;
            const char* a3 = a2 + kstep; const char* b3 = b2 + kstep;
            unsigned g2[2][2];
#pragma unroll
            for (int h = 0; h < 2; ++h)
#pragma unroll
                for (int i = 0; i < 2; ++i) { if constexpr (GATHER) { asm volatile("" : "+v"(tokN[h][i])); goN[h][i] = (unsigned)(tokN[h][i] >> 1) * (unsigned)(K * 2) + (unsigned)CA2[i]; }
                    g2[h][i] = (GATHER && last && has_next) ? goN[h][i] : goC[h][i]; }
            PG8_LDB(B0, 0, 0); PG8_LDB(B1, 0, 1); PG8_SCHED; PG8_LDA(At, 0, 0); PG8_STAGE(PG8_SA(1, 1), a1, goC[1]);
            PG8_WAIT_V(8); PG8_WAIT_L(0); PG8_BAR; PG8_MMA(0, 0, At, B0); PG8_MMA(0, 1, At, B1); PG8_BAR; PG8_SCHED;
            PG8_LDA(At, 0, 1); PG8_STAGE(PG8_SB(0, 0), b2, voffB); PG8_STAGE(PG8_SB(0, 1), b2 + hstep, voffB); PG8_STAGE(PG8_SA(0, 0), a2, g2[0]);
            PG8_WAIT_V(8); PG8_WAIT_L(0); PG8_BAR; PG8_MMA(1, 0, At, B0); PG8_MMA(1, 1, At, B1); PG8_BAR; PG8_SCHED;
            PG8_LDB(B0, 1, 0); PG8_LDB(B1, 1, 1); PG8_SCHED; PG8_LDA(At, 1, 0); PG8_STAGE(PG8_SA(0, 1), a2, g2[1]);
            PG8_WAIT_V(8); PG8_WAIT_L(0); PG8_BAR; PG8_MMA(0, 0, At, B0); PG8_MMA(0, 1, At, B1); PG8_BAR; PG8_SCHED;
            PG8_LDA(At, 1, 1); PG8_STAGE(PG8_SB(1, 0), b3, voffB); PG8_STAGE(PG8_SB(1, 1), b3 + hstep, voffB); PG8_STAGE(PG8_SA(1, 0), a3, g2[0]);
            PG8_WAIT_V(8); PG8_WAIT_L(0); PG8_BAR; PG8_MMA(1, 0, At, B0); PG8_MMA(1, 1, At, B1); PG8_BAR; PG8_SCHED;
        }
        if constexpr (ALIGN_EPI) { if (wr == 0) PG8_BAR; }
        E(acc, cur, wr, wc, fr, fq);
        if (!has_next) break;
#pragma unroll
        for (int a = 0; a < 2; ++a)
#pragma unroll
            for (int b = 0; b < 2; ++b)
#pragma unroll
                for (int m = 0; m < 4; ++m)
#pragma unroll
                    for (int n = 0; n < 2; ++n) acc[a][b][m][n] = (f32x4){0.f, 0.f, 0.f, 0.f};
        cur = nxt; cA = nA; cB = nB; ++ui;
#pragma unroll
        for (int h = 0; h < 2; ++h)
#pragma unroll
            for (int i = 0; i < 2; ++i) goC[h][i] = goN[h][i];
        if constexpr (ALIGN_EPI) { if (wr == 1) PG8_BAR; }
    }
    PG8_WAIT_V(0);
    if constexpr (!ALIGN_EPI) { if (wr == 0) PG8_BAR; }
    PG8_BAR;
#undef PG8_SA
#undef PG8_SB
#undef PG8_STAGE
#undef PG8_LDA
#undef PG8_LDB
#undef PG8_MMA
#undef PG8_WAIT_V
#undef PG8_WAIT_L
#undef PG8_BAR
#undef PG8_SCHED
}
}
#define GAS __attribute__((address_space(1)))
#define LAS __attribute__((address_space(3)))
typedef unsigned short bf16;
typedef unsigned v4u __attribute__((ext_vector_type(4)));
typedef float f32x4 __attribute__((ext_vector_type(4)));
typedef short bf16x8 __attribute__((ext_vector_type(8)));
typedef GAS unsigned gu32;
typedef GAS unsigned long long gu64;
#define RLX_AGENT __ATOMIC_RELAXED, __HIP_MEMORY_SCOPE_AGENT
#define LDS_WAIT() asm volatile("s_waitcnt lgkmcnt(0)" ::: "memory")
#define VM_WAIT() asm volatile("s_waitcnt vmcnt(0)" ::: "memory")
__device__ __forceinline__ unsigned long long rt() { return __builtin_amdgcn_s_memrealtime(); }
__device__ __forceinline__ unsigned f2bf(float f) { unsigned u = __builtin_bit_cast(unsigned, f); return (u + 0x7fffu + ((u >> 16) & 1u)) >> 16; }
__device__ __forceinline__ unsigned pk2(float lo, float hi) { typedef float f2v_ __attribute__((ext_vector_type(2))); typedef __bf16 b2v_ __attribute__((ext_vector_type(2))); f2v_ v = {lo, hi}; b2v_ b = __builtin_convertvector(v, b2v_); return __builtin_bit_cast(unsigned, b); }

#define XB_TMO      128
#define XB_XCNT(j)  (256  + 64 * (j))
#define XB_XSUB(j)  (1280 + 64 * (j))
#define XB_XGEN(j)  (2304 + 64 * (j))
#define XB_TOP      3328
#define XB_TOPGEN   3392
#define XCD_BAR_WORDS 3456
#define XB_SPIN_CAP (1u << 18)

__device__ __forceinline__ unsigned xb_ld(unsigned* p)              { return __hip_atomic_load(p, __ATOMIC_RELAXED, __HIP_MEMORY_SCOPE_AGENT); }
__device__ __forceinline__ unsigned xb_add(unsigned* p, unsigned v) { return __hip_atomic_fetch_add(p, v, __ATOMIC_RELAXED, __HIP_MEMORY_SCOPE_AGENT); }
__device__ __forceinline__ unsigned xb_xcc_id() { return (unsigned)__builtin_amdgcn_s_getreg((3 << 11) | 20) & 0xFu; }
#define XB_SPIN(cond, bar) do { unsigned _sp = 0; while (cond) { __builtin_amdgcn_s_sleep(1); \
    if ((++_sp & 255u) == 0u) { if (xb_ld(&(bar)[XB_TMO])) break; if (_sp > XB_SPIN_CAP) { atomicAdd(&(bar)[XB_TMO], 1u); break; } } } } while (0)

__device__ __forceinline__ int mk_lane() { int l; asm volatile("v_mbcnt_lo_u32_b32 %0, -1, 0\n\tv_mbcnt_hi_u32_b32 %0, -1, %0" : "=v"(l)); return l; }
struct XcdBarrier {
    unsigned* bar; unsigned x; int wave;
    volatile LAS unsigned* st;
};

__device__ __forceinline__ XcdBarrier xcd_barrier_post(unsigned* bar, volatile LAS unsigned* st, int wave) {
    XcdBarrier b; b.bar = bar; b.x = xb_xcc_id(); b.st = st; b.wave = wave;
    if (wave == 0 && mk_lane() == 0) (void)xb_add(&bar[XB_XCNT(b.x)], 1u);
    return b;
}
__device__ __forceinline__ void xcd_barrier_complete(unsigned* bar, unsigned x, unsigned& nloc, unsigned& nx) {
    const unsigned G = gridDim.x * gridDim.y * gridDim.z;
    unsigned sum, cnt, mine, sp = 0u;
    for (;;) {
        sum = 0u; cnt = 0u; mine = 0u;
#pragma unroll
        for (unsigned j = 0; j < 16; ++j) { const unsigned c = xb_ld(&bar[XB_XCNT(j)]); sum += c; cnt += (c > 0u) ? 1u : 0u; mine = (j == x) ? c : mine; }
        if (sum == G) break;
        __builtin_amdgcn_s_sleep(1);
        if ((++sp & 255u) == 0u) { if (xb_ld(&bar[XB_TMO])) break; if (sp > XB_SPIN_CAP) { atomicAdd(&bar[XB_TMO], 1u); break; } }
    }
    nloc = mine > 0u ? mine : 1u; nx = cnt > 0u ? cnt : 1u;
}

__device__ __forceinline__ void xcd_barrier(const XcdBarrier& b) {
    asm volatile("s_waitcnt vmcnt(0)" ::: "memory");
    __syncthreads();
    if (b.wave == 0 && mk_lane() == 0) {
        unsigned* bar = b.bar;
        __builtin_amdgcn_s_waitcnt(0);
        unsigned nloc = b.st[0], nx = b.st[1];
        if (nloc == 0u) { xcd_barrier_complete(bar, b.x, nloc, nx); b.st[0] = nloc; b.st[1] = nx; }
        const unsigned old = xb_add(&bar[XB_XSUB(b.x)], 1u);
        const unsigned gen = old / nloc;
        if (old + 1u == (gen + 1u) * nloc) {
            __builtin_amdgcn_fence(__ATOMIC_RELEASE, "agent");
            asm volatile("s_waitcnt vmcnt(0)" ::: "memory");
            const unsigned og = xb_add(&bar[XB_TOP], 1u);
            const unsigned tg = og / nx;
            if (og + 1u == (tg + 1u) * nx) xb_add(&bar[XB_TOPGEN], 1u);
            else XB_SPIN(xb_ld(&bar[XB_TOPGEN]) == tg, bar);
            __builtin_amdgcn_fence(__ATOMIC_ACQUIRE, "agent");
            xb_add(&bar[XB_XGEN(b.x)], 1u);
            asm volatile("s_waitcnt vmcnt(0)" ::: "memory");
        } else {
            XB_SPIN(xb_ld(&bar[XB_XGEN(b.x)]) == gen, bar);
            __builtin_amdgcn_fence(__ATOMIC_ACQUIRE, "agent");
            asm volatile("s_waitcnt vmcnt(0)" ::: "memory");
        }
    }
    __syncthreads();
}
#ifndef MK_DIAG_SEL
#define MK_DIAG_SEL -1
#endif
#ifndef MK_DIAG_SCALE
#define MK_DIAG_SCALE 1e-5f
#endif
constexpr int NB = 8, SEQ = 4096, DM = 1024, MTOK = NB * SEQ;
constexpr int EVEN_IN = 2560, ODD_IN = 3072, FFD = 2816, FFE = 3584, NEXP = 8;
constexpr float EPS = 1e-6f;
constexpr size_t MiB = 1u << 20;
constexpr int NWAVES = 8;
constexpr size_t WS_CTL = 0, CTL_ZERO_BYTES = 1 * MiB;
constexpr size_t WS_MOD = 1 * MiB;
constexpr size_t WS_TOPW = 2 * MiB;
constexpr size_t WS_LIST = 3 * MiB;
constexpr size_t WS_WIN0 = 4 * MiB, WS_WOUT0 = 9 * MiB, WS_WGU0 = 11 * MiB, WS_WD0 = 22 * MiB, WS_WIN1 = 28 * MiB, WS_WOUT1 = 34 * MiB;
constexpr size_t WS_WMOE = 40 * MiB, WMOE_STRIDE = 21 * MiB, WMOE_D_OFF = 14 * MiB;
constexpr size_t WS_H = 208 * MiB;
constexpr size_t WS_PROJ = 272 * MiB;
constexpr size_t WS_MIX = 464 * MiB;
constexpr size_t WS_ACT = 272 * MiB;
constexpr size_t WS_XB = 510 * MiB;
constexpr size_t WS_END = 574 * MiB;
constexpr long LIST_CAP = 32768;
constexpr int MOE_CHUNK_TILES = 128;
constexpr int CW_BAR = 4096;
constexpr int CW_CNT = 8192;
constexpr int RING_BYTES = 131072, MISC_OFF = RING_BYTES, LDS_BYTES = 135168;

__device__ __forceinline__ float bf2f(bf16 v) { return __builtin_bit_cast(float, (unsigned)v << 16); }
__device__ __forceinline__ float wave_sum(float v) {
#pragma unroll
    for (int o = 1; o < 64; o <<= 1) v += __shfl_xor(v, o);
    return v;
}
__device__ __forceinline__ float logsig_f(float z) { return fminf(z, 0.f) - log1pf(expf(-fabsf(z))); }
__device__ __forceinline__ float sigmoid_f(float z) { return 1.0f / (1.0f + expf(-z)); }
__device__ __forceinline__ float gelu_tanh_f(float x) { const float t = tanhf(0.7978845608028654f * (x + 0.044715f * x * x * x)); return 0.5f * x * (1.0f + t); }

struct Frame {
    LAS unsigned char* lds; volatile LAS unsigned* MISC; gu32* ctl;
    int tid, lane, wave, G, gw, NGW;
    float* out; unsigned char* ws;
};
__device__ __forceinline__ const float* inp(const Frame& F, int i) {
    const unsigned long long v = ((const LAS unsigned long long*)(F.lds + MISC_OFF + 512))[i];
    const unsigned lo = __builtin_amdgcn_readfirstlane((unsigned)v), hi = __builtin_amdgcn_readfirstlane((unsigned)(v >> 32));
    return (const float*)(((unsigned long long)hi << 32) | lo);
}

typedef short v4i16p __attribute__((ext_vector_type(4)));
constexpr int TR_ROW = 288;
template <bool SCALED = false> __device__ __forceinline__ void transpose_item(const float* W, int N, int k0, int n0, bf16* dst, int ldk, LAS unsigned char* scr, int lane, float sc = 1.0f) {
    const int l32 = lane & 31, rh = lane >> 5;
    const GAS f32x4* src = (const GAS f32x4*)(W + (size_t)(k0 + rh) * N + n0) + l32;
    const size_t rs2 = (size_t)(N >> 1);
    {
        f32x4 v[16];
#pragma unroll
        for (int i = 0; i < 16; ++i) v[i] = src[(size_t)i * rs2];
#pragma unroll
        for (int i = 0; i < 16; ++i) { if constexpr (SCALED) v[i] = v[i] * sc; *(LAS unsigned long long*)(scr + (2 * i + rh) * TR_ROW + 8 * l32) = (unsigned long long)pk2(v[i].x, v[i].y) | ((unsigned long long)pk2(v[i].z, v[i].w) << 32); }
    }
    LDS_WAIT(); asm volatile("" ::: "memory");
    const int kc = lane >> 4, li = lane & 15, q = li >> 2, p = li & 3;
    LAS unsigned char* rb = scr + (8 * kc + q) * TR_ROW + 8 * p;
#pragma unroll
    for (int j = 0; j < 8; ++j) {
        const v4i16p lo = __builtin_amdgcn_ds_read_tr16_b64_v4i16((LAS v4i16p*)(rb + 32 * j)), hi = __builtin_amdgcn_ds_read_tr16_b64_v4i16((LAS v4i16p*)(rb + 4 * TR_ROW + 32 * j));
        v4u o; o.x = (unsigned)(unsigned short)lo[0] | ((unsigned)(unsigned short)lo[1] << 16); o.y = (unsigned)(unsigned short)lo[2] | ((unsigned)(unsigned short)lo[3] << 16);
        o.z = (unsigned)(unsigned short)hi[0] | ((unsigned)(unsigned short)hi[1] << 16); o.w = (unsigned)(unsigned short)hi[2] | ((unsigned)(unsigned short)hi[3] << 16);
        *(GAS v4u*)(dst + (size_t)(16 * j + li) * ldk + k0 + 8 * kc) = o; }
    LDS_WAIT(); asm volatile("" ::: "memory");
}
__device__ __forceinline__ bool tr_plain(int& r, const float* W, int K, int N, bf16* Wt, LAS unsigned char* scr, int lane) {
    const int nblk = N / 128, items = (K / 32) * nblk;
    if (r >= items) { r -= items; return false; }
    const int kb = r / nblk, nb = r % nblk;
    transpose_item(W, N, 32 * kb, 128 * nb, Wt + (size_t)(128 * nb) * K, K, scr, lane); return true;
}
__device__ __forceinline__ bool tr_gu(int& r, const float* Wg, const float* Wu, int K, int F, bf16* Wt, LAS unsigned char* scr, int lane) {
    const int nblk = F / 128, items = (K / 32) * nblk;
    if (r >= 2 * items) { r -= 2 * items; return false; }
    const int up = r >= items ? 1 : 0; const int q = r - up * items; const int kb = q / nblk, nb = q % nblk;
    transpose_item<true>(up ? Wu : Wg, F, 32 * kb, 128 * nb, Wt + (size_t)(256 * nb + 128 * up) * K, K, scr, lane, up ? -0.6931471805599453f : -1.4426950408889634f); return true;
}
__device__ __forceinline__ void p_prologue(Frame& F) {
    LAS float* cond = (LAS float*)F.lds;
    const float* cin = inp(F, 1);
    for (int i = F.tid; i < NB * DM; i += 512) { const float c = cin[i]; cond[i] = c / (1.0f + expf(-c)); }
    __syncthreads();
    float* mod = (float*)(F.ws + WS_MOD);
    const float* ada_w = inp(F, 3); const float* ada_b = inp(F, 4);
    for (int it = F.gw; it < 768; it += F.NGW) {
        const int layer = it / 384, j0 = (it % 384) * 16, cj = F.lane & 15, kp = F.lane >> 4;
        float acc[NB];
#pragma unroll
        for (int b = 0; b < NB; ++b) acc[b] = 0.f;
        const float* wp = ada_w + (size_t)layer * DM * 6144 + j0 + cj;
#pragma unroll 16
        for (int k = kp; k < DM; k += 4) { const float w = wp[(size_t)k * 6144];
#pragma unroll
            for (int b = 0; b < NB; ++b) acc[b] += cond[b * DM + k] * w; }
#pragma unroll
        for (int b = 0; b < NB; ++b) { acc[b] += __shfl_xor(acc[b], 16); acc[b] += __shfl_xor(acc[b], 32); }
        if (kp == 0) {
            const float bias = ada_b[layer * 6144 + j0 + cj];
#pragma unroll
            for (int b = 0; b < NB; ++b) mod[(size_t)(layer * NB + b) * 6144 + j0 + cj] = acc[b] + bias; }
    }
    __syncthreads();
    LAS unsigned char* scr = F.lds + F.wave * 16384;
    constexpr int ITEMS_MOE_E = 3 * (DM / 32) * (FFE / 128);
    constexpr int ITEMS_FIX = (DM / 32) * (EVEN_IN / 128) + (DM / 32) * (DM / 128) + 2 * (DM / 32) * (FFD / 128) + (FFD / 32) * (DM / 128) + (DM / 32) * (ODD_IN / 128) + (DM / 32) * (DM / 128);
    constexpr int NITEMS = ITEMS_FIX + NEXP * ITEMS_MOE_E;
    unsigned char* ws = F.ws;
    for (int it = F.gw; it < NITEMS; it += F.NGW) {
        int r = it;
        if (tr_plain(r, inp(F, 8), DM, EVEN_IN, (bf16*)(ws + WS_WIN0), scr, F.lane)) continue;
        if (tr_plain(r, inp(F, 9), DM, DM, (bf16*)(ws + WS_WOUT0), scr, F.lane)) continue;
        if (tr_gu(r, inp(F, 17), inp(F, 18), DM, FFD, (bf16*)(ws + WS_WGU0), scr, F.lane)) continue;
        if (tr_plain(r, inp(F, 19), FFD, DM, (bf16*)(ws + WS_WD0), scr, F.lane)) continue;
        if (tr_plain(r, inp(F, 20), DM, ODD_IN, (bf16*)(ws + WS_WIN1), scr, F.lane)) continue;
        if (tr_plain(r, inp(F, 21), DM, DM, (bf16*)(ws + WS_WOUT1), scr, F.lane)) continue;
        const int e = r / ITEMS_MOE_E; r -= e * ITEMS_MOE_E;
        unsigned char* we = ws + WS_WMOE + (size_t)e * WMOE_STRIDE;
        if (tr_gu(r, inp(F, 29) + (size_t)e * DM * FFE, inp(F, 30) + (size_t)e * DM * FFE, DM, FFE, (bf16*)we, scr, F.lane)) continue;
        tr_plain(r, inp(F, 31) + (size_t)e * FFE * DM, FFE, DM, (bf16*)(we + WMOE_D_OFF), scr, F.lane);
    }
}

__device__ __forceinline__ f32x4 bf4_to_f32(unsigned long long w) { return (f32x4){__uint_as_float((unsigned)w << 16), __uint_as_float((unsigned)w & 0xffff0000u), __uint_as_float((unsigned)(w >> 32) << 16), __uint_as_float((unsigned)(w >> 32) & 0xffff0000u)}; }
template <bool X_BF16> __device__ __forceinline__ void p_norm_mod(Frame& F, const void* X, bf16* H, const float* ln, const float* modl, int sh_off, int sc_off) {
    for (int m = F.gw; m < MTOK; m += F.NGW) {
        const int b = m / SEQ;
        const GAS f32x4* xr = (const GAS f32x4*)((const float*)X + (size_t)m * DM) + F.lane;
        const GAS unsigned long long* xb8 = (const GAS unsigned long long*)((const bf16*)X + (size_t)m * DM) + F.lane;
        f32x4 v[4]; float ss = 0.f;
#pragma unroll
        for (int j = 0; j < 4; ++j) { if constexpr (X_BF16) v[j] = bf4_to_f32(xb8[64 * j]); else v[j] = xr[64 * j]; ss += (v[j].x * v[j].x + v[j].y * v[j].y) + (v[j].z * v[j].z + v[j].w * v[j].w); }
        const float rstd = 1.0f / sqrtf(wave_sum(ss) * (1.f / DM) + EPS);
        GAS unsigned long long* o8 = (GAS unsigned long long*)(H + (size_t)m * DM) + F.lane;
#pragma unroll
        for (int j = 0; j < 4; ++j) { const int col = 4 * F.lane + 256 * j;
            const f32x4 g = *(const GAS f32x4*)(ln + col), sc = *(const GAS f32x4*)(modl + (size_t)b * 6144 + sc_off + col), sh = *(const GAS f32x4*)(modl + (size_t)b * 6144 + sh_off + col);
            const f32x4 h = v[j] * rstd * g * (sc + 1.0f) + sh;
            o8[64 * j] = (unsigned long long)pk2(h.x, h.y) | ((unsigned long long)pk2(h.z, h.w) << 32); }
    }
}
__device__ __forceinline__ void p_router(Frame& F, const bf16* X, bf16* H, const float* ln, const float* modl, int sh_off, int sc_off) {
    LAS float* rws = (LAS float*)F.lds;
    LAS int* sel = (LAS int*)(F.lds + 32768);
    const float* rw = inp(F, 27); const float* rb = inp(F, 28);
    float* topw = (float*)(F.ws + WS_TOPW); int* list = (int*)(F.ws + WS_LIST);
    for (int i = F.tid; i < DM * NEXP; i += 512) rws[i] = rw[i];
    __syncthreads();
    for (int chunk = blockIdx.x; chunk < MTOK / 128; chunk += F.G) {
        for (int i = 0; i < 16; ++i) {
            const int lt = F.wave * 16 + i, m = chunk * 128 + lt, b = m / SEQ;
            const GAS unsigned long long* xb8 = (const GAS unsigned long long*)(X + (size_t)m * DM) + F.lane;
            f32x4 v[4]; float ss = 0.f;
#pragma unroll
            for (int j = 0; j < 4; ++j) { v[j] = bf4_to_f32(xb8[64 * j]); ss += (v[j].x * v[j].x + v[j].y * v[j].y) + (v[j].z * v[j].z + v[j].w * v[j].w); }
            const float rstd = 1.0f / sqrtf(wave_sum(ss) * (1.f / DM) + EPS);
            GAS unsigned long long* o8 = (GAS unsigned long long*)(H + (size_t)m * DM) + F.lane;
            float lg[NEXP];
#pragma unroll
            for (int e = 0; e < NEXP; ++e) lg[e] = 0.f;
#pragma unroll
            for (int j = 0; j < 4; ++j) { const int col = 4 * F.lane + 256 * j;
                const f32x4 g = *(const GAS f32x4*)(ln + col), sc = *(const GAS f32x4*)(modl + (size_t)b * 6144 + sc_off + col), sh = *(const GAS f32x4*)(modl + (size_t)b * 6144 + sh_off + col);
                const f32x4 h = v[j] * rstd * g * (sc + 1.0f) + sh;
                o8[64 * j] = (unsigned long long)pk2(h.x, h.y) | ((unsigned long long)pk2(h.z, h.w) << 32);
#pragma unroll
                for (int q = 0; q < 4; ++q) { const f32x4 w0 = *(const LAS f32x4*)(rws + (col + q) * 8), w1 = *(const LAS f32x4*)(rws + (col + q) * 8 + 4); const float hv = h[q];
                    lg[0] += hv * w0.x; lg[1] += hv * w0.y; lg[2] += hv * w0.z; lg[3] += hv * w0.w; lg[4] += hv * w1.x; lg[5] += hv * w1.y; lg[6] += hv * w1.z; lg[7] += hv * w1.w; } }
#pragma unroll
            for (int e = 0; e < NEXP; ++e) lg[e] = wave_sum(lg[e]) + rb[e];
            int i0 = 0; float v0 = lg[0];
#pragma unroll
            for (int e = 1; e < NEXP; ++e) if (lg[e] > v0) { v0 = lg[e]; i0 = e; }
            int i1 = (i0 == 0) ? 1 : 0; float v1 = (i0 == 0) ? lg[1] : lg[0];
#pragma unroll
            for (int e = 1; e < NEXP; ++e) if (e != i0 && lg[e] > v1) { v1 = lg[e]; i1 = e; }
            const float w0 = 1.0f / (1.0f + expf(v1 - v0)), w1 = 1.0f - w0;
            if (F.lane == 0) { sel[2 * lt] = i0; sel[2 * lt + 1] = i1; topw[(size_t)m * 2] = w0; topw[(size_t)m * 2 + 1] = w1; }
        }
        __syncthreads();
        {
            const int e = F.wave; bool mt[4]; int rk[4]; int total = 0;
#pragma unroll
            for (int r = 0; r < 4; ++r) { mt[r] = (sel[r * 64 + F.lane] == e); const unsigned long long mask = __ballot(mt[r]);
                rk[r] = total + __popcll(mask & ((1ull << F.lane) - 1ull)); total += __popcll(mask); }
            int base = 0;
            if (F.lane == 0 && total > 0) base = (int)__hip_atomic_fetch_add((unsigned*)(F.ctl + CW_CNT + 64 * e), (unsigned)total, RLX_AGENT);
            base = __builtin_amdgcn_readfirstlane(base);
#pragma unroll
            for (int r = 0; r < 4; ++r) if (mt[r]) list[(size_t)e * LIST_CAP + base + rk[r]] = (chunk * 128) * 2 + r * 64 + F.lane;
        }
        __syncthreads();
    }
}
__device__ __forceinline__ void p_final(Frame& F, const bf16* XB, const float* gate, const float* ln) {
    const float* topw = (const float*)(F.ws + WS_TOPW);
    for (int m = F.gw; m < MTOK; m += F.NGW) {
        const int b = m / SEQ;
        const GAS unsigned long long* x8 = (const GAS unsigned long long*)(XB + (size_t)m * DM) + F.lane;
        const GAS unsigned long long* y0 = (const GAS unsigned long long*)((const bf16*)F.out + (size_t)(2 * m) * DM) + F.lane;
        const GAS unsigned long long* y1 = (const GAS unsigned long long*)((const bf16*)F.out + (size_t)(2 * m + 1) * DM) + F.lane;
        const float w0 = topw[(size_t)m * 2], w1 = topw[(size_t)m * 2 + 1];
        f32x4 v[4]; float ss = 0.f;
#pragma unroll
        for (int j = 0; j < 4; ++j) { const unsigned long long xa = x8[64 * j], ya = y0[64 * j], yb = y1[64 * j];
            const f32x4 g = *(const GAS f32x4*)(gate + (size_t)b * 6144 + 4 * F.lane + 256 * j);
            f32x4 xv, y0v, y1v;
            xv.x = bf2f((bf16)(xa & 0xffff)); xv.y = bf2f((bf16)((xa >> 16) & 0xffff)); xv.z = bf2f((bf16)((xa >> 32) & 0xffff)); xv.w = bf2f((bf16)(xa >> 48));
            y0v.x = bf2f((bf16)(ya & 0xffff)); y0v.y = bf2f((bf16)((ya >> 16) & 0xffff)); y0v.z = bf2f((bf16)((ya >> 32) & 0xffff)); y0v.w = bf2f((bf16)(ya >> 48));
            y1v.x = bf2f((bf16)(yb & 0xffff)); y1v.y = bf2f((bf16)((yb >> 16) & 0xffff)); y1v.z = bf2f((bf16)((yb >> 32) & 0xffff)); y1v.w = bf2f((bf16)(yb >> 48));
            v[j] = xv + g * (y0v * w0 + y1v * w1);
            ss += (v[j].x * v[j].x + v[j].y * v[j].y) + (v[j].z * v[j].z + v[j].w * v[j].w); }
        float rstd = 1.0f / sqrtf(wave_sum(ss) * (1.f / DM) + EPS);
#if MK_DIAG_SEL >= 0
        rstd *= 1.0f + ((const float*)(F.ws + WS_CTL + 65536))[MK_DIAG_SEL] * MK_DIAG_SCALE;
#endif
        asm volatile("" ::: "memory");
        GAS f32x4* orow = (GAS f32x4*)(F.out + (size_t)m * DM) + F.lane;
#pragma unroll
        for (int j = 0; j < 4; ++j) { const f32x4 g = *(const GAS f32x4*)(ln + 4 * F.lane + 256 * j); orow[64 * j] = v[j] * rstd * g; }
    }
}

__device__ __forceinline__ void p_sb_naive(Frame& F, const bf16* proj, bf16* mix) {
    for (int w = blockIdx.x * 7 + (F.wave - 1); w < NB * 8 * SEQ; w += F.G * 7) {
        const int t = w % SEQ, bh = w / SEQ, h = bh % 8, b = bh / 8;
        const size_t row = (size_t)b * SEQ + t;
        const float q = bf2f(proj[row * EVEN_IN + h * 64 + F.lane]);
        float acc = 0.f, later = 0.f;
        for (int s = t - 1; s >= 0; --s) {
            const size_t kr = ((size_t)b * SEQ + s) * EVEN_IN;
            const float kk = bf2f(proj[kr + 512 + h * 64 + F.lane]), vv = bf2f(proj[kr + 1024 + h * 64 + F.lane]);
            const float z = wave_sum(q * kk) * 0.125f;
            const float lp = logsig_f(z), ln_ = lp - z;
            acc += expf(lp + later) * vv; later += ln_;
            if (later < -110.f) break;
        }
        mix[row * DM + h * 64 + F.lane] = (bf16)f2bf(acc);
    }
}
__device__ __forceinline__ void p_lru_naive_wave(Frame& F, int unit, const bf16* proj, bf16* mix) {
    LAS float* wa = (LAS float*)F.lds; LAS float* wx = wa + 4096; LAS float* xcs = wx + 4096;
    const float* conv_w = inp(F, 10); const float* conv_b = inp(F, 11); const float* ga_w = inp(F, 12); const float* ga_b = inp(F, 13); const float* gx_w = inp(F, 14); const float* gx_b = inp(F, 15); const float* lam = inp(F, 16);
    const int b = unit / 8, g = unit % 8, j = F.lane, c = g * 64 + j;
    for (int i = j; i < 4096; i += 64) { wa[i] = ga_w[g * 4096 + i]; wx[i] = gx_w[g * 4096 + i]; }
    const float cw0 = conv_w[c], cw1 = conv_w[512 + c], cw2 = conv_w[1024 + c], cw3 = conv_w[1536 + c], cb = conv_b[c], ba = ga_b[c], bx = gx_b[c], lsl = logsig_f(lam[c]);
    float x1 = 0.f, x2 = 0.f, x3 = 0.f, hs = 0.f;
    LDS_WAIT();
    for (int t = 0; t < SEQ; ++t) {
        const size_t row = (size_t)b * SEQ + t;
        const float xb = bf2f(proj[row * EVEN_IN + 1536 + c]), gb = bf2f(proj[row * EVEN_IN + 2048 + c]);
        const float xc = cw0 * x3 + cw1 * x2 + cw2 * x1 + cw3 * xb + cb; x3 = x2; x2 = x1; x1 = xb;
        xcs[j] = xc; LDS_WAIT(); asm volatile("" ::: "memory");
        float ra = ba, rx = bx;
#pragma unroll 8
        for (int i = 0; i < 64; ++i) { const float xi = xcs[i]; ra += xi * wa[i * 64 + j]; rx += xi * wx[i * 64 + j]; }
        LDS_WAIT(); asm volatile("" ::: "memory");
        const float r = sigmoid_f(ra), ig = sigmoid_f(rx), log_a = 8.0f * r * lsl, aa = expf(log_a), u = sqrtf(-expm1f(2.0f * log_a)) * (ig * xc);
        hs = aa * hs + u;
        mix[row * DM + 512 + c] = (bf16)f2bf(hs * gelu_tanh_f(gb));
    }
}
__device__ __forceinline__ void p_diff_naive(Frame& F, const bf16* proj, bf16* o, float lambda_init) {
    LAS float* lut = (LAS float*)F.lds; LAS float* lam_s = lut + 132;
    const float* rel_bias = inp(F, 2); const float* lq1 = inp(F, 22); const float* lk1 = inp(F, 23); const float* lq2 = inp(F, 24); const float* lk2 = inp(F, 25); const float* subln = inp(F, 26);
    int k = 0;
    for (int u = blockIdx.x; u < NB * 8 * 32; u += F.G, ++k) {
        const int bh = u / 32, h = bh % 8, b = bh / 8; int tile = u % 32; if (k & 1) tile = 31 - tile;
        const int qi = F.tid >> 2, part = F.tid & 3, t = tile * 128 + qi;
        __syncthreads();
        if (F.tid < 129) { const int n = F.tid; int bk;
            if (n < 16) bk = n; else bk = 16 + (n >= 19) + (n >= 21) + (n >= 24) + (n >= 27) + (n >= 31) + (n >= 35) + (n >= 40) + (n >= 46) + (n >= 52) + (n >= 59) + (n >= 67) + (n >= 77) + (n >= 87) + (n >= 99) + (n >= 113);
            lut[n] = rel_bias[bk * 8 + h]; }
        if (F.tid == 0) { float s1 = 0.f, s2 = 0.f; for (int i = 0; i < 64; ++i) { s1 += lq1[i] * lk1[i]; s2 += lq2[i] * lk2[i]; } lam_s[0] = expf(s1) - expf(s2) + lambda_init; }
        __syncthreads();
        const float lam = lam_s[0];
        const size_t row = (size_t)b * SEQ + t;
        float q1[16], q2[16], a1[32], a2[32];
#pragma unroll
        for (int i = 0; i < 16; ++i) { q1[i] = bf2f(proj[row * ODD_IN + (2 * h) * 64 + part * 16 + i]); q2[i] = bf2f(proj[row * ODD_IN + (2 * h + 1) * 64 + part * 16 + i]); }
#pragma unroll
        for (int i = 0; i < 32; ++i) { a1[i] = 0.f; a2[i] = 0.f; }
        float m1 = -INFINITY, m2 = -INFINITY, l1 = 0.f, l2 = 0.f;
        const int tmax = tile * 128 + 127;
        for (int s = 0; s <= tmax; ++s) {
            const bf16* kr = proj + ((size_t)b * SEQ + s) * ODD_IN;
            const bf16x8 ka = *(const bf16x8*)(kr + 1024 + (2 * h) * 64 + part * 16), kb = *(const bf16x8*)(kr + 1024 + (2 * h) * 64 + part * 16 + 8);
            const bf16x8 kc = *(const bf16x8*)(kr + 1024 + (2 * h + 1) * 64 + part * 16), kd = *(const bf16x8*)(kr + 1024 + (2 * h + 1) * 64 + part * 16 + 8);
            float d1 = 0.f, d2 = 0.f;
#pragma unroll
            for (int i = 0; i < 8; ++i) { d1 += q1[i] * bf2f((bf16)ka[i]) + q1[8 + i] * bf2f((bf16)kb[i]); d2 += q2[i] * bf2f((bf16)kc[i]) + q2[8 + i] * bf2f((bf16)kd[i]); }
            d1 += __shfl_xor(d1, 1); d1 += __shfl_xor(d1, 2); d2 += __shfl_xor(d2, 1); d2 += __shfl_xor(d2, 2);
            if (s <= t) {
                const int rel = t - s; const float bias = lut[rel > 128 ? 128 : rel];
                const float z1 = d1 * 0.125f + bias, z2 = d2 * 0.125f + bias;
                const float n1 = fmaxf(m1, z1), n2 = fmaxf(m2, z2);
                const float s1 = expf(m1 - n1), s2 = expf(m2 - n2), p1 = expf(z1 - n1), p2 = expf(z2 - n2);
                l1 = l1 * s1 + p1; l2 = l2 * s2 + p2; m1 = n1; m2 = n2;
                const bf16* vr = kr + 2048 + h * 128 + part * 32;
#pragma unroll
                for (int c8 = 0; c8 < 4; ++c8) { const bf16x8 vv = *(const bf16x8*)(vr + 8 * c8);
#pragma unroll
                    for (int i = 0; i < 8; ++i) { const float vf = bf2f((bf16)vv[i]); a1[8 * c8 + i] = a1[8 * c8 + i] * s1 + p1 * vf; a2[8 * c8 + i] = a2[8 * c8 + i] * s2 + p2 * vf; } }
            }
        }
        const float r1 = 1.0f / l1, r2 = lam / l2; float ss = 0.f;
#pragma unroll
        for (int i = 0; i < 32; ++i) { a1[i] = a1[i] * r1 - a2[i] * r2; ss += a1[i] * a1[i]; }
        ss += __shfl_xor(ss, 1); ss += __shfl_xor(ss, 2);
        const float rstd = 1.0f / sqrtf(ss * (1.0f / 128.0f) + EPS) * (1.0f - lambda_init);
        bf16* op = o + row * DM + h * 128 + part * 32;
#pragma unroll
        for (int i = 0; i < 32; i += 2) *(unsigned*)(op + i) = pk2(a1[i] * rstd * subln[part * 32 + i], a1[i + 1] * rstd * subln[part * 32 + i + 1]);
    }
}

typedef float f32x16 __attribute__((ext_vector_type(16)));
typedef short v4i16_t __attribute__((ext_vector_type(4)));
constexpr float LOG2E = 1.4426950408889634f;
constexpr float QK_PRESCALE = 0.125f * LOG2E;
constexpr int ATTN_QSCALE_COLS = 1024; constexpr float ATTN_QSCALE = QK_PRESCALE;
__device__ __forceinline__ float max3f(float a, float b, float c) { float r; asm("v_max3_f32 %0, %1, %2, %3" : "=v"(r) : "v"(a), "v"(b), "v"(c)); return r; }
__device__ __forceinline__ float mov_s(float a) { float r; asm("v_mov_b32_e32 %0, %1" : "=v"(r) : "v"(a)); return r; }
__device__ __forceinline__ float fadd_s(float a, float b) { float r; asm("v_add_f32_e32 %0, %1, %2" : "=v"(r) : "v"(a), "v"(b)); return r; }
__device__ __forceinline__ int crow(int r, int hi) { return (r & 3) + 8 * (r >> 2) + 4 * hi; }
__device__ __forceinline__ float half_max(float v) { auto rr = __builtin_amdgcn_permlane32_swap(__float_as_uint(v), __float_as_uint(v), false, false); return fmaxf(__uint_as_float(rr[0]), __uint_as_float(rr[1])); }
__device__ __forceinline__ float half_sum(float v) { auto rr = __builtin_amdgcn_permlane32_swap(__float_as_uint(v), __float_as_uint(v), false, false); return __uint_as_float(rr[0]) + __uint_as_float(rr[1]); }
__device__ __forceinline__ unsigned cvtpk(float lo, float hi) { typedef float f2 __attribute__((ext_vector_type(2))); typedef __bf16 b2 __attribute__((ext_vector_type(2))); f2 v = {lo, hi}; b2 b = __builtin_convertvector(v, b2); return __builtin_bit_cast(unsigned, b); }
__device__ __forceinline__ bf16x8 vfrag(LAS const unsigned char* p0, LAS const unsigned char* p1) {
    const v4i16_t lo = __builtin_amdgcn_ds_read_tr16_b64_v4i16((LAS v4i16_t*)p0), hi = __builtin_amdgcn_ds_read_tr16_b64_v4i16((LAS v4i16_t*)p1);
    return (bf16x8){lo[0], lo[1], lo[2], lo[3], hi[0], hi[1], hi[2], hi[3]};
}
constexpr int DA_KRING = 0, DA_KSLOT = 16384, DA_VRING = 49152, DA_VSLOT = 16384, DA_LUT = 131072 + 1024, DA_SLN = 131072 + 2560, DA_QF = 98304, DA_OST = 65536, DA_OROW = 264;
constexpr float DA_THR = 8.0f;

#ifndef MK_DIAG_SEL
#define MK_DIAG_SEL -1
#endif
#if MK_DIAG_SEL >= 0
#define DIAG_T(v) do { v = __builtin_amdgcn_s_memtime(); } while (0)
#define DIAG_ACC(k, t1, t0) do { dg[k] += (t1) - (t0); } while (0)
#else
#define DIAG_T(v) do { } while (0)
#define DIAG_ACC(k, t1, t0) do { } while (0)
#endif
__device__ __forceinline__ float da_maxall(const f32x16& a, const f32x16& b) {
    float mxa = max3f(a[0], a[1], b[0]), mxb = max3f(a[2], a[3], b[1]); mxa = max3f(mxa, b[2], b[3]);
#pragma unroll
    for (int r = 4; r < 16; r += 4) { mxa = max3f(mxa, a[r], a[r + 1]); mxb = max3f(mxb, a[r + 2], a[r + 3]); mxa = max3f(mxa, b[r], b[r + 1]); mxb = max3f(mxb, b[r + 2], b[r + 3]); }
    return max3f(mxa, mxb, mxb);
}
#define DA_MAXALL(a, b) da_maxall(a, b)
__device__ __forceinline__ void p_diff_attn(Frame& F, const bf16* proj, bf16* o, float lambda_init) {
    unsigned long long dg[6] = {0, 0, 0, 0, 0, 0}; unsigned long long ta = 0, tb = 0, tc = 0, td = 0; (void)ta; (void)tb; (void)tc; (void)td; (void)dg;
    const float* rel_bias = inp(F, 2); const float* lq1 = inp(F, 22); const float* lk1 = inp(F, 23); const float* lq2 = inp(F, 24); const float* lk2 = inp(F, 25); const float* subln = inp(F, 26);
    const int lane0 = F.lane, wave = F.wave, w4 = wave & 3, map = wave >> 2;
    LAS unsigned char* L = F.lds;
    LAS float* lut = (LAS float*)(L + DA_LUT) + 128;
    float lam;
    { float s1 = lq1[lane0] * lk1[lane0], s2 = lq2[lane0] * lk2[lane0]; s1 = wave_sum(s1); s2 = wave_sum(s2); lam = expf(s1) - expf(s2) + lambda_init; }
    const int G = F.G; const int bx = blockIdx.x; const int vcu0 = (G % 8 == 0) ? (bx % 8) * (G / 8) + bx / 8 : bx;
#define DA_WAITBAR(n) do { asm volatile("s_waitcnt vmcnt(" #n ") lgkmcnt(0)" ::: "memory"); __builtin_amdgcn_s_barrier(); asm volatile("" ::: "memory"); } while (0)
#define DA_WAITBAR_N(cnt) do { if ((cnt) >= 6) DA_WAITBAR(6); else if ((cnt) == 4) DA_WAITBAR(4); else if ((cnt) == 2) DA_WAITBAR(2); else DA_WAITBAR(0); } while (0)
    LAS float* sln = (LAS float*)(L + DA_SLN);
    __syncthreads();
    if (F.tid < 128) sln[F.tid] = subln[F.tid];
    for (int vcu = vcu0; vcu < 256; vcu += G) {
        const int xg = vcu >> 5, jl = vcu & 31;
        for (int k = 0; k < 8; ++k) {
            const int bh = xg * 8 + k, h = bh & 7, b = bh >> 3, qb = (k & 1) ? 31 - jl : jl;
            int lane_u = lane0; asm volatile("" : "+v"(lane_u));
            const int lane = lane_u, r32 = lane & 31, hi = lane >> 5;
            const int q4 = (lane & 15) >> 2, p4 = lane & 3, blk = (lane >> 4) & 1;
            const int vb0 = 64 * (4 * hi + q4) + 16 * ((2 * blk + (p4 >> 1)) ^ hi) + 8 * (p4 & 1);
            const int vb1 = 2048 + 64 * (4 * hi + q4) + 16 * ((2 * blk + (p4 >> 1)) ^ (2 + hi)) + 8 * (p4 & 1);
            const int vkey = 8 * wave + ((lane >> 2) & 7);
            const int vch0 = 4 * (lane >> 5) + ((lane & 3) ^ (2 * (wave & 1) + ((lane >> 4) & 1)));
            const int q0w = qb * 128 + 32 * w4, head = 2 * h + map;
            const int nkt = 2 * qb + 2, my_last = 2 * qb + (w4 >= 2 ? 1 : 0);
            __syncthreads();
            if (F.tid < 384) { int n = F.tid - 128; asm volatile("" : "+v"(n)); int bk;
                if (n < 16) bk = max(n, 0); else bk = 16 + (n >= 19) + (n >= 21) + (n >= 24) + (n >= 27) + (n >= 31) + (n >= 35) + (n >= 40) + (n >= 46) + (n >= 52) + (n >= 59) + (n >= 67) + (n >= 77) + (n >= 87) + (n >= 99) + (n >= 113);
                const float bv = rel_bias[bk * 8 + h] * LOG2E; lut[n] = n < 0 ? -INFINITY : bv; }
            const bf16* kvbase = proj + (size_t)b * SEQ * ODD_IN;
            bf16x8 qf[4];
            { const bf16* qp = kvbase + (size_t)(q0w + r32) * ODD_IN + head * 64 + 8 * hi;
#pragma unroll
              for (int d0 = 0; d0 < 4; ++d0) qf[d0] = *(const bf16x8*)(qp + 16 * d0); }
            const int krow = 8 * wave + (lane >> 3), kch = (lane & 7) ^ ((krow >> 1) & 7);
            const unsigned ko0 = (unsigned)(krow * ODD_IN + 1024 + (2 * h) * 64 + 8 * kch) * 2u, ko1 = ko0 + 128u;
            const unsigned vo0 = (unsigned)(vkey * ODD_IN + 2048 + h * 128 + 8 * vch0) * 2u, vo1 = vo0 + 128u;
#define DA_ISSUE_K(kt) do { const char* gb_ = (const char*)kvbase + (size_t)(kt) * 64 * ODD_IN * 2; LAS unsigned char* sb_ = L + DA_KRING + ((kt) % 3) * DA_KSLOT; \
            __builtin_amdgcn_global_load_lds((const unsigned*)(gb_ + ko0), (LAS unsigned*)(sb_ + wave * 1024), 16, 0, 0); \
            __builtin_amdgcn_global_load_lds((const unsigned*)(gb_ + ko1), (LAS unsigned*)(sb_ + 8192 + wave * 1024), 16, 0, 0); } while (0)
#define DA_ISSUE_V(kt) do { const char* gb_ = (const char*)kvbase + (size_t)(kt) * 64 * ODD_IN * 2; LAS unsigned char* sb_ = L + DA_VRING + ((kt) % 3) * DA_VSLOT; \
            __builtin_amdgcn_global_load_lds((const unsigned*)(gb_ + vo0), (LAS unsigned*)(sb_ + wave * 2048), 16, 0, 0); \
            __builtin_amdgcn_global_load_lds((const unsigned*)(gb_ + vo1), (LAS unsigned*)(sb_ + wave * 2048 + 1024), 16, 0, 0); } while (0)
            DA_ISSUE_K(0); DA_ISSUE_V(0); DA_ISSUE_K(1); DA_ISSUE_V(1); if (2 < nkt) DA_ISSUE_K(2);
            f32x16 oacc[4];
#pragma unroll
            for (int c = 0; c < 4; ++c)
#pragma unroll
                for (int r = 0; r < 16; ++r) oacc[c][r] = 0.f;
            float mref = 0.f, lrun = 0.f; bool first = true;
            f32x16 s0, s1;
#define DA_SB() __builtin_amdgcn_sched_barrier(0)
#define DA_LDKQ(t) do { LAS const unsigned char* kb_ = L + DA_KRING + ((t) % 3) * DA_KSLOT + map * 8192 + r32 * 128; const int sw_ = (r32 >> 1) & 7; \
                _Pragma("unroll") for (int d0 = 0; d0 < 4; ++d0) { const int co_ = ((2 * d0 + hi) ^ sw_) << 4; kf[2 * d0] = *(LAS const bf16x8*)(kb_ + co_); kf[2 * d0 + 1] = *(LAS const bf16x8*)(kb_ + co_ + 4096); } } while (0)
#define DA_QKM(t, S0, S1) do { const bool farq_ = (q0w - (64 * (t) + 63) >= 128); const float ci_ = (farq_ ? lut128 : 0.f) - mref; \
                _Pragma("unroll") for (int r = 0; r < 16; ++r) { S0[r] = ci_; S1[r] = ci_; } \
                _Pragma("unroll") for (int d0 = 0; d0 < 4; ++d0) { \
                    S0 = __builtin_amdgcn_mfma_f32_32x32x16_bf16(kf[2 * d0], qf[d0], S0, 0, 0, 0); \
                    S1 = __builtin_amdgcn_mfma_f32_32x32x16_bf16(kf[2 * d0 + 1], qf[d0], S1, 0, 0, 0); } } while (0)
#define DA_LDV(c, dst) do { _Pragma("unroll") for (int s = 0; s < 4; ++s) { \
                asm volatile("ds_read_b64_tr_b16 %0, %1 offset:%c2" : "=&v"(dst##l[s]) : "v"(vp0u), "i"(4096 * s + 512 * (c)) : "memory"); \
                asm volatile("ds_read_b64_tr_b16 %0, %1 offset:%c2" : "=&v"(dst##h[s]) : "v"(vp1u), "i"(4096 * s + 512 * (c)) : "memory"); } } while (0)
#define DA_VF(dst, s) (bf16x8){dst##l[s][0], dst##l[s][1], dst##l[s][2], dst##l[s][3], dst##h[s][0], dst##h[s][1], dst##h[s][2], dst##h[s][3]}
#define DA_LWAIT(n) do { asm volatile("s_waitcnt lgkmcnt(" #n ")" ::: "memory"); DA_SB(); } while (0)
            bf16x8 kf[8];
            DA_WAITBAR(0);
            const float lut128 = lut[128];
            DA_LDKQ(0); DA_SB(); DA_QKM(0, s0, s1); DA_SB();
            asm volatile("s_nop 15\n\ts_nop 7" : "+v"(s0), "+v"(s1));
            float mx_pre = DA_MAXALL(s0, s1);
#pragma unroll 1
            for (int t = 0; t < nkt; ++t) {
                if (t > 0) { const int fly = 2 * ((t + 2 < nkt ? 1 : 0) + (t + 1 < nkt ? 1 : 0)); DA_WAITBAR_N(fly); }
                if (t + 3 < nkt) DA_ISSUE_K(t + 3);
                if (t + 2 < nkt) DA_ISSUE_V(t + 2);
                DA_LDKQ(t + 1);
                DA_SB();
                const int k0_ = 64 * t;
                float mx;
                if (!(q0w - (k0_ + 63) >= 128)) { int lq_ = lane; asm volatile("" : "+v"(lq_));
                    const int relb = q0w + (lq_ & 31) - k0_ - 4 * (lq_ >> 5);
                    LAS const float* bp = lut + (relb - 59); { unsigned bpu = (unsigned)(size_t)bp; asm volatile("" : "+v"(bpu)); bp = (LAS const float*)bpu; }
#pragma unroll
                    for (int r = 0; r < 16; ++r) { const int c = (r & 3) + 8 * (r >> 2); s0[r] += bp[59 - c]; s1[r] += bp[27 - c]; }
                    mx = DA_MAXALL(s0, s1); }
                else mx = mx_pre;
                mx = half_max(mx);
                if (first || __any(mx > DA_THR)) {
                    const float dl = first ? mx : fmaxf(mx, 0.f); const float al = __builtin_amdgcn_exp2f(-dl);
                    mref += dl; lrun *= al;
#pragma unroll
                    for (int c = 0; c < 4; ++c)
#pragma unroll
                        for (int r = 0; r < 16; ++r) oacc[c][r] *= al;
#pragma unroll
                    for (int r = 0; r < 16; ++r) { s0[r] -= dl; s1[r] -= dl; }
                    first = false; }
                DA_SB();
                f32x16 n0, n1;
                DA_QKM(t + 1, n0, n1);
#pragma unroll
                for (int r = 0; r < 16; ++r) { s0[r] = __builtin_amdgcn_exp2f(s0[r]); s1[r] = __builtin_amdgcn_exp2f(s1[r]); }
#pragma unroll
                for (int i = 0; i < 8; ++i) { __builtin_amdgcn_sched_group_barrier(0x008, 1, 0); __builtin_amdgcn_sched_group_barrier(0x400, 4, 0); }
                DA_SB();
                asm volatile("s_nop 1" : "+v"(s0), "+v"(s1));
                unsigned vp0u = (unsigned)(size_t)(L + DA_VRING + (t % 3) * DA_VSLOT) + (unsigned)vb0, vp1u = vp0u - (unsigned)vb0 + (unsigned)vb1;
                asm volatile("" : "+v"(vp0u), "+v"(vp1u));
                v4i16_t val[4], vah[4], vnl[4], vnh[4], vml[4], vmh[4];
                DA_LDV(0, va); DA_LDV(1, vn);
                DA_SB();
                bf16x8 pw[4];
                { v4u w;
                  w.x = cvtpk(s0[0], s0[1]); w.y = cvtpk(s0[2], s0[3]); w.z = cvtpk(s0[4], s0[5]); w.w = cvtpk(s0[6], s0[7]); pw[0] = __builtin_bit_cast(bf16x8, w);
                  w.x = cvtpk(s0[8], s0[9]); w.y = cvtpk(s0[10], s0[11]); w.z = cvtpk(s0[12], s0[13]); w.w = cvtpk(s0[14], s0[15]); pw[1] = __builtin_bit_cast(bf16x8, w); }
                DA_SB();
                float lsa = 0.f, lsb = 0.f, mxa, mxb;
#define DA_PVA(acc, vf, s, r, EXTRA) do { acc = __builtin_amdgcn_mfma_f32_32x32x16_bf16(DA_VF(vf, s), pw[s], acc, 0, 0, 0); lsa = fadd_s(lsa, s0[r]); lsb = fadd_s(lsb, s1[r]); EXTRA; if ((r) > 0) { s0[(r) - 1] = mov_s(n0[(r) - 1]); s1[(r) - 1] = mov_s(n1[(r) - 1]); } DA_SB(); } while (0)
                DA_LDV(2, vm); DA_LWAIT(15);
                DA_PVA(oacc[0], va, 0, 0, { v4u w; w.x = cvtpk(s1[0], s1[1]); w.y = cvtpk(s1[2], s1[3]); w.z = cvtpk(s1[4], s1[5]); w.w = cvtpk(s1[6], s1[7]); pw[2] = __builtin_bit_cast(bf16x8, w); });
                DA_PVA(oacc[0], va, 1, 1, { v4u w; w.x = cvtpk(s1[8], s1[9]); w.y = cvtpk(s1[10], s1[11]); w.z = cvtpk(s1[12], s1[13]); w.w = cvtpk(s1[14], s1[15]); pw[3] = __builtin_bit_cast(bf16x8, w); });
                DA_PVA(oacc[0], va, 2, 2, );
                DA_PVA(oacc[0], va, 3, 3, { mxa = max3f(n0[0], n0[1], n1[0]); mxb = max3f(n0[2], n0[3], n1[1]); });
                DA_LDV(3, va); DA_LWAIT(15);
                DA_PVA(oacc[1], vn, 0, 4, { mxa = max3f(mxa, n1[2], n1[3]); mxb = max3f(mxb, n0[6], n0[7]); });
                DA_PVA(oacc[1], vn, 1, 5, { mxa = max3f(mxa, n0[4], n0[5]); mxb = max3f(mxb, n1[6], n1[7]); });
                DA_PVA(oacc[1], vn, 2, 6, { mxa = max3f(mxa, n1[4], n1[5]); });
                DA_PVA(oacc[1], vn, 3, 7, { mxb = max3f(mxb, n0[10], n0[11]); });
                DA_LWAIT(8);
                DA_PVA(oacc[2], vm, 0, 8, { mxa = max3f(mxa, n0[8], n0[9]); });
                DA_PVA(oacc[2], vm, 1, 9, { mxb = max3f(mxb, n1[10], n1[11]); });
                DA_PVA(oacc[2], vm, 2, 10, { mxa = max3f(mxa, n1[8], n1[9]); });
                DA_PVA(oacc[2], vm, 3, 11, { mxb = max3f(mxb, n0[14], n0[15]); });
                DA_LWAIT(0);
                DA_PVA(oacc[3], va, 0, 12, { mxa = max3f(mxa, n0[12], n0[13]); });
                DA_PVA(oacc[3], va, 1, 13, { mxb = max3f(mxb, n1[14], n1[15]); });
                DA_PVA(oacc[3], va, 2, 14, { mxa = max3f(mxa, n1[12], n1[13]); });
                DA_PVA(oacc[3], va, 3, 15, { mx_pre = max3f(mxa, mxb, mxb); });
#undef DA_PVA
                lrun = fadd_s(lrun, fadd_s(lsa, lsb));
                s0[15] = mov_s(n0[15]); s1[15] = mov_s(n1[15]);
            }
#undef DA_SB
#undef DA_LDKQ
#undef DA_QKM
#undef DA_LDV
#undef DA_VF
#undef DA_LWAIT
#undef DA_ISSUE_K
#undef DA_ISSUE_V
            {
            int lane_e = lane; asm volatile("" : "+v"(lane_e));
            const int r32 = lane_e & 31, hi = lane_e >> 5, lane = lane_e;
            const float ltot = half_sum(lrun);
            const float rl = (map == 0 ? 1.0f : lam) / ltot;
#pragma unroll
            for (int c = 0; c < 4; ++c)
#pragma unroll
                for (int r = 0; r < 16; ++r) oacc[c][r] *= rl;
            __syncthreads();
            LAS f32x4* cb = (LAS f32x4*)(L + w4 * 16384) + lane;
            if (map == 1) {
#pragma unroll
                for (int c = 0; c < 4; ++c)
#pragma unroll
                    for (int g = 0; g < 4; ++g) cb[(c * 4 + g) * 64] = (f32x4){oacc[c][4 * g], oacc[c][4 * g + 1], oacc[c][4 * g + 2], oacc[c][4 * g + 3]};
            }
            __syncthreads();
            if (map == 0) {
                float ss = 0.f;
#pragma unroll
                for (int c = 0; c < 4; ++c)
#pragma unroll
                    for (int g = 0; g < 4; ++g) { const f32x4 tq = cb[(c * 4 + g) * 64];
                        oacc[c][4 * g] -= tq.x; oacc[c][4 * g + 1] -= tq.y; oacc[c][4 * g + 2] -= tq.z; oacc[c][4 * g + 3] -= tq.w;
                        ss += (oacc[c][4 * g] * oacc[c][4 * g] + oacc[c][4 * g + 1] * oacc[c][4 * g + 1]) + (oacc[c][4 * g + 2] * oacc[c][4 * g + 2] + oacc[c][4 * g + 3] * oacc[c][4 * g + 3]); }
                ss = half_sum(ss);
                const float rstd = (1.0f - lambda_init) / sqrtf(ss * (1.0f / 128.0f) + EPS);
                LAS unsigned char* st = L + DA_OST + w4 * (32 * DA_OROW);
#pragma unroll
                for (int c = 0; c < 4; ++c)
#pragma unroll
                    for (int g = 0; g < 4; ++g) { const int d = 32 * c + 8 * g + 4 * hi; const f32x4 sg = *(const LAS f32x4*)(sln + d);
                        const unsigned lo = cvtpk(oacc[c][4 * g] * rstd * sg.x, oacc[c][4 * g + 1] * rstd * sg.y), hi2 = cvtpk(oacc[c][4 * g + 2] * rstd * sg.z, oacc[c][4 * g + 3] * rstd * sg.w);
                        *(LAS unsigned long long*)(st + r32 * DA_OROW + d * 2) = (unsigned long long)lo | ((unsigned long long)hi2 << 32); }
                LDS_WAIT(); asm volatile("" ::: "memory");
                bf16* orow = o + ((size_t)b * SEQ + q0w) * DM + h * 128;
#pragma unroll
                for (int i = 0; i < 8; ++i) { const int idx = i * 64 + lane, row = idx >> 4, ch = idx & 15;
                    const unsigned long long a = *(LAS const unsigned long long*)(st + row * DA_OROW + ch * 16), bq = *(LAS const unsigned long long*)(st + row * DA_OROW + ch * 16 + 8);
                    v4u w; w.x = (unsigned)a; w.y = (unsigned)(a >> 32); w.z = (unsigned)bq; w.w = (unsigned)(bq >> 32);
                    *(GAS v4u*)(orow + (size_t)row * DM + ch * 8) = w; }
            }
            }
        }
    }
#undef DA_WAITBAR
#undef DA_WAITBAR_N
#if MK_DIAG_SEL >= 0
    if (blockIdx.x == 0 && F.wave == 0 && lane0 == 0) { float* dgo = (float*)(F.ws + WS_CTL + 65536); const float n = (float)dg[4];
        dgo[0] = (float)dg[0] / n; dgo[1] = (float)dg[1] / n; dgo[2] = (float)dg[2] / n; dgo[3] = (float)dg[3] / n; dgo[4] = n; }
#endif
}

constexpr size_t WS_HL = WS_H, WS_AC = WS_H + 32 * MiB;
constexpr size_t WS_SUMM = 3 * MiB;
constexpr int LRU_W = 512, NSEG = 32;
__device__ __forceinline__ float expm1_fast(float x) { const float p = x * (1.0f + x * (0.5f + x * (0.16666667f + x * (0.041666668f + x * 0.0083333338f)))); return x > -0.1f ? p : __expf(x) - 1.0f; }
__device__ __forceinline__ float expm1_sq(float x, float a) { const float p = x * (1.0f + x * (0.5f + x * (0.16666667f + x * (0.041666668f + x * 0.0083333338f)))); return x > -0.1f ? p : a * a - 1.0f; }
__device__ __forceinline__ float fast_sigmoid(float z) { return __builtin_amdgcn_rcpf(1.0f + __expf(-z)); }
__device__ __forceinline__ void p_lru_local(Frame& F, const bf16* proj) {
    const float* conv_w = inp(F, 10); const float* conv_b = inp(F, 11); const float* ga_w = inp(F, 12); const float* ga_b = inp(F, 13); const float* gx_w = inp(F, 14); const float* gx_b = inp(F, 15); const float* lamp = inp(F, 16);
    const int lane = F.lane, r32 = lane & 31, hi = lane >> 5;
    const int g = blockIdx.x & 7;
    LAS unsigned char* WAl = F.lds;
    LAS float* Lc = (LAS float*)(F.lds + 16384);
    LAS float* cw = Lc; LAS float* cb = Lc + 256; LAS float* gab = Lc + 320; LAS float* gxb = Lc + 384; LAS float* lsl = Lc + 448;
    LAS float* hcs = (LAS float*)(F.lds + 20480 + F.wave * 512); LAS float* Acs = hcs + 64;
    __syncthreads();
    if (F.wave == 0) { const int c = g * 64 + lane;
      cw[lane] = conv_w[c]; cw[64 + lane] = conv_w[512 + c]; cw[128 + lane] = conv_w[1024 + c]; cw[192 + lane] = conv_w[1536 + c];
      cb[lane] = conv_b[c]; gab[lane] = ga_b[c]; gxb[lane] = gx_b[c]; lsl[lane] = logsig_f(lamp[c]); }
#pragma unroll
    for (int f2 = 0; f2 < 2; ++f2) { const int fi = 2 * F.wave + f2, rt = fi >> 2, ks = fi & 3;
        const float* wp = (rt < 2 ? ga_w : gx_w) + (size_t)g * 4096 + 32 * (rt & 1) + r32 + (16 * ks + 8 * hi) * 64; v4u w;
        w.x = cvtpk(wp[0], wp[64]); w.y = cvtpk(wp[128], wp[192]); w.z = cvtpk(wp[256], wp[320]); w.w = cvtpk(wp[384], wp[448]);
        *(LAS v4u*)(WAl + (fi * 64 + lane) * 16) = w; }
    __syncthreads();
    bf16x8 idf[2];
#pragma unroll
    for (int kk = 0; kk < 2; ++kk)
#pragma unroll
        for (int jj = 0; jj < 8; ++jj) idf[kk][jj] = (r32 == (16 * kk + 8 * hi + jj)) ? (short)0x3F80 : (short)0;
#define LRU_WA(rt, ks) (*(const LAS bf16x8*)(WAl + (((rt) * 4 + (ks)) * 64 + lane) * 16))
    bf16* HL = (bf16*)(F.ws + WS_HL); bf16* AC = (bf16*)(F.ws + WS_AC); float* SUMM = (float*)(F.ws + WS_SUMM);
    for (int item = (blockIdx.x >> 3) * 8 + F.wave; item < NB * NSEG; item += (F.G >> 3) * 8) {
        const int b = item / NSEG, seg = item % NSEG;
        hcs[lane] = 0.f; Acs[lane] = 1.f;
        LDS_WAIT(); asm volatile("" ::: "memory");
#pragma unroll 1
        for (int tile = 0; tile < 4; ++tile) {
            const int t = seg * 128 + tile * 32 + r32; const size_t row = (size_t)b * SEQ + t;
            bf16x8 Bf[4];
#pragma unroll
            for (int ks = 0; ks < 4; ++ks) { const int i0 = 16 * ks + 8 * hi; const bf16* xp = proj + row * EVEN_IN + 1536 + g * 64 + i0;
                float xc[8];
                { const f32x4 c0 = *(const LAS f32x4*)(cb + i0), c1 = *(const LAS f32x4*)(cb + i0 + 4); xc[0] = c0.x; xc[1] = c0.y; xc[2] = c0.z; xc[3] = c0.w; xc[4] = c1.x; xc[5] = c1.y; xc[6] = c1.z; xc[7] = c1.w; }
#pragma unroll
                for (int w = 0; w < 4; ++w) { const int back = 3 - w;
                    const bool inb = (t - back >= 0);
                    bf16x8 xv = *(const bf16x8*)(xp - (size_t)(inb ? back : 0) * EVEN_IN);
                    if (!inb) xv = (bf16x8){0, 0, 0, 0, 0, 0, 0, 0};
                    const f32x4 w0 = *(const LAS f32x4*)(cw + 64 * w + i0), w1 = *(const LAS f32x4*)(cw + 64 * w + i0 + 4);
                    xc[0] += w0.x * bf2f((bf16)xv[0]); xc[1] += w0.y * bf2f((bf16)xv[1]); xc[2] += w0.z * bf2f((bf16)xv[2]); xc[3] += w0.w * bf2f((bf16)xv[3]);
                    xc[4] += w1.x * bf2f((bf16)xv[4]); xc[5] += w1.y * bf2f((bf16)xv[5]); xc[6] += w1.z * bf2f((bf16)xv[6]); xc[7] += w1.w * bf2f((bf16)xv[7]); }
                v4u pk; pk.x = cvtpk(xc[0], xc[1]); pk.y = cvtpk(xc[2], xc[3]); pk.z = cvtpk(xc[4], xc[5]); pk.w = cvtpk(xc[6], xc[7]); Bf[ks] = __builtin_bit_cast(bf16x8, pk);
                __builtin_amdgcn_sched_barrier(0); }
#pragma unroll 1
            for (int rt2 = 0; rt2 < 2; ++rt2) {
                f32x16 Dr, Di, Dx;
#pragma unroll
                for (int r = 0; r < 16; ++r) { Dr[r] = 0.f; Di[r] = 0.f; Dx[r] = 0.f; }
#pragma unroll
                for (int ks = 0; ks < 4; ++ks) {
                    Dr = __builtin_amdgcn_mfma_f32_32x32x16_bf16(LRU_WA(rt2, ks), Bf[ks], Dr, 0, 0, 0);
                    Di = __builtin_amdgcn_mfma_f32_32x32x16_bf16(LRU_WA(2 + rt2, ks), Bf[ks], Di, 0, 0, 0);
                    if ((ks >> 1) == rt2) Dx = __builtin_amdgcn_mfma_f32_32x32x16_bf16(idf[ks & 1], Bf[ks], Dx, 0, 0, 0); }
                float av[16], hv[16];
#pragma unroll
                for (int a4 = 0; a4 < 4; ++a4) { const int ch = 32 * rt2 + 8 * a4 + 4 * hi;
                    const f32x4 ba = *(const LAS f32x4*)(gab + ch), bx = *(const LAS f32x4*)(gxb + ch), ls = *(const LAS f32x4*)(lsl + ch);
#pragma unroll
                    for (int q = 0; q < 4; ++q) { const int r = 4 * a4 + q;
                        const float rg = fast_sigmoid(Dr[r] + ba[q]), ig = fast_sigmoid(Di[r] + bx[q]);
                        const float log_a = 8.0f * rg * ls[q];
                        av[r] = __expf(log_a); hv[r] = __builtin_amdgcn_sqrtf(-expm1_sq(2.0f * log_a, av[r])) * (ig * Dx[r]); }
                    __builtin_amdgcn_sched_barrier(0); }
#define LRU_DPP(oldv, v, ctrl, rmask) __builtin_bit_cast(float, __builtin_amdgcn_update_dpp(__builtin_bit_cast(int, (float)(oldv)), __builtin_bit_cast(int, (float)(v)), (ctrl), (rmask), 0xf, false))
#define LRU_STEP(ctrl, rmask) do { _Pragma("unroll") for (int r = 0; r < 16; ++r) { const float ap = LRU_DPP(1.0f, av[r], ctrl, rmask), hp = LRU_DPP(0.0f, hv[r], ctrl, rmask); \
                        hv[r] = av[r] * hp + hv[r]; av[r] = av[r] * ap; } } while (0)
                LRU_STEP(0x111, 0xf); LRU_STEP(0x112, 0xf); LRU_STEP(0x114, 0xf); LRU_STEP(0x118, 0xf); LRU_STEP(0x142, 0xa);
#undef LRU_STEP
#undef LRU_DPP
                unsigned hp[4][2], ap[4][2];
#pragma unroll
                for (int a4 = 0; a4 < 4; ++a4) { const int ch = 32 * rt2 + 8 * a4 + 4 * hi;
                    const f32x4 hc = *(const LAS f32x4*)(hcs + ch), Ac = *(const LAS f32x4*)(Acs + ch);
                    f32x4 ho, ao;
#pragma unroll
                    for (int q = 0; q < 4; ++q) { const int r = 4 * a4 + q; ho[q] = hv[r] + av[r] * hc[q]; ao[q] = av[r] * Ac[q]; }
                    asm volatile("" ::: "memory");
                    if (r32 == 31) { *(LAS f32x4*)(hcs + ch) = ho; *(LAS f32x4*)(Acs + ch) = ao; }
                    hp[a4][0] = cvtpk(ho[0], ho[1]); hp[a4][1] = cvtpk(ho[2], ho[3]); ap[a4][0] = cvtpk(ao[0], ao[1]); ap[a4][1] = cvtpk(ao[2], ao[3]); }
#pragma unroll
                for (int k = 0; k < 2; ++k) {
#pragma unroll
                    for (int j = 0; j < 2; ++j) {
                        { auto r = __builtin_amdgcn_permlane32_swap(hp[2 * k][j], hp[2 * k + 1][j], false, false); hp[2 * k][j] = r[0]; hp[2 * k + 1][j] = r[1]; }
                        { auto r = __builtin_amdgcn_permlane32_swap(ap[2 * k][j], ap[2 * k + 1][j], false, false); ap[2 * k][j] = r[0]; ap[2 * k + 1][j] = r[1]; } }
                    const size_t o = row * LRU_W + g * 64 + 32 * rt2 + 16 * k + 8 * hi;
                    v4u wh, wa; wh.x = hp[2 * k][0]; wh.y = hp[2 * k][1]; wh.z = hp[2 * k + 1][0]; wh.w = hp[2 * k + 1][1];
                    wa.x = ap[2 * k][0]; wa.y = ap[2 * k][1]; wa.z = ap[2 * k + 1][0]; wa.w = ap[2 * k + 1][1];
                    *(GAS v4u*)(HL + o) = wh; *(GAS v4u*)(AC + o) = wa; }
                LDS_WAIT(); asm volatile("" ::: "memory");
            }
        }
        { float* sp = SUMM + ((size_t)(b * NSEG + seg) * 2) * LRU_W + g * 64; sp[lane] = Acs[lane]; sp[LRU_W + lane] = hcs[lane]; }
    }
#undef LRU_WA
}
__device__ __forceinline__ void p_lru_fix(Frame& F, const bf16* proj, bf16* mix) {
    const bf16* HL = (const bf16*)(F.ws + WS_HL); const bf16* AC = (const bf16*)(F.ws + WS_AC); const float* SUMM = (const float*)(F.ws + WS_SUMM);
    const int lane = F.lane;
    for (int u = F.gw; u < NB * NSEG * 8; u += F.NGW) {
        const int qt = u & 7, bs = u >> 3, b = bs / NSEG, seg = bs % NSEG;
        float c[8];
#pragma unroll
        for (int j = 0; j < 8; ++j) c[j] = 0.f;
        const float* sp0 = SUMM + ((size_t)(b * NSEG) * 2) * LRU_W + 8 * lane;
        int s = 0;
        for (; s + 4 <= seg; s += 4) {
            f32x4 a0[4], a1[4], h0[4], h1[4];
#pragma unroll
            for (int k = 0; k < 4; ++k) { const float* sp = sp0 + (size_t)(s + k) * 2 * LRU_W; a0[k] = *(const GAS f32x4*)sp; a1[k] = *(const GAS f32x4*)(sp + 4); h0[k] = *(const GAS f32x4*)(sp + LRU_W); h1[k] = *(const GAS f32x4*)(sp + LRU_W + 4); }
#pragma unroll
            for (int k = 0; k < 4; ++k) {
                c[0] = a0[k].x * c[0] + h0[k].x; c[1] = a0[k].y * c[1] + h0[k].y; c[2] = a0[k].z * c[2] + h0[k].z; c[3] = a0[k].w * c[3] + h0[k].w;
                c[4] = a1[k].x * c[4] + h1[k].x; c[5] = a1[k].y * c[5] + h1[k].y; c[6] = a1[k].z * c[6] + h1[k].z; c[7] = a1[k].w * c[7] + h1[k].w; } }
        for (; s < seg; ++s) { const float* sp = sp0 + (size_t)s * 2 * LRU_W;
            const f32x4 a0 = *(const GAS f32x4*)sp, a1 = *(const GAS f32x4*)(sp + 4), h0 = *(const GAS f32x4*)(sp + LRU_W), h1 = *(const GAS f32x4*)(sp + LRU_W + 4);
            c[0] = a0.x * c[0] + h0.x; c[1] = a0.y * c[1] + h0.y; c[2] = a0.z * c[2] + h0.z; c[3] = a0.w * c[3] + h0.w;
            c[4] = a1.x * c[4] + h1.x; c[5] = a1.y * c[5] + h1.y; c[6] = a1.z * c[6] + h1.z; c[7] = a1.w * c[7] + h1.w; }
#pragma unroll 4
        for (int i = 0; i < 16; ++i) {
            const size_t row = (size_t)b * SEQ + seg * 128 + qt * 16 + i;
            const bf16x8 hl = *(const bf16x8*)(HL + row * LRU_W + 8 * lane), ac = *(const bf16x8*)(AC + row * LRU_W + 8 * lane), gb = *(const bf16x8*)(proj + row * EVEN_IN + 2048 + 8 * lane);
            float y[8];
#pragma unroll
            for (int j = 0; j < 8; ++j) { const float g = bf2f((bf16)gb[j]); const float u2 = 1.5957691216057308f * (g + 0.044715f * g * g * g);
                y[j] = (bf2f((bf16)hl[j]) + bf2f((bf16)ac[j]) * c[j]) * (g * __builtin_amdgcn_rcpf(1.0f + __expf(-u2))); }
            v4u w; w.x = cvtpk(y[0], y[1]); w.y = cvtpk(y[2], y[3]); w.z = cvtpk(y[4], y[5]); w.w = cvtpk(y[6], y[7]);
            *(GAS v4u*)(mix + row * DM + 512 + 8 * lane) = w;
        }
    }
}

constexpr int SB_LDS0 = 32768;
constexpr float LN2 = 0.6931471805599453f;
#define SB_QSCALE_COLS 512
#define SB_QSCALE (0.125f * LOG2E)
constexpr float SB_STOP = -40.0f * LOG2E;
__device__ __forceinline__ void p_sb_attn(Frame& F, const bf16* proj, bf16* mix) {
    const int lane = F.lane, wave = F.wave, r32 = lane & 31, hi = lane >> 5;
    LAS unsigned char* Vw = F.lds + SB_LDS0 + wave * 8192;
    const int q4 = (lane & 15) >> 2, p4 = lane & 3, blk = (lane >> 4) & 1;
    const int vb0 = 64 * (4 * hi + q4) + 16 * ((2 * blk + (p4 >> 1)) ^ hi) + 8 * (p4 & 1);
    const int vb1 = 1024 + 64 * (4 * hi + q4) + 16 * ((2 * blk + (p4 >> 1)) ^ (2 + hi)) + 8 * (p4 & 1);
    const int vkl = (lane >> 2) & 7, vchE = 4 * (lane >> 5) + ((lane & 3) ^ ((lane >> 4) & 1)), vchO = 4 * (lane >> 5) + ((lane & 3) ^ (2 + ((lane >> 4) & 1)));
    const unsigned voE = (unsigned)(vkl * EVEN_IN + 8 * vchE) * 2u, voO = (unsigned)(vkl * EVEN_IN + 8 * vchO) * 2u;
    bf16x8 Tp[2], ONES;
#pragma unroll
    for (int ks = 0; ks < 2; ++ks)
#pragma unroll
        for (int jj = 0; jj < 8; ++jj) Tp[ks][jj] = ((16 * ks + 8 * (jj >> 2) + 4 * hi + (jj & 3)) > r32) ? (short)0x3F80 : (short)0;
#pragma unroll
    for (int jj = 0; jj < 8; ++jj) ONES[jj] = (short)0x3F80;
    for (int u = F.gw; u < NB * 8 * (SEQ / 32); u += F.NGW) {
        const int qt = u % (SEQ / 32), h = (u / (SEQ / 32)) % 8, b = u / (8 * (SEQ / 32)), qw = qt * 32;
        const bf16* base = proj + (size_t)b * SEQ * EVEN_IN;
        bf16x8 qf[4];
        { const bf16* qp = base + (size_t)(qw + r32) * EVEN_IN + h * 64 + 8 * hi;
#pragma unroll
          for (int d0 = 0; d0 < 4; ++d0) qf[d0] = *(const bf16x8*)(qp + 16 * d0); }
        f32x16 oacc[2];
#pragma unroll
        for (int c = 0; c < 2; ++c)
#pragma unroll
            for (int r = 0; r < 16; ++r) oacc[c][r] = 0.f;
        float R = 0.f;
        const int qpos = qw + r32;
#pragma unroll 1
        for (int k0 = ((qw + 30) >> 6) << 6; k0 >= 0; k0 -= 64) {
            LDS_WAIT();
            { const char* vg = (const char*)(base + (size_t)k0 * EVEN_IN + 1024 + h * 64);
#pragma unroll
              for (int p = 0; p < 8; ++p)
                  __builtin_amdgcn_global_load_lds((const unsigned*)(vg + (size_t)(8 * p) * EVEN_IN * 2 + ((p & 1) ? voO : voE)), (LAS unsigned*)(Vw + p * 1024), 16, 0, 0); }
            f32x16 p0, p1;
#pragma unroll
            for (int r = 0; r < 16; ++r) { p0[r] = 0.f; p1[r] = 0.f; }
            { const bf16* kp = base + (size_t)(k0 + r32) * EVEN_IN + 512 + h * 64 + 8 * hi;
#pragma unroll
              for (int d0 = 0; d0 < 4; ++d0) { const bf16x8 a0 = *(const bf16x8*)(kp + 16 * d0), a1 = *(const bf16x8*)(kp + (size_t)32 * EVEN_IN + 16 * d0);
                  p0 = __builtin_amdgcn_mfma_f32_32x32x16_bf16(a0, qf[d0], p0, 0, 0, 0);
                  p1 = __builtin_amdgcn_mfma_f32_32x32x16_bf16(a1, qf[d0], p1, 0, 0, 0); } }
            float Lsum = 0.f; bf16x8 Lh[4], Ll[4];
#define SB_SOFT(MASKED) \
            _Pragma("unroll") for (int half = 0; half < 2; ++half) { \
                float Lv[16]; \
                _Pragma("unroll") for (int r = 0; r < 16; ++r) { const float z = half ? p1[r] : p0[r]; \
                    const float sp = __builtin_amdgcn_logf(1.0f + __builtin_amdgcn_exp2f(-fabsf(z))); \
                    float lp = fminf(z, 0.f) - sp, lv = -fmaxf(z, 0.f) - sp; \
                    if (MASKED) { const bool valid = (k0 + 32 * half + crow(r, hi)) < qpos; lv = valid ? lv : 0.f; lp = valid ? lp : -INFINITY; } \
                    Lv[r] = lv; Lsum += lv; if (half) p1[r] = lp; else p0[r] = lp; } \
                _Pragma("unroll") for (int s = 0; s < 2; ++s) { v4u wh, wl; unsigned hv[4], lv[4]; \
                    _Pragma("unroll") for (int i = 0; i < 4; ++i) { const float x0 = Lv[8 * s + 2 * i], x1 = Lv[8 * s + 2 * i + 1]; hv[i] = cvtpk(x0, x1); \
                        const float r0 = x0 - __uint_as_float(hv[i] << 16), r1 = x1 - __uint_as_float(hv[i] & 0xffff0000u); lv[i] = cvtpk(r0, r1); } \
                    wh.x = hv[0]; wh.y = hv[1]; wh.z = hv[2]; wh.w = hv[3]; wl.x = lv[0]; wl.y = lv[1]; wl.z = lv[2]; wl.w = lv[3]; \
                    Lh[2 * half + s] = __builtin_bit_cast(bf16x8, wh); Ll[2 * half + s] = __builtin_bit_cast(bf16x8, wl); } }
            if (k0 + 63 >= qw) { SB_SOFT(1) } else { SB_SOFT(0) }
#undef SB_SOFT
            __builtin_amdgcn_sched_barrier(0);
            f32x16 l0, l1;
#pragma unroll
            for (int r = 0; r < 16; ++r) { l0[r] = R + p0[r]; l1[r] = R + p1[r]; }
#pragma unroll
            for (int ks = 0; ks < 2; ++ks) {
                l0 = __builtin_amdgcn_mfma_f32_32x32x16_bf16(Tp[ks], Lh[ks], l0, 0, 0, 0); l0 = __builtin_amdgcn_mfma_f32_32x32x16_bf16(Tp[ks], Ll[ks], l0, 0, 0, 0);
                l0 = __builtin_amdgcn_mfma_f32_32x32x16_bf16(ONES, Lh[2 + ks], l0, 0, 0, 0); l0 = __builtin_amdgcn_mfma_f32_32x32x16_bf16(ONES, Ll[2 + ks], l0, 0, 0, 0);
                l1 = __builtin_amdgcn_mfma_f32_32x32x16_bf16(Tp[ks], Lh[2 + ks], l1, 0, 0, 0); l1 = __builtin_amdgcn_mfma_f32_32x32x16_bf16(Tp[ks], Ll[2 + ks], l1, 0, 0, 0); }
            R += half_sum(Lsum);
            bf16x8 pw[4];
            { v4u w;
#define SBW(P, Lx, r) __builtin_amdgcn_exp2f(Lx[r])
              w.x = cvtpk(SBW(p0, l0, 0), SBW(p0, l0, 1)); w.y = cvtpk(SBW(p0, l0, 2), SBW(p0, l0, 3)); w.z = cvtpk(SBW(p0, l0, 4), SBW(p0, l0, 5)); w.w = cvtpk(SBW(p0, l0, 6), SBW(p0, l0, 7)); pw[0] = __builtin_bit_cast(bf16x8, w);
              w.x = cvtpk(SBW(p0, l0, 8), SBW(p0, l0, 9)); w.y = cvtpk(SBW(p0, l0, 10), SBW(p0, l0, 11)); w.z = cvtpk(SBW(p0, l0, 12), SBW(p0, l0, 13)); w.w = cvtpk(SBW(p0, l0, 14), SBW(p0, l0, 15)); pw[1] = __builtin_bit_cast(bf16x8, w);
              w.x = cvtpk(SBW(p1, l1, 0), SBW(p1, l1, 1)); w.y = cvtpk(SBW(p1, l1, 2), SBW(p1, l1, 3)); w.z = cvtpk(SBW(p1, l1, 4), SBW(p1, l1, 5)); w.w = cvtpk(SBW(p1, l1, 6), SBW(p1, l1, 7)); pw[2] = __builtin_bit_cast(bf16x8, w);
              w.x = cvtpk(SBW(p1, l1, 8), SBW(p1, l1, 9)); w.y = cvtpk(SBW(p1, l1, 10), SBW(p1, l1, 11)); w.z = cvtpk(SBW(p1, l1, 12), SBW(p1, l1, 13)); w.w = cvtpk(SBW(p1, l1, 14), SBW(p1, l1, 15)); pw[3] = __builtin_bit_cast(bf16x8, w);
#undef SBW
            }
            asm volatile("s_waitcnt vmcnt(0)" ::: "memory");
#pragma unroll
            for (int c = 0; c < 2; ++c) {
                bf16x8 va[4];
#pragma unroll
                for (int s = 0; s < 4; ++s) va[s] = vfrag(Vw + vb0 + 2048 * s + 512 * c, Vw + vb1 + 2048 * s + 512 * c);
#pragma unroll
                for (int s = 0; s < 4; ++s) oacc[c] = __builtin_amdgcn_mfma_f32_32x32x16_bf16(va[s], pw[s], oacc[c], 0, 0, 0);
            }
            if (__all(R < SB_STOP)) break;
        }
        bf16* op = mix + ((size_t)b * SEQ + qpos) * DM + h * 64 + 8 * hi;
#pragma unroll
        for (int c = 0; c < 2; ++c)
#pragma unroll
            for (int k = 0; k < 2; ++k) {
                unsigned ax = cvtpk(oacc[c][8 * k], oacc[c][8 * k + 1]), ay = cvtpk(oacc[c][8 * k + 2], oacc[c][8 * k + 3]);
                unsigned bx = cvtpk(oacc[c][8 * k + 4], oacc[c][8 * k + 5]), by = cvtpk(oacc[c][8 * k + 6], oacc[c][8 * k + 7]);
                { auto r = __builtin_amdgcn_permlane32_swap(ax, bx, false, false); ax = r[0]; bx = r[1]; }
                { auto r = __builtin_amdgcn_permlane32_swap(ay, by, false, false); ay = r[0]; by = r[1]; }
                v4u w; w.x = ax; w.y = ay; w.z = bx; w.w = by;
                *(GAS v4u*)(op + 32 * c + 16 * k) = w; }
    }
}

#ifndef MK_NAIVE_DIFF
#define MK_NAIVE_DIFF 0
#endif
constexpr int NPHASE = 19;
#ifndef MK_REP3_SUB
#define MK_REP3_SUB 0
#endif
#ifndef MK_REPEAT_PHASE
#define MK_REPEAT_PHASE -1
#endif
#ifndef MK_REPEAT_COUNT
#define MK_REPEAT_COUNT 2
#endif
#ifndef MK_NAIVE_MIX0
#define MK_NAIVE_MIX0 0
#endif
struct Args { const float* in[32]; float* out; unsigned char* ws; int ph_lo, ph_hi; float lambda_init; int pad; };
__global__ void __launch_bounds__(NWAVES * 64, 2) mk_fwd(Args args) {
    extern __shared__ __attribute__((aligned(16))) unsigned char lds[];
    Frame F;
    F.lds = (LAS unsigned char*)lds; F.MISC = (volatile LAS unsigned*)(F.lds + MISC_OFF);
    F.wave = __builtin_amdgcn_readfirstlane(threadIdx.x >> 6); F.lane = mk_lane(); F.tid = F.wave * 64 + F.lane;
    F.G = gridDim.x; F.gw = blockIdx.x * NWAVES + F.wave; F.NGW = F.G * NWAVES;
    F.out = args.out; F.ws = args.ws; F.ctl = (gu32*)(args.ws + WS_CTL);
    for (int u = F.tid; u < (LDS_BYTES - MISC_OFF) / 4; u += NWAVES * 64) ((LAS unsigned*)(F.lds + MISC_OFF))[u] = 0u;
    __syncthreads();
    if (F.tid < 32) ((LAS unsigned long long*)(F.lds + MISC_OFF + 512))[F.tid] = (unsigned long long)args.in[F.tid];
    __syncthreads();
    const int lo = args.ph_lo, hi = args.ph_hi;
    const bool one = (hi - lo) > 1;
    XcdBarrier bar; bar.bar = (unsigned*)(F.ctl + CW_BAR); bar.x = 0; bar.st = nullptr; bar.wave = F.wave;
    if (one) bar = xcd_barrier_post((unsigned*)(F.ctl + CW_BAR), F.MISC + 8, F.wave);
#define IN(k) (lo <= (k) && (k) < hi && ((F.lane = mk_lane()), (F.tid = F.wave * 64 + F.lane), true))
#define SEAM(k) do { if (IN(k) && IN((k) + 1)) xcd_barrier(bar); } while (0)
    unsigned char* ws = args.ws;
    float* xo = args.out;
    const float* mod0 = (const float*)(ws + WS_MOD); const float* mod1 = mod0 + (size_t)NB * 6144;
    bf16* H = (bf16*)(ws + WS_H); bf16* PROJ = (bf16*)(ws + WS_PROJ); bf16* MIX = (bf16*)args.out;                   bf16* ACT = (bf16*)(ws + WS_ACT); bf16* XB = (bf16*)(ws + WS_XB);
    const int G = F.G, cid = (int)blockIdx.x;

    if (IN(0)) for (int rep_ = 0; rep_ < ((MK_REPEAT_PHASE == 0) ? MK_REPEAT_COUNT : 1); ++rep_) { if (rep_ > 0) __syncthreads();  p_prologue(F); } SEAM(0);
    if (IN(1)) for (int rep_ = 0; rep_ < ((MK_REPEAT_PHASE == 1) ? MK_REPEAT_COUNT : 1); ++rep_) { if (rep_ > 0) __syncthreads();  p_norm_mod<false>(F, inp(F, 0), H, inp(F, 5), mod0, 0, 1024); } SEAM(1);
    if (IN(2)) for (int rep_ = 0; rep_ < ((MK_REPEAT_PHASE == 2) ? MK_REPEAT_COUNT : 1); ++rep_) { if (rep_ > 0) __syncthreads();  pg8::SchedPlain S; S.init(H, ws + WS_WIN0, MTOK, EVEN_IN, DM, G, cid); pg8::EpiStore E{(pg8::bf16_t*)PROJ, EVEN_IN, SB_QSCALE_COLS, SB_QSCALE};
                 pg8::gphase<pg8::EpiStore, pg8::SchedPlain, false>(F.lds, DM, S, E, F.wave, F.lane); } SEAM(2);
    if (IN(3)) for (int rep_ = 0; rep_ < ((MK_REPEAT_PHASE == 3) ? MK_REPEAT_COUNT : 1); ++rep_) { if (rep_ > 0) __syncthreads();
#if MK_NAIVE_MIX0
        if (F.wave == 0) { if (cid < NB * 8) p_lru_naive_wave(F, cid, PROJ, MIX); } else p_sb_naive(F, PROJ, MIX);
#else
        if (rep_ == 0 || MK_REP3_SUB != 2) p_lru_local(F, PROJ);
        if (rep_ == 0 || MK_REP3_SUB != 1) p_sb_attn(F, PROJ, MIX);
#endif
    } SEAM(3);
    if (IN(4)) for (int rep_ = 0; rep_ < ((MK_REPEAT_PHASE == 4) ? MK_REPEAT_COUNT : 1); ++rep_) { if (rep_ > 0) __syncthreads();
#if !MK_NAIVE_MIX0
        p_lru_fix(F, PROJ, MIX);
#endif
    } SEAM(4);

    if (IN(5)) for (int rep_ = 0; rep_ < ((MK_REPEAT_PHASE == 5) ? MK_REPEAT_COUNT : 1); ++rep_) { if (rep_ > 0) __syncthreads();  pg8::SchedPlain S; S.init(MIX, ws + WS_WOUT0, MTOK, DM, DM, G, cid); pg8::EpiResid<false> E{inp(F, 0), (pg8::bf16_t*)XB, mod0 + 2048, 6144, SEQ, DM, 0};
                 pg8::gphase<pg8::EpiResid<false>, pg8::SchedPlain, false>(F.lds, DM, S, E, F.wave, F.lane); } SEAM(5);
    if (IN(6)) for (int rep_ = 0; rep_ < ((MK_REPEAT_PHASE == 6) ? MK_REPEAT_COUNT : 1); ++rep_) { if (rep_ > 0) __syncthreads();  p_norm_mod<true>(F, XB, H, inp(F, 6), mod0, 3072, 4096); } SEAM(6);
    if (IN(7)) for (int rep_ = 0; rep_ < ((MK_REPEAT_PHASE == 7) ? MK_REPEAT_COUNT : 1); ++rep_) { if (rep_ > 0) __syncthreads();  pg8::SchedPlain S; S.init(H, ws + WS_WGU0, MTOK, 2 * FFD, DM, G, cid); pg8::EpiSwiglu E{(pg8::bf16_t*)ACT, FFD, 0};
                 pg8::gphase<pg8::EpiSwiglu, pg8::SchedPlain, false>(F.lds, DM, S, E, F.wave, F.lane); } SEAM(7);
    if (IN(8)) for (int rep_ = 0; rep_ < ((MK_REPEAT_PHASE == 8) ? MK_REPEAT_COUNT : 1); ++rep_) { if (rep_ > 0) __syncthreads();  pg8::SchedPlain S; S.init(ACT, ws + WS_WD0, MTOK, DM, FFD, G, cid); pg8::EpiResid<true> E{XB, (pg8::bf16_t*)XB, mod0 + 5120, 6144, SEQ, DM, 0};
                 pg8::gphase<pg8::EpiResid<true>, pg8::SchedPlain, false>(F.lds, FFD, S, E, F.wave, F.lane); } SEAM(8);
    if (IN(9)) for (int rep_ = 0; rep_ < ((MK_REPEAT_PHASE == 9) ? MK_REPEAT_COUNT : 1); ++rep_) { if (rep_ > 0) __syncthreads();  p_norm_mod<true>(F, XB, H, inp(F, 5) + DM, mod1, 0, 1024); } SEAM(9);
    if (IN(10)) for (int rep_ = 0; rep_ < ((MK_REPEAT_PHASE == 10) ? MK_REPEAT_COUNT : 1); ++rep_) { if (rep_ > 0) __syncthreads();  pg8::SchedPlain S; S.init(H, ws + WS_WIN1, MTOK, ODD_IN, DM, G, cid); pg8::EpiStore E{(pg8::bf16_t*)PROJ, ODD_IN, ATTN_QSCALE_COLS, ATTN_QSCALE};
                 pg8::gphase<pg8::EpiStore, pg8::SchedPlain, false>(F.lds, DM, S, E, F.wave, F.lane); } SEAM(10);
    if (IN(11)) for (int rep_ = 0; rep_ < ((MK_REPEAT_PHASE == 11) ? MK_REPEAT_COUNT : 1); ++rep_) { if (rep_ > 0) __syncthreads();
#if MK_NAIVE_DIFF
        p_diff_naive(F, PROJ, MIX, args.lambda_init);
#else
#ifdef MK_ATTN_VAR
        if (rep_ == 0) p_diff_attn(F, PROJ, MIX, args.lambda_init); else p_diff_attn_t<MK_ATTN_VAR>(F, PROJ, H, args.lambda_init);
#else
        p_diff_attn(F, PROJ, MIX, args.lambda_init);
#endif
#endif
    } SEAM(11);
    if (IN(12)) for (int rep_ = 0; rep_ < ((MK_REPEAT_PHASE == 12) ? MK_REPEAT_COUNT : 1); ++rep_) { if (rep_ > 0) __syncthreads();  pg8::SchedPlain S; S.init(MIX, ws + WS_WOUT1, MTOK, DM, DM, G, cid); pg8::EpiResid<true> E{XB, (pg8::bf16_t*)XB, mod1 + 2048, 6144, SEQ, DM, 0};
                  pg8::gphase<pg8::EpiResid<true>, pg8::SchedPlain, false>(F.lds, DM, S, E, F.wave, F.lane); } SEAM(12);
    if (IN(13)) for (int rep_ = 0; rep_ < ((MK_REPEAT_PHASE == 13) ? MK_REPEAT_COUNT : 1); ++rep_) { if (rep_ > 0) __syncthreads();  p_router(F, XB, H, inp(F, 6) + DM, mod1, 3072, 4096); } SEAM(13);
    int ntiles = 0;
    LAS int* mtab = (LAS int*)(F.lds + MISC_OFF + 256);
    if (hi > 14 && lo < 18) {
        int acc_t = 0;
#pragma unroll
        for (int e = 0; e < NEXP; ++e) { const int c = (int)__builtin_amdgcn_readfirstlane(__hip_atomic_load(F.ctl + CW_CNT + 64 * e, RLX_AGENT));
            if (F.tid == 0) { mtab[e] = acc_t; mtab[16 + e] = c; } acc_t += (c + 255) >> 8; }
        if (F.tid == 0) mtab[8] = acc_t;
        ntiles = acc_t;
        __syncthreads();
    }
    const int nA = ntiles < MOE_CHUNK_TILES ? ntiles : MOE_CHUNK_TILES, nAB = ntiles < 2 * MOE_CHUNK_TILES ? ntiles : 2 * MOE_CHUNK_TILES, nB = nAB - nA, nO = ntiles - nAB;
    const bool fancy = (G == 256) && nO > 0 && nB == MOE_CHUNK_TILES;
    const int nd = fancy ? 4 * nO : 0;
    const int* list = (const int*)(ws + WS_LIST);
#define MOE_SCHED(S, Aptr, Wptr, Kk, gat, t0_, nM_, nN_, ovfat_, mode_) pg8::SchedMoe S; S.A = (const char*)(Aptr); S.W = (const char*)(Wptr); S.wstride = WMOE_STRIDE; S.list = list; S.cap = LIST_CAP; S.tab = mtab; \
        S.t0 = (t0_); S.K = (Kk); S.gather = (gat); S.ovf_at = (ovfat_); S.ovf_tile0 = 2 * MOE_CHUNK_TILES; S.mode = (mode_); S.nd = nd; S.rounds = ((nM_) * (nN_) + G - 1) / G; S.so.init((nM_) * 256, (nN_) * 256, G, cid)
    if (IN(14)) for (int rep_ = 0; rep_ < ((MK_REPEAT_PHASE == 14) ? MK_REPEAT_COUNT : 1); ++rep_) { if (rep_ > 0) __syncthreads();  MOE_SCHED(S, H, ws + WS_WMOE, DM, 1, 0, nA + (fancy ? nO : 0), 2 * FFE / 256, nA, 0);
                  pg8::EpiSwiglu E{(pg8::bf16_t*)ACT, FFE, 0};
                  pg8::gphase<pg8::EpiSwiglu, pg8::SchedMoe, true>(F.lds, DM, S, E, F.wave, F.lane); } SEAM(14);
    if (IN(15)) for (int rep_ = 0; rep_ < ((MK_REPEAT_PHASE == 15) ? MK_REPEAT_COUNT : 1); ++rep_) { if (rep_ > 0) __syncthreads();  MOE_SCHED(S, ACT, ws + WS_WMOE + WMOE_D_OFF, FFE, 0, 0, nA, DM / 256, 1 << 30, 0);
                  pg8::EpiMoeDown E{(pg8::bf16_t*)xo, list, LIST_CAP};
                  pg8::gphase<pg8::EpiMoeDown, pg8::SchedMoe, false>(F.lds, FFE, S, E, F.wave, F.lane); } SEAM(15);
    if (IN(16)) for (int rep_ = 0; rep_ < ((MK_REPEAT_PHASE == 16) ? MK_REPEAT_COUNT : 1); ++rep_) { if (rep_ > 0) __syncthreads();  if (fancy) { MOE_SCHED(S, ACT, ws + WS_WMOE + WMOE_D_OFF, FFE, 0, 0, nO, DM / 256, MOE_CHUNK_TILES, 2);
                      pg8::EpiMoeDown E{(pg8::bf16_t*)xo, list, LIST_CAP};
                      pg8::gphase<pg8::EpiMoeDown, pg8::SchedMoe, false>(F.lds, FFE, S, E, F.wave, F.lane); }
                  { MOE_SCHED(S, H, ws + WS_WMOE, DM, 1, nA, nB + (fancy ? 0 : nO), 2 * FFE / 256, 1 << 30, fancy ? 1 : 0);
                    pg8::EpiSwiglu E{(pg8::bf16_t*)ACT, FFE, 0};
                    pg8::gphase<pg8::EpiSwiglu, pg8::SchedMoe, true>(F.lds, DM, S, E, F.wave, F.lane); } } SEAM(16);
    if (IN(17)) for (int rep_ = 0; rep_ < ((MK_REPEAT_PHASE == 17) ? MK_REPEAT_COUNT : 1); ++rep_) { if (rep_ > 0) __syncthreads();  MOE_SCHED(S, ACT, ws + WS_WMOE + WMOE_D_OFF, FFE, 0, nA, nB + (fancy ? 0 : nO), DM / 256, 1 << 30, 0);
                  pg8::EpiMoeDown E{(pg8::bf16_t*)xo, list, LIST_CAP};
                  pg8::gphase<pg8::EpiMoeDown, pg8::SchedMoe, false>(F.lds, FFE, S, E, F.wave, F.lane); } SEAM(17);
#undef MOE_SCHED
    if (IN(18)) for (int rep_ = 0; rep_ < ((MK_REPEAT_PHASE == 18) ? MK_REPEAT_COUNT : 1); ++rep_) { if (rep_ > 0) __syncthreads();  p_final(F, XB, mod1 + 5120, inp(F, 7)); }
#undef IN
#undef SEAM
}

#ifndef MK_ONE_LAUNCH
#define MK_ONE_LAUNCH 1
#endif
extern "C" void kernel_launch(void* const* d_in, const int* in_sizes, int n_in, void* d_out, int out_size, void* d_ws, size_t ws_size, hipStream_t stream) {
    static int grid = 0;
    if (grid == 0) {
        int dev = 0, cus = 0;
        if (hipGetDevice(&dev) != hipSuccess || hipDeviceGetAttribute(&cus, hipDeviceAttributeMultiprocessorCount, dev) != hipSuccess) { grid = -1; return; }
        if (n_in != 32 || ws_size < WS_END) { fprintf(stderr, "kernel_launch: unexpected n_in %d / ws %zu\n", n_in, ws_size); grid = -1; return; }
        if (hipFuncSetAttribute((const void*)mk_fwd, hipFuncAttributeMaxDynamicSharedMemorySize, LDS_BYTES) != hipSuccess) { grid = -1; return; }
        grid = cus;
    }
    if (grid < 0) return;
    (void)hipMemsetAsync((char*)d_ws + WS_CTL, 0, CTL_ZERO_BYTES, stream);
    Args a{};
    for (int i = 0; i < 32; ++i) a.in[i] = (const float*)d_in[i];
    a.out = (float*)d_out; a.ws = (unsigned char*)d_ws; a.lambda_init = (float)(0.8 - 0.6 * exp(-0.3 * 1.0)); a.pad = 0;
#if MK_ONE_LAUNCH
    a.ph_lo = 0; a.ph_hi = NPHASE;
    hipLaunchKernelGGL(mk_fwd, dim3(grid), dim3(NWAVES * 64), LDS_BYTES, stream, a);
#else
    for (int p = 0; p < NPHASE; ++p) { a.ph_lo = p; a.ph_hi = p + 1; hipLaunchKernelGGL(mk_fwd, dim3(grid), dim3(NWAVES * 64), LDS_BYTES, stream, a); }
#endif
}
```
